# Optimizing an MI355X kernel written in HIP

```python
import math
import jax
import jax.numpy as jnp
from jax import lax
import numpy as np


D_MODEL = 4096
BATCH = 8
SEQ = 2048
DEPTH = 2

HEAD_DIM = 128
N_GROUPS = 4
GROUP_WIDTH = D_MODEL // N_GROUPS
N_HEADS = GROUP_WIDTH // HEAD_DIM
MIX_WIDTH = N_GROUPS * GROUP_WIDTH
Q_BLOCK = 128
EPS = 1e-6
NEG_INF = -1e30

DIFF_DH = HEAD_DIM // 2

DILATED_CFG = ((128, 1), (512, 4), (2048, 16))
DIL_BLOCK = 64

GRID_W = 64
NA_ROWS_MAX = 8
NA_COLS = 16

Q_LORA = 768
KV_LORA = 512
QK_NOPE = 128
QK_ROPE = 64
V_DIM = 128
ROPE_THETA = 10000.0

PEER_HEADS = 8
PEER_NKEYS = 128
PEER_EXPERTS = PEER_NKEYS * PEER_NKEYS
PEER_DQ = 256
PEER_TOPK = 16
PEER_CHUNK = 128

QKV_COLS = 3 * GROUP_WIDTH
MLA_COLS = Q_LORA + KV_LORA + QK_ROPE
IN_COLS = 3 * QKV_COLS + MLA_COLS

kernel_name = 'hybrid_parallel_mixer_peer_encoder'


def rms_norm(x, g):
    xf = x.astype(jnp.float32)
    y = xf * lax.rsqrt(jnp.mean(xf * xf, axis=-1, keepdims=True) + EPS)
    return (y * g.astype(jnp.float32)).astype(x.dtype)


def alibi_slopes(n):
    return jnp.asarray(2.0 ** (-8.0 * np.arange(1, n + 1) / n), dtype=jnp.float32)


def rope(x, cos, sin):
    x1, x2 = jnp.split(x, 2, axis=-1)
    c = cos.astype(x.dtype)
    s = sin.astype(x.dtype)
    return jnp.concatenate([x1 * c - x2 * s, x2 * c + x1 * s], axis=-1)


def block_attention(q, k, v, scale):
    B, S, H, _ = q.shape
    n_blk = S // Q_BLOCK
    q_blocks = q.reshape(B, n_blk, Q_BLOCK, H, q.shape[-1]).swapaxes(0, 1)

    def blk(q_blk):
        s = jnp.einsum('bqhd,bkhd->bhqk', q_blk, k, preferred_element_type=jnp.float32) * scale
        a = jax.nn.softmax(s, axis=-1)
        return jnp.einsum('bhqk,bkhd->bqhd', a.astype(v.dtype), v)

    o = lax.map(blk, q_blocks)
    return o.swapaxes(0, 1).reshape(B, S, H, v.shape[-1])


def diff_attention(p, lam_vecs, g_qk, g_out, lambda_init):
    B, S, _ = p.shape
    q = rms_norm(p[..., :GROUP_WIDTH].reshape(B, S, N_HEADS, 2, DIFF_DH), g_qk[0])
    k = rms_norm(p[..., GROUP_WIDTH:2 * GROUP_WIDTH].reshape(B, S, N_HEADS, 2, DIFF_DH), g_qk[1])
    v = p[..., 2 * GROUP_WIDTH:].reshape(B, S, N_HEADS, HEAD_DIM)
    lv = lam_vecs.astype(jnp.float32)
    lam = jnp.exp(jnp.sum(lv[0] * lv[1])) - jnp.exp(jnp.sum(lv[2] * lv[3])) + lambda_init
    slopes = alibi_slopes(N_HEADS)
    n_blk = S // Q_BLOCK
    q_blocks = q.reshape(B, n_blk, Q_BLOCK, N_HEADS, 2, DIFF_DH).swapaxes(0, 1)
    k_pos = jnp.arange(S)
    scale = DIFF_DH ** -0.5

    def block(args):
        q_blk, b = args
        s = jnp.einsum('bqhcd,bkhcd->bhcqk', q_blk, k, preferred_element_type=jnp.float32) * scale
        q_pos = b * Q_BLOCK + jnp.arange(Q_BLOCK)
        dist = jnp.abs(q_pos[:, None] - k_pos[None, :]).astype(jnp.float32)
        s = s - slopes[:, None, None, None] * dist
        a = jax.nn.softmax(s, axis=-1)
        w = a[:, :, 0] - lam * a[:, :, 1]
        return jnp.einsum('bhqk,bkhd->bqhd', w.astype(v.dtype), v)

    o = lax.map(block, (q_blocks, jnp.arange(n_blk)))
    o = o.swapaxes(0, 1).reshape(B, S, N_HEADS, HEAD_DIM)
    o = rms_norm(o, g_out) * (1.0 - lambda_init)
    return o.reshape(B, S, GROUP_WIDTH)


def dilated_branch(q, k, v, window, dil, slopes):
    B, S, H, dh = q.shape
    half = window // (2 * dil)
    L = S // dil
    n_blk = -(-L // DIL_BLOCK)
    Lp = n_blk * DIL_BLOCK
    span = DIL_BLOCK + 2 * half

    def to_sub(a):
        return a.reshape(B, L, dil, H, dh).transpose(0, 2, 3, 1, 4)

    qs = jnp.pad(to_sub(q), ((0, 0), (0, 0), (0, 0), (0, Lp - L), (0, 0)))
    kv_pad = ((0, 0), (0, 0), (0, 0), (half, Lp - L + half), (0, 0))
    ks = jnp.pad(to_sub(k), kv_pad)
    vs = jnp.pad(to_sub(v), kv_pad)
    k_idx = np.arange(n_blk)[:, None] * DIL_BLOCK + np.arange(span)[None, :]
    kb = ks[:, :, :, k_idx]
    vb = vs[:, :, :, k_idx]
    qb = qs.reshape(B, dil, H, n_blk, DIL_BLOCK, dh)
    s = jnp.einsum('brhnqd,brhnkd->brhnqk', qb, kb, preferred_element_type=jnp.float32) * dh ** -0.5
    q_l = np.arange(n_blk)[:, None] * DIL_BLOCK + np.arange(DIL_BLOCK)[None, :]
    k_l = k_idx - half
    rel = k_l[:, None, :] - q_l[:, :, None]
    valid = (np.abs(rel) <= half) & (k_l[:, None, :] >= 0) & (k_l[:, None, :] < L)
    dist = jnp.asarray(np.abs(rel) * dil, dtype=jnp.float32)
    s = s - slopes[:, None, None, None] * dist
    s = jnp.where(valid, s, NEG_INF)
    lse = jax.nn.logsumexp(s, axis=-1)
    a = jnp.exp(s - lse[..., None])
    o = jnp.einsum('brhnqk,brhnkd->brhnqd', a.astype(v.dtype), vb)
    o = o.reshape(B, dil, H, Lp, dh)[:, :, :, :L].transpose(0, 3, 1, 2, 4).reshape(B, S, H, dh)
    lse = lse.reshape(B, dil, H, Lp)[..., :L].transpose(0, 3, 1, 2).reshape(B, S, H)
    return o, lse


def dilated_attention(p, g_qk):
    B, S, _ = p.shape
    shp = (B, S, N_HEADS, HEAD_DIM)
    q = rms_norm(p[..., :GROUP_WIDTH].reshape(shp), g_qk[0])
    k = rms_norm(p[..., GROUP_WIDTH:2 * GROUP_WIDTH].reshape(shp), g_qk[1])
    v = p[..., 2 * GROUP_WIDTH:].reshape(shp)
    slopes = alibi_slopes(N_HEADS)
    outs, lses = [], []
    for window, dil in DILATED_CFG:
        o, lse = dilated_branch(q, k, v, window, dil, slopes)
        outs.append(o)
        lses.append(lse)
    wts = jax.nn.softmax(jnp.stack(lses, axis=0), axis=0)
    o = jnp.einsum('ibsh,ibshd->bshd', wts.astype(v.dtype), jnp.stack(outs, axis=0))
    return o.reshape(B, S, GROUP_WIDTH)


def neighbourhood_attention(p, g_qk, rpb):
    B, S, _ = p.shape
    rows = S // GRID_W
    kr = min(NA_ROWS_MAX, rows)
    shp = (B, rows, GRID_W, N_HEADS, HEAD_DIM)
    q = rms_norm(p[..., :GROUP_WIDTH].reshape(shp), g_qk[0])
    k = rms_norm(p[..., GROUP_WIDTH:2 * GROUP_WIDTH].reshape(shp), g_qk[1])
    v = p[..., 2 * GROUP_WIDTH:].reshape(shp)
    n_cb = GRID_W // NA_COLS
    span = 2 * NA_COLS
    q_col = np.arange(GRID_W).reshape(n_cb, NA_COLS)
    k_col = np.clip(np.arange(n_cb) * NA_COLS - NA_COLS // 2, 0, GRID_W - span)[:, None] + np.arange(span)[None, :]
    c_start = np.clip(q_col - NA_COLS // 2, 0, GRID_W - NA_COLS)
    col_ok = (k_col[:, None, :] >= c_start[:, :, None]) & (k_col[:, None, :] < c_start[:, :, None] + NA_COLS)
    col_idx = np.clip(k_col[:, None, :] - q_col[:, :, None] + NA_COLS - 1, 0, 2 * NA_COLS - 2)
    bias_col = rpb.astype(jnp.float32)[:, :, col_idx]
    scale = HEAD_DIM ** -0.5

    def row(args):
        q_row, r = args
        rs = jnp.clip(r - kr // 2, 0, rows - kr)
        kg = lax.dynamic_slice_in_dim(k, rs, kr, axis=1)[:, :, k_col]
        vg = lax.dynamic_slice_in_dim(v, rs, kr, axis=1)[:, :, k_col]
        qc = q_row.reshape(B, n_cb, NA_COLS, N_HEADS, HEAD_DIM)
        s = jnp.einsum('bcqhd,bjckhd->bhcqjk', qc, kg, preferred_element_type=jnp.float32) * scale
        row_idx = rs + jnp.arange(kr) - r + NA_ROWS_MAX - 1
        s = s + bias_col[:, row_idx].transpose(0, 2, 3, 1, 4)[None]
        s = jnp.where(col_ok[:, :, None, :], s, NEG_INF)
        a = jax.nn.softmax(s.reshape(B, N_HEADS, n_cb, NA_COLS, kr * span), axis=-1).reshape(s.shape)
        o = jnp.einsum('bhcqjk,bjckhd->bcqhd', a.astype(v.dtype), vg)
        return o.reshape(B, GRID_W, N_HEADS, HEAD_DIM)

    o = lax.map(row, (q.swapaxes(0, 1), jnp.arange(rows)))
    return o.swapaxes(0, 1).reshape(B, S, GROUP_WIDTH)


def mla_attention(p, g_cq, g_ckv, w_uq, w_ukv, g_qk, cos, sin):
    B, S, _ = p.shape
    c_q = rms_norm(p[..., :Q_LORA], g_cq)
    c_kv = rms_norm(p[..., Q_LORA:Q_LORA + KV_LORA], g_ckv)
    k_rope = p[..., Q_LORA + KV_LORA:]
    q = (c_q @ w_uq).reshape(B, S, N_HEADS, QK_NOPE + QK_ROPE)
    kv = (c_kv @ w_ukv).reshape(B, S, N_HEADS, QK_NOPE + V_DIM)
    k_nope, v = kv[..., :QK_NOPE], kv[..., QK_NOPE:]
    k = jnp.concatenate([k_nope, jnp.broadcast_to(k_rope[:, :, None, :], (B, S, N_HEADS, QK_ROPE))], axis=-1)
    q = rms_norm(q, g_qk[0])
    k = rms_norm(k, g_qk[1])
    q = jnp.concatenate([q[..., :QK_NOPE], rope(q[..., QK_NOPE:], cos, sin)], axis=-1)
    k = jnp.concatenate([k[..., :QK_NOPE], rope(k[..., QK_NOPE:], cos, sin)], axis=-1)
    o = block_attention(q, k, v, (QK_NOPE + QK_ROPE) ** -0.5)
    return o.reshape(B, S, N_HEADS * V_DIM)


def peer_ffn(h, w_q, sub_keys, u, v):
    B, S, D = h.shape
    T = B * S
    hf = h.reshape(T, D)
    q = (hf @ w_q).reshape(T, PEER_HEADS, 2, PEER_DQ // 2)
    sc = jnp.einsum('thcd,hcnd->thcn', q, sub_keys, preferred_element_type=jnp.float32)
    top_s, top_i = lax.top_k(sc, PEER_TOPK)
    cand_s = (top_s[:, :, 0, :, None] + top_s[:, :, 1, None, :]).reshape(T, PEER_HEADS, PEER_TOPK * PEER_TOPK)
    cand_i = (top_i[:, :, 0, :, None] * PEER_NKEYS + top_i[:, :, 1, None, :]).reshape(T, PEER_HEADS, PEER_TOPK * PEER_TOPK)
    best_s, best_j = lax.top_k(cand_s, PEER_TOPK)
    expert = jnp.take_along_axis(cand_i, best_j, axis=-1)
    gate = jax.nn.softmax(best_s, axis=-1)
    n_chunk = T // PEER_CHUNK
    n_sel = PEER_HEADS * PEER_TOPK

    def chunk(args):
        h_c, e_c, g_c = args
        act = jax.nn.gelu(jnp.einsum('cd,ced->ce', h_c, u[e_c]), approximate=False)
        return jnp.einsum('ce,ced->cd', (g_c * act).astype(h_c.dtype), v[e_c])

    out = lax.map(chunk, (hf.reshape(n_chunk, PEER_CHUNK, D),
                          expert.reshape(n_chunk, PEER_CHUNK, n_sel),
                          gate.reshape(n_chunk, PEER_CHUNK, n_sel)))
    return out.reshape(B, S, D)


def setup_inputs(seed: int = 0) -> dict:
    key = jax.random.key(seed)
    ks = jax.random.split(key, 20)

    def nrm(k, shape, scale):
        return jax.random.normal(k, shape, jnp.float32) * scale

    def gain(k, shape):
        return 1.0 + 0.01 * jax.random.normal(k, shape, jnp.float32)

    L = DEPTH
    return {
        'x': nrm(ks[0], (BATCH, SEQ, D_MODEL), 1.0),
        'g_mix': gain(ks[1], (L, D_MODEL)),
        'w_in': nrm(ks[2], (L, D_MODEL, IN_COLS), D_MODEL ** -0.5),
        'w_out': nrm(ks[3], (L, MIX_WIDTH, D_MODEL), MIX_WIDTH ** -0.5),
        'diff_lambda': nrm(ks[4], (L, 4, DIFF_DH), 0.1),
        'diff_g_qk': gain(ks[5], (L, 2, DIFF_DH)),
        'diff_g_out': gain(ks[6], (L, HEAD_DIM)),
        'dil_g_qk': gain(ks[7], (L, 2, HEAD_DIM)),
        'na_g_qk': gain(ks[8], (L, 2, HEAD_DIM)),
        'na_rpb': nrm(ks[9], (L, N_HEADS, 2 * NA_ROWS_MAX - 1, 2 * NA_COLS - 1), 0.1),
        'mla_g_cq': gain(ks[10], (L, Q_LORA)),
        'mla_g_ckv': gain(ks[11], (L, KV_LORA)),
        'mla_w_uq': nrm(ks[12], (L, Q_LORA, N_HEADS * (QK_NOPE + QK_ROPE)), Q_LORA ** -0.5),
        'mla_w_ukv': nrm(ks[13], (L, KV_LORA, N_HEADS * (QK_NOPE + V_DIM)), KV_LORA ** -0.5),
        'mla_g_qk': gain(ks[14], (L, 2, QK_NOPE + QK_ROPE)),
        'g_ffn': gain(ks[15], (L, D_MODEL)),
        'peer_w_q': nrm(ks[16], (L, D_MODEL, PEER_HEADS * PEER_DQ), D_MODEL ** -0.5),
        'peer_sub_keys': nrm(ks[17], (L, PEER_HEADS, 2, PEER_NKEYS, PEER_DQ // 2), (PEER_DQ // 2) ** -0.5),
        'peer_u': nrm(ks[18], (L, PEER_EXPERTS, D_MODEL), D_MODEL ** -0.5),
        'peer_v': nrm(ks[19], (L, PEER_EXPERTS, D_MODEL), PEER_HEADS ** -0.5),
    }


def reference(x, g_mix, w_in, w_out, diff_lambda, diff_g_qk, diff_g_out, dil_g_qk, na_g_qk, na_rpb,
              mla_g_cq, mla_g_ckv, mla_w_uq, mla_w_ukv, mla_g_qk, g_ffn, peer_w_q, peer_sub_keys,
              peer_u, peer_v):
    B, S, D = x.shape
    pos = jnp.arange(S, dtype=jnp.float32)
    inv_freq = 1.0 / (ROPE_THETA ** (jnp.arange(0, QK_ROPE, 2, dtype=jnp.float32) / QK_ROPE))
    ang = pos[:, None] * inv_freq[None, :]
    cos = jnp.cos(ang)[:, None, :]
    sin = jnp.sin(ang)[:, None, :]
    for l in range(DEPTH):
        lambda_init = 0.8 - 0.6 * math.exp(-0.3 * l)
        h = rms_norm(x, g_mix[l])
        p = h @ w_in[l]
        o_a = diff_attention(p[..., :QKV_COLS], diff_lambda[l], diff_g_qk[l], diff_g_out[l], lambda_init)
        o_b = dilated_attention(p[..., QKV_COLS:2 * QKV_COLS], dil_g_qk[l])
        o_c = neighbourhood_attention(p[..., 2 * QKV_COLS:3 * QKV_COLS], na_g_qk[l], na_rpb[l])
        o_d = mla_attention(p[..., 3 * QKV_COLS:], mla_g_cq[l], mla_g_ckv[l], mla_w_uq[l], mla_w_ukv[l],
                            mla_g_qk[l], cos, sin)
        x = x + jnp.concatenate([o_a, o_b, o_c, o_d], axis=-1) @ w_out[l]
        x = x + peer_ffn(rms_norm(x, g_ffn[l]), peer_w_q[l], peer_sub_keys[l], peer_u[l], peer_v[l])
    return x
```

```cpp
#include <hip/hip_runtime.h>
#include <cstdio>
#include <cstdint>
#include <cstddef>
namespace pg8 {
#define PG8_LAS __attribute__((address_space(3)))
typedef unsigned short bf16_t;
typedef short bf16x8 __attribute__((ext_vector_type(8)));
typedef float f32x4 __attribute__((ext_vector_type(4)));
typedef unsigned u32x4 __attribute__((ext_vector_type(4)));
constexpr int BM = 256, BK = 64, HALF = 128, HTB = HALF * BK * 2  , STAGE_BYTES = 8 * HTB, NXCD = 8, WGM = 8;

__host__ __device__ __forceinline__ int lds_byte(int r, int c) { const int st = (r >> 4) * 2 + (c >> 5), rr = r & 15, cc = c & 31, ob = rr * 64 + cc * 2; return st * 1024 + (ob ^ (((ob >> 9) & 1) << 5)); }
__host__ __device__ __forceinline__ void stage_rc(int b, int& R, int& C) { const int st = b / 1024, sb = b % 1024, swz = sb ^ (((sb >> 9) & 1) << 5); R = (st >> 1) * 16 + swz / 64; C = (st & 1) * 32 + (swz % 64) / 2; }
__host__ __device__ __forceinline__ int perm32(int rho) { const int n = rho >> 4, i = rho & 15; return 8 * (i >> 2) + 4 * n + (i & 3); }

struct Unit { int pm, pn; };
struct Gemm { const bf16_t* A; const bf16_t* Bt; int M, N, K; };

struct StaticOrder {
    int nM, nN, nwg, G, c;
    __host__ __device__ void init(int M, int N, int G_, int c_) { nM = M / BM; nN = N / BM; nwg = nM * nN; G = G_; c = c_; }
    __host__ __device__ bool next(int i, Unit& u) const {
        const long L = (long)i * G + c; if (L >= nwg) return false;
        int wgid = (int)L; { const int q = nwg / NXCD, r = nwg % NXCD, xcd = wgid % NXCD, off = wgid / NXCD; wgid = (xcd < r ? xcd * (q + 1) : r * (q + 1) + (xcd - r) * q) + off; }
        const int nig = WGM * nN, gid = wgid / nig, fm = gid * WGM, gsz = (nM - fm) < WGM ? (nM - fm) : WGM;
        u.pm = fm + ((wgid % nig) % gsz); u.pn = (wgid % nig) / gsz; return true;
    }
    __device__ __forceinline__ void a_ready(const Unit&) const {}
    __device__ __forceinline__ void done(const Unit&) const {}
};
__device__ __forceinline__ unsigned cvt_pk_bf16(float lo, float hi) { unsigned r; asm volatile("v_cvt_pk_bf16_f32 %0, %1, %2" : "=v"(r) : "v"(lo), "v"(hi)); return r; }
typedef float f32x2 __attribute__((ext_vector_type(2)));
struct EpiF32 {
    static constexpr bool PERM = false, AFTER_DRAIN = false;
    float* C; int ldc; const float* bias;
    __device__ __forceinline__ void operator()(const f32x4 (&acc)[2][2][4][2], const Unit& u, int wr, int wc, int fr, int fq) const {
        const int row0 = u.pm * BM + wr * 64 + fr, col0 = u.pn * BM + wc * 32 + 4 * fq;
        f32x4 bv[2][2];
#pragma unroll
        for (int bj = 0; bj < 2; ++bj)
#pragma unroll
            for (int n = 0; n < 2; ++n) bv[bj][n] = bias ? *(const f32x4*)(bias + col0 + bj * HALF + n * 16) : (f32x4){0.f, 0.f, 0.f, 0.f};
#pragma unroll
        for (int ai = 0; ai < 2; ++ai)
#pragma unroll
            for (int m = 0; m < 4; ++m) { float* rowp = C + (size_t)(row0 + ai * HALF + m * 16) * ldc + col0;
#pragma unroll
                for (int bj = 0; bj < 2; ++bj)
#pragma unroll
                    for (int n = 0; n < 2; ++n) *(f32x4*)(rowp + bj * HALF + n * 16) = acc[ai][bj][m][n] + bv[bj][n]; }
    }
};
struct EpiBf16P {
    static constexpr bool PERM = true, AFTER_DRAIN = false;
    bf16_t* O; int ldc;
    __device__ __forceinline__ void operator()(const f32x4 (&acc)[2][2][4][2], const Unit& u, int wr, int wc, int fr, int fq) const {
        const int row0 = u.pm * BM + wr * 64 + fr, col0 = u.pn * BM + wc * 32 + 8 * fq;
#pragma unroll
        for (int ai = 0; ai < 2; ++ai)
#pragma unroll
            for (int m = 0; m < 4; ++m) { bf16_t* rowp = O + (size_t)(row0 + ai * HALF + m * 16) * ldc + col0;
#pragma unroll
                for (int bj = 0; bj < 2; ++bj) { const f32x4 v0 = acc[ai][bj][m][0], v1 = acc[ai][bj][m][1];
                    u32x4 w; w.x = cvt_pk_bf16(v0[0], v0[1]); w.y = cvt_pk_bf16(v0[2], v0[3]); w.z = cvt_pk_bf16(v1[0], v1[1]); w.w = cvt_pk_bf16(v1[2], v1[3]);
                    *(u32x4*)(rowp + bj * HALF) = w; } }
    }
};
struct EpiResF32 {
    static constexpr bool PERM = false, AFTER_DRAIN = false;
    const float* res; float* out; int ldc;
    __device__ __forceinline__ void operator()(const f32x4 (&acc)[2][2][4][2], const Unit& u, int wr, int wc, int fr, int fq) const {
        const int row0 = u.pm * BM + wr * 64 + fr, col0 = u.pn * BM + wc * 32 + 4 * fq;
#pragma unroll
        for (int ai = 0; ai < 2; ++ai)
#pragma unroll
            for (int m = 0; m < 4; ++m) { const size_t off = (size_t)(row0 + ai * HALF + m * 16) * ldc + col0;
#pragma unroll
                for (int bj = 0; bj < 2; ++bj)
#pragma unroll
                    for (int n = 0; n < 2; ++n) { const size_t o = off + bj * HALF + n * 16; const f32x4 r = *(const f32x4*)(res + o); *(f32x4*)(out + o) = r + acc[ai][bj][m][n]; } }
    }
};

template <class Epi, class Sched, bool STAMP = false>
__device__ __forceinline__ void gemm_phase(PG8_LAS unsigned char* lds, const Gemm g, const Sched& S, const Epi& E, unsigned long long* stamps) {
    int tid_ = threadIdx.x; asm volatile("" : "+v"(tid_));
    const int tid = tid_, wid = __builtin_amdgcn_readfirstlane(tid >> 6), lane = tid & 63, wr = wid >> 2, wc = wid & 3, fr = lane & 15, fq = lane >> 4;
    const int K = g.K, nt = K / BK;
    int ts_lo = 0, ts_hi = 0, nts = 0; const unsigned long long rt_entry = STAMP ? (unsigned long long)wall_clock64() : 0ull;
#define PG8_STAMP() do { if (STAMP && wid == 0 && nts < 64) { const unsigned long long _c = (unsigned long long)clock64(); \
        ts_lo = (lane == nts) ? (int)(unsigned)_c : ts_lo; ts_hi = (lane == nts) ? (int)(unsigned)(_c >> 32) : ts_hi; ++nts; } } while (0)
    PG8_STAMP();
    unsigned voffA[2], voffB[2];
#pragma unroll
    for (int i = 0; i < 2; ++i) { int R, C; stage_rc(tid * 16 + i * 8192, R, C); const int Rb = Epi::PERM ? ((R & ~31) + perm32(R & 31)) : R;
        voffA[i] = (unsigned)(R * K + C) * 2u; voffB[i] = (unsigned)(Rb * K + C) * 2u; }
    const size_t kstep = (size_t)(BK * 2);
    const size_t hstep = (size_t)HALF * K * 2;
    const size_t tstep = 2 * hstep;
    const unsigned ldsw = (unsigned)wid * 1024u;
    const int aoff = lds_byte(wr * 64 + fr, fq * 8), boff = lds_byte(wc * 32 + fr, fq * 8);
#define PG8_SA(b, h) (((b) * 2 + (h)) * HTB)
#define PG8_SB(b, h) ((4 + (b) * 2 + (h)) * HTB)
#define PG8_STAGE(bufoff, gbase, voff) do { _Pragma("unroll") for (int _i = 0; _i < 2; ++_i) \
        __builtin_amdgcn_global_load_lds((const unsigned*)((const char*)(gbase) + (voff)[_i]), (PG8_LAS unsigned*)(lds + (bufoff) + ldsw + _i * 8192), 16, 0, 0); } while (0)
#define PG8_LDA(dst, b, h) do { _Pragma("unroll") for (int m = 0; m < 4; ++m) _Pragma("unroll") for (int k = 0; k < 2; ++k) dst[m][k] = *(const PG8_LAS bf16x8*)(lds + PG8_SA(b, h) + aoff + m * 2048 + k * 1024); } while (0)
#define PG8_LDB(dst, b, h) do { _Pragma("unroll") for (int n = 0; n < 2; ++n) _Pragma("unroll") for (int k = 0; k < 2; ++k) dst[n][k] = *(const PG8_LAS bf16x8*)(lds + PG8_SB(b, h) + boff + n * 2048 + k * 1024); } while (0)
#define PG8_MMA(ai, bj, At, Bt) do { __builtin_amdgcn_s_setprio(1); _Pragma("unroll") for (int m = 0; m < 4; ++m) _Pragma("unroll") for (int n = 0; n < 2; ++n) _Pragma("unroll") for (int k = 0; k < 2; ++k) \
        acc[ai][bj][m][n] = __builtin_amdgcn_mfma_f32_16x16x32_bf16(Bt[n][k], At[m][k], acc[ai][bj][m][n], 0, 0, 0); __builtin_amdgcn_s_setprio(0); } while (0)
#define PG8_WAIT_V(n) asm volatile("s_waitcnt vmcnt(" #n ")" ::: "memory")
#define PG8_WAIT_L(n) asm volatile("s_waitcnt lgkmcnt(" #n ")" ::: "memory")
#define PG8_BAR __builtin_amdgcn_s_barrier()
#define PG8_SCHED __builtin_amdgcn_sched_barrier(0)
    Unit cur, nxt; int ui = 0;
    if (!S.next(0, cur)) return;
    f32x4 acc[2][2][4][2];
#pragma unroll
    for (int a = 0; a < 2; ++a)
#pragma unroll
        for (int b = 0; b < 2; ++b)
#pragma unroll
            for (int m = 0; m < 4; ++m)
#pragma unroll
                for (int n = 0; n < 2; ++n) acc[a][b][m][n] = (f32x4){0.f, 0.f, 0.f, 0.f};
    bf16x8 At[4][2], B0[2][2], B1[2][2];
    const char* cA = (const char*)g.A + (size_t)cur.pm * tstep; const char* cB = (const char*)g.Bt + (size_t)cur.pn * tstep;
    S.a_ready(cur);
    PG8_STAGE(PG8_SB(0, 0), cB, voffB); PG8_STAGE(PG8_SA(0, 0), cA, voffA); PG8_STAGE(PG8_SB(0, 1), cB + hstep, voffB); PG8_STAGE(PG8_SA(0, 1), cA + hstep, voffA);
    if (wr == 1) PG8_BAR;
    PG8_WAIT_V(4); PG8_BAR;
    PG8_STAGE(PG8_SB(1, 0), cB + kstep, voffB); PG8_STAGE(PG8_SA(1, 0), cA + kstep, voffA); PG8_STAGE(PG8_SB(1, 1), cB + hstep + kstep, voffB);
    PG8_WAIT_V(6); PG8_BAR;
    PG8_STAMP();
    for (;;) {
        const bool has_next = S.next(ui + 1, nxt);
        const char* nA = has_next ? (const char*)g.A + (size_t)nxt.pm * tstep : cA; const char* nB = has_next ? (const char*)g.Bt + (size_t)nxt.pn * tstep : cB;
        for (int t = 0; t < nt; t += 2) {
            const bool last = (t == nt - 2);
            const char* a1 = cA + (size_t)(t + 1) * kstep;
            const char* a2 = last ? nA : cA + (size_t)(t + 2) * kstep; const char* b2 = last ? nB : cB + (size_t)(t + 2) * kstep;
            const char* a3 = a2 + kstep; const char* b3 = b2 + kstep;
            if (last && has_next) S.a_ready(nxt);
            PG8_LDB(B0, 0, 0); PG8_SCHED; PG8_LDA(At, 0, 0); PG8_STAGE(PG8_SA(1, 1), a1 + hstep, voffA);
            PG8_WAIT_L(8); PG8_BAR; PG8_WAIT_L(0); PG8_MMA(0, 0, At, B0); PG8_BAR; PG8_SCHED;
            PG8_LDB(B1, 0, 1); PG8_STAGE(PG8_SB(0, 0), b2, voffB);
            PG8_BAR; PG8_WAIT_L(0); PG8_MMA(0, 1, At, B1); PG8_BAR;
            PG8_LDA(At, 0, 1); PG8_STAGE(PG8_SA(0, 0), a2, voffA);
            PG8_BAR; PG8_WAIT_L(0); PG8_MMA(1, 0, At, B0); PG8_BAR; PG8_SCHED;
            PG8_STAGE(PG8_SB(0, 1), b2 + hstep, voffB);
            PG8_WAIT_V(6); PG8_BAR; PG8_MMA(1, 1, At, B1); PG8_BAR;
            PG8_LDB(B0, 1, 0); PG8_SCHED; PG8_LDA(At, 1, 0); PG8_STAGE(PG8_SA(0, 1), a2 + hstep, voffA);
            PG8_WAIT_L(8); PG8_BAR; PG8_WAIT_L(0); PG8_MMA(0, 0, At, B0); PG8_BAR; PG8_SCHED;
            PG8_LDB(B1, 1, 1); PG8_STAGE(PG8_SB(1, 0), b3, voffB);
            PG8_BAR; PG8_WAIT_L(0); PG8_MMA(0, 1, At, B1); PG8_BAR;
            PG8_LDA(At, 1, 1); PG8_STAGE(PG8_SA(1, 0), a3, voffA);
            PG8_BAR; PG8_WAIT_L(0); PG8_MMA(1, 0, At, B0); PG8_BAR; PG8_SCHED;
            PG8_STAGE(PG8_SB(1, 1), b3 + hstep, voffB);
            PG8_WAIT_V(6); PG8_BAR; PG8_MMA(1, 1, At, B1); PG8_BAR;
        }
        PG8_STAMP();
        if constexpr (!Epi::AFTER_DRAIN) { E(acc, cur, wr, wc, fr, fq); S.done(cur); }
        PG8_STAMP();
        if (!has_next) break;
#pragma unroll
        for (int a = 0; a < 2; ++a)
#pragma unroll
            for (int b = 0; b < 2; ++b)
#pragma unroll
                for (int m = 0; m < 4; ++m)
#pragma unroll
                    for (int n = 0; n < 2; ++n) acc[a][b][m][n] = (f32x4){0.f, 0.f, 0.f, 0.f};
        cur = nxt; cA = nA; cB = nB; ++ui;
    }
    PG8_WAIT_V(0);
    if (wr == 0) PG8_BAR;
    PG8_BAR;
    if constexpr (Epi::AFTER_DRAIN) { E.fused(acc, cur, wr, wc, fr, fq, lds, wid, lane); S.done(cur); }
    PG8_STAMP();
    if (STAMP && wid == 0) { stamps[lane] = lane < nts ? (((unsigned long long)(unsigned)ts_hi << 32) | (unsigned)ts_lo) : 0ull;
        if (lane == 62) stamps[62] = rt_entry; if (lane == 63) stamps[63] = (unsigned long long)wall_clock64(); }
#undef PG8_STAMP
#undef PG8_SA
#undef PG8_SB
#undef PG8_STAGE
#undef PG8_LDA
#undef PG8_LDB
#undef PG8_MMA
#undef PG8_WAIT_V
#undef PG8_WAIT_L
#undef PG8_BAR
#undef PG8_SCHED
}

}

#define XB_TMO      128
#define XB_XCNT(j)  (256  + 64 * (j))
#define XB_XSUB(j)  (1280 + 64 * (j))
#define XB_XGEN(j)  (2304 + 64 * (j))
#define XB_TOP      3328
#define XB_TOPGEN   3392
#define XCD_BAR_WORDS 3456
#define XB_SPIN_CAP (1u << 18)
#define LAS __attribute__((address_space(3)))

__device__ __forceinline__ unsigned xb_ld(unsigned* p)              { return __hip_atomic_load(p, __ATOMIC_RELAXED, __HIP_MEMORY_SCOPE_AGENT); }
__device__ __forceinline__ unsigned xb_add(unsigned* p, unsigned v) { return __hip_atomic_fetch_add(p, v, __ATOMIC_RELAXED, __HIP_MEMORY_SCOPE_AGENT); }
__device__ __forceinline__ unsigned xb_xcc_id() { return (unsigned)__builtin_amdgcn_s_getreg((3 << 11) | 20) & 0xFu; }
#define XB_SPIN(cond, bar) do { unsigned _sp = 0; while (cond) { __builtin_amdgcn_s_sleep(1); \
    if ((++_sp & 255u) == 0u) { if (xb_ld(&(bar)[XB_TMO])) break; if (_sp > XB_SPIN_CAP) { atomicAdd(&(bar)[XB_TMO], 1u); break; } } } } while (0)

struct XcdBarrier {
    unsigned* bar; unsigned x;
    volatile LAS unsigned* st;
};

__device__ __forceinline__ XcdBarrier xcd_barrier_post(unsigned* bar, volatile LAS unsigned* st) {
    XcdBarrier b; b.bar = bar; b.x = xb_xcc_id(); b.st = st;
    if (threadIdx.x == 0) (void)xb_add(&bar[XB_XCNT(b.x)], 1u);
    return b;
}
__device__ __forceinline__ void xcd_barrier_complete(unsigned* bar, unsigned x, unsigned& nloc, unsigned& nx) {
    const unsigned G = gridDim.x * gridDim.y * gridDim.z;
    unsigned sum, cnt, mine, sp = 0u;
    for (;;) {
        sum = 0u; cnt = 0u; mine = 0u;
#pragma unroll
        for (unsigned j = 0; j < 16; ++j) { const unsigned c = xb_ld(&bar[XB_XCNT(j)]); sum += c; cnt += (c > 0u) ? 1u : 0u; mine = (j == x) ? c : mine; }
        if (sum == G) break;
        __builtin_amdgcn_s_sleep(1);
        if ((++sp & 255u) == 0u) { if (xb_ld(&bar[XB_TMO])) break; if (sp > XB_SPIN_CAP) { atomicAdd(&bar[XB_TMO], 1u); break; } }
    }
    nloc = mine > 0u ? mine : 1u; nx = cnt > 0u ? cnt : 1u;
}

__device__ __forceinline__ void xcd_barrier(const XcdBarrier& b) {
    asm volatile("s_waitcnt vmcnt(0)" ::: "memory");
    __syncthreads();
    if (threadIdx.x == 0) {
        unsigned* bar = b.bar;
        __builtin_amdgcn_s_waitcnt(0);
        unsigned nloc = b.st[0], nx = b.st[1];
        if (nloc == 0u) { xcd_barrier_complete(bar, b.x, nloc, nx); b.st[0] = nloc; b.st[1] = nx; }
        const unsigned old = xb_add(&bar[XB_XSUB(b.x)], 1u);
        const unsigned gen = old / nloc;
        if (old + 1u == (gen + 1u) * nloc) {
            __builtin_amdgcn_fence(__ATOMIC_RELEASE, "agent");
            asm volatile("s_waitcnt vmcnt(0)" ::: "memory");
            const unsigned og = xb_add(&bar[XB_TOP], 1u);
            const unsigned tg = og / nx;
            if (og + 1u == (tg + 1u) * nx) xb_add(&bar[XB_TOPGEN], 1u);
            else XB_SPIN(xb_ld(&bar[XB_TOPGEN]) == tg, bar);
            __builtin_amdgcn_fence(__ATOMIC_ACQUIRE, "agent");
            xb_add(&bar[XB_XGEN(b.x)], 1u);
            asm volatile("s_waitcnt vmcnt(0)" ::: "memory");
        } else {
            XB_SPIN(xb_ld(&bar[XB_XGEN(b.x)]) == gen, bar);
            __builtin_amdgcn_fence(__ATOMIC_ACQUIRE, "agent");
            asm volatile("s_waitcnt vmcnt(0)" ::: "memory");
        }
    }
    __syncthreads();
}


namespace mk {
typedef unsigned short bf16_t;
typedef short bf16x8 __attribute__((ext_vector_type(8)));
typedef short s16x4 __attribute__((ext_vector_type(4)));
typedef float f32x16 __attribute__((ext_vector_type(16)));
typedef float f32x4 __attribute__((ext_vector_type(4)));
typedef unsigned u32x4 __attribute__((ext_vector_type(4)));
typedef unsigned u32x2 __attribute__((ext_vector_type(2)));
typedef __bf16 bf2 __attribute__((ext_vector_type(2)));

constexpr int T = 16384, S = 2048, NB = 8, DM = 4096, NIN = 10560, NINP = 10752, NH = 8, NEXP = 16384;
constexpr float EPS = 1e-6f;
constexpr int NWAVES = 8, NTHR = 512;
constexpr int LDS_BYTES = 139264;
constexpr int LDS_XB = 131072;

constexpr size_t SZ_WIN = (size_t)NINP * DM * 2, SZ_WOUT = (size_t)DM * DM * 2, SZ_W2 = (size_t)2048 * DM * 2, SZ_WUQ = (size_t)1536 * 768 * 2, SZ_WUKV = (size_t)2048 * 512 * 2,
                 SZ_TAB = (size_t)NEXP * DM * 2;
constexpr size_t LW_WIN = 0, LW_WOUT = LW_WIN + SZ_WIN, LW_W2 = LW_WOUT + SZ_WOUT, LW_WUQ = LW_W2 + SZ_W2, LW_WUKV = LW_WUQ + SZ_WUQ, LW_U = LW_WUKV + SZ_WUKV, LW_V = LW_U + SZ_TAB,
                 LW_END = LW_V + SZ_TAB;
constexpr size_t WS_CTL = 0, WS_W = 65536, WS_HN = WS_W + 2 * LW_END, SZ_HN = (size_t)T * DM * 2, WS_P = WS_HN + SZ_HN, SZ_P = (size_t)T * NINP * 2;
constexpr size_t SZ_H1 = (size_t)T * 1024 * 2;
constexpr size_t WS_QKV = WS_P + SZ_P;
constexpr size_t QO_QA = 0, QO_KA = SZ_H1, QO_VA = 2 * SZ_H1, QO_QB = 3 * SZ_H1, QO_KB = 4 * SZ_H1, QO_VB = 5 * SZ_H1, QO_QC = 6 * SZ_H1, QO_KC = 7 * SZ_H1, QO_VC = 8 * SZ_H1,
                 QO_QD = 9 * SZ_H1, SZ_QD = (size_t)T * 1536 * 2, QO_KD = QO_QD + SZ_QD, QO_VD = QO_KD + SZ_QD, SZ_QKV = QO_VD + SZ_H1;
constexpr size_t WS_O = WS_QKV + SZ_QKV, SZ_O = (size_t)T * DM * 2, WS_T2 = WS_O + SZ_O, SZ_T2 = (size_t)2 * T * 1024 * 4, WS_END = WS_T2 + SZ_T2;
constexpr size_t SZ_F1 = (size_t)T * 1024 * 4;
constexpr size_t PO_OA = 0, PO_OB = 2 * SZ_F1, PO_LSE = 5 * SZ_F1, SZ_LSE = (size_t)3 * T * 8 * 4;
static_assert(PO_LSE + SZ_LSE <= SZ_P, "P alias");
constexpr size_t PO_SC = 0, SZ_SC = (size_t)T * 2048 * 4, PO_EXP = SZ_SC, SZ_EG = (size_t)T * 128 * 4, PO_GATE = PO_EXP + SZ_EG;
static_assert(PO_GATE + SZ_EG <= SZ_P, "P alias 2");
constexpr size_t OO_QRAW = 0, OO_KVRAW = (size_t)T * 1536 * 2;
static_assert(OO_KVRAW + (size_t)T * 2048 * 2 <= SZ_O, "O alias");
constexpr size_t TO_CQ = 0, TO_CKV = (size_t)T * 768 * 2;
constexpr size_t TO_OC = 0, TO_OD = SZ_F1;

struct Args { const float* in[20]; float* out; unsigned char* ws; int ph_lo, ph_hi; };
enum { I_X = 0, I_GMIX, I_WIN, I_WOUT, I_DLAM, I_DGQK, I_DGOUT, I_DILG, I_NAG, I_RPB, I_GCQ, I_GCKV, I_WUQ, I_WUKV, I_MLAG, I_GFFN, I_PWQ, I_PSK, I_PU, I_PV };

struct Frame {
    const float* in[20]; float* out; unsigned char* ws; LAS unsigned char* lds;
    int tid, lane, wid, G, bx;
};

__device__ __forceinline__ float wsum(float v) {
#pragma unroll
    for (int o = 32; o >= 1; o >>= 1) v += __shfl_xor(v, o);
    return v;
}
__device__ __forceinline__ unsigned pk_bf16(float lo, float hi) { unsigned r; asm volatile("v_cvt_pk_bf16_f32 %0, %1, %2" : "=v"(r) : "v"(lo), "v"(hi)); return r; }
__device__ __forceinline__ float bf_lo(unsigned w) { return __uint_as_float(w << 16); }
__device__ __forceinline__ float bf_hi(unsigned w) { return __uint_as_float(w & 0xffff0000u); }

__device__ __forceinline__ void transpose_tile(const Frame& F, const float* __restrict__ src, int N, int K, bf16_t* __restrict__ dst, const float* __restrict__ gain, int k0, int n0) {
    LAS float* tile = (LAS float*)F.lds;
    const int r = F.tid >> 4, c4 = F.tid & 15;
#pragma unroll
    for (int i = 0; i < 2; ++i) { const int k = r + 32 * i; const f32x4 v = *(const f32x4*)(src + (size_t)(k0 + k) * N + n0 + c4 * 4); const float g = gain ? gain[k0 + k] : 1.0f;
        tile[k * 65 + c4 * 4 + 0] = v[0] * g; tile[k * 65 + c4 * 4 + 1] = v[1] * g; tile[k * 65 + c4 * 4 + 2] = v[2] * g; tile[k * 65 + c4 * 4 + 3] = v[3] * g; }
    __syncthreads();
    const int n = F.tid >> 3, k8 = F.tid & 7;
    float e[8];
#pragma unroll
    for (int j = 0; j < 8; ++j) e[j] = tile[(k8 * 8 + j) * 65 + n];
    u32x4 w; w.x = pk_bf16(e[0], e[1]); w.y = pk_bf16(e[2], e[3]); w.z = pk_bf16(e[4], e[5]); w.w = pk_bf16(e[6], e[7]);
    *(u32x4*)(dst + (size_t)(n0 + n) * K + k0 + k8 * 8) = w;
    __syncthreads();
}

__device__ __forceinline__ void p0_prologue(const Frame& F) {
    constexpr int N_WIN = 64 * 165, N_WOUT = 64 * 64, N_UQ = 12 * 24, N_UKV = 8 * 32, N_L = N_WIN + N_WOUT + N_UQ + N_UKV;
    for (int u = F.bx; u < 2 * N_L; u += F.G) {
        const int l = u / N_L; int r = u % N_L; unsigned char* lw = F.ws + WS_W + (size_t)l * LW_END;
        if (r < N_WIN) { transpose_tile(F, F.in[I_WIN] + (size_t)l * DM * NIN, NIN, DM, (bf16_t*)(lw + LW_WIN), F.in[I_GMIX] + l * DM, (r & 63) * 64, (r >> 6) * 64); continue; }
        r -= N_WIN;
        if (r < N_WOUT) { transpose_tile(F, F.in[I_WOUT] + (size_t)l * DM * DM, DM, DM, (bf16_t*)(lw + LW_WOUT), nullptr, (r & 63) * 64, (r >> 6) * 64); continue; }
        r -= N_WOUT;
        if (r < N_UQ) { transpose_tile(F, F.in[I_WUQ] + (size_t)l * 768 * 1536, 1536, 768, (bf16_t*)(lw + LW_WUQ), F.in[I_GCQ] + l * 768, (r % 12) * 64, (r / 12) * 64); continue; }
        r -= N_UQ;
        transpose_tile(F, F.in[I_WUKV] + (size_t)l * 512 * 2048, 2048, 512, (bf16_t*)(lw + LW_WUKV), F.in[I_GCKV] + l * 512, (r & 7) * 64, (r >> 3) * 64);
    }
    for (int i = F.bx * NTHR + F.tid; i < 2 * 192 * DM / 8; i += F.G * NTHR) { const int l = i / (192 * DM / 8), o = i % (192 * DM / 8);
        *(u32x4*)(F.ws + WS_W + (size_t)l * LW_END + LW_WIN + (size_t)NIN * DM * 2 + (size_t)o * 16) = (u32x4){0u, 0u, 0u, 0u}; }
    {
        LAS float* SK = (LAS float*)F.lds;
        LAS float* WQ = (LAS float*)(F.lds + 65536);
        for (int u = F.bx; u < 2 * 16 * 64; u += F.G) {
            const int l = u >> 10, hc = (u >> 6) & 15, k0 = (u & 63) * 64;
            const float* sk = F.in[I_PSK] + (size_t)(l * 16 + hc) * 128 * 128;
            const float* wq = F.in[I_PWQ] + (size_t)l * DM * 2048 + (size_t)k0 * 2048 + hc * 128;
#pragma unroll
            for (int i = 0; i < 8; ++i) { const int idx = F.tid + NTHR * i, row = idx >> 5, c4 = idx & 31; *(LAS f32x4*)(SK + row * 128 + c4 * 4) = *(const f32x4*)(sk + row * 128 + c4 * 4); }
#pragma unroll
            for (int i = 0; i < 4; ++i) { const int idx = F.tid + NTHR * i, row = idx >> 5, c4 = idx & 31; *(LAS f32x4*)(WQ + row * 132 + c4 * 4) = *(const f32x4*)(wq + (size_t)row * 2048 + c4 * 4); }
            __syncthreads();
            const int k = F.lane, ng = F.wid;
            float acc[16];
#pragma unroll
            for (int j = 0; j < 16; ++j) acc[j] = 0.f;
            for (int d4 = 0; d4 < 32; ++d4) { const f32x4 w = *(const LAS f32x4*)(WQ + k * 132 + d4 * 4);
#pragma unroll
                for (int j = 0; j < 16; ++j) { const f32x4 s = *(const LAS f32x4*)(SK + (ng * 16 + j) * 128 + d4 * 4); acc[j] += w[0] * s[0] + w[1] * s[1] + w[2] * s[2] + w[3] * s[3]; } }
            const float g = F.in[I_GFFN][l * DM + k0 + k];
            bf16_t* w2 = (bf16_t*)(F.ws + WS_W + (size_t)l * LW_END + LW_W2);
#pragma unroll
            for (int j = 0; j < 16; ++j) w2[(size_t)(hc * 128 + ng * 16 + j) * DM + k0 + k] = (bf16_t)(pk_bf16(acc[j] * g, 0.f) & 0xffffu);
            __syncthreads();
        }
    }
    {
        constexpr size_t NCH = (size_t)NEXP * DM / 8;
        for (size_t i = (size_t)F.bx * NTHR + F.tid; i < 4 * NCH; i += (size_t)F.G * NTHR) {
            const int tb = (int)(i / NCH); const size_t o = i % NCH; const int l = tb >> 1, isv = tb & 1;
            const float* src = (isv ? F.in[I_PV] : F.in[I_PU]) + (size_t)l * NEXP * DM + o * 8;
            f32x4 a = *(const f32x4*)src, b = *(const f32x4*)(src + 4);
            if (!isv) { const float* g = F.in[I_GFFN] + l * DM + (int)((o * 8) & (DM - 1)); const f32x4 ga = *(const f32x4*)g, gb = *(const f32x4*)(g + 4); a *= ga; b *= gb; }
            u32x4 w; w.x = pk_bf16(a[0], a[1]); w.y = pk_bf16(a[2], a[3]); w.z = pk_bf16(b[0], b[1]); w.w = pk_bf16(b[2], b[3]);
            *(u32x4*)(F.ws + WS_W + (size_t)l * LW_END + (isv ? LW_V : LW_U) + o * 16) = w;
        }
    }
}

__device__ __forceinline__ void p_norm(const Frame& F, const float* __restrict__ x, bf16_t* __restrict__ hn) {
    for (int t = F.bx * NWAVES + F.wid; t < T; t += F.G * NWAVES) {
        const f32x4* xr = (const f32x4*)(x + (size_t)t * DM);
        f32x4 v[16]; float ss = 0.f;
#pragma unroll
        for (int i = 0; i < 16; ++i) { v[i] = xr[i * 64 + F.lane]; ss += v[i][0] * v[i][0] + v[i][1] * v[i][1] + v[i][2] * v[i][2] + v[i][3] * v[i][3]; }
        ss = wsum(ss);
        const float r = rsqrtf(ss * (1.0f / DM) + EPS);
        u32x2* o = (u32x2*)(hn + (size_t)t * DM);
#pragma unroll
        for (int i = 0; i < 16; ++i) { u32x2 w; w.x = pk_bf16(v[i][0] * r, v[i][1] * r); w.y = pk_bf16(v[i][2] * r, v[i][3] * r); o[i * 64 + F.lane] = w; }
    }
}

__device__ __forceinline__ void unpack16(const u32x4 a, const u32x4 b, float (&x)[16]) {
#pragma unroll
    for (int i = 0; i < 4; ++i) { x[2 * i] = bf_lo(a[i]); x[2 * i + 1] = bf_hi(a[i]); x[8 + 2 * i] = bf_lo(b[i]); x[8 + 2 * i + 1] = bf_hi(b[i]); }
}
__device__ __forceinline__ void p_post1(const Frame& F, int l) {
    const bf16_t* P = (const bf16_t*)(F.ws + WS_P);
    unsigned char* qkv = F.ws + WS_QKV;
    for (int t = F.bx * NWAVES + F.wid; t < T; t += F.G * NWAVES) {
        const bf16_t* pr = P + (size_t)t * NINP; const int b = t / S, s = t % S, lane = F.lane;
#pragma unroll
        for (int seg = 0; seg < 9; ++seg) {
            const int mixer = seg / 3, which = seg % 3;
            const u32x4 a = *(const u32x4*)(pr + seg * 1024 + lane * 16), bb = *(const u32x4*)(pr + seg * 1024 + lane * 16 + 8);
            bf16_t* dst;
            if (mixer == 0 && which < 2) dst = (bf16_t*)(qkv + (which == 0 ? QO_QA : QO_KA)) + ((size_t)(b * 16 + (lane >> 2)) * S + s) * 64 + (lane & 3) * 16;
            else dst = (bf16_t*)(qkv + (size_t)seg * SZ_H1) + ((size_t)(b * 8 + (lane >> 3)) * S + s) * 128 + (lane & 7) * 16;
            if (which == 2) { *(u32x4*)dst = a; *(u32x4*)(dst + 8) = bb; continue; }
            float x[16]; unpack16(a, bb, x);
            float ss = 0.f;
#pragma unroll
            for (int j = 0; j < 16; ++j) ss += x[j] * x[j];
            ss += __shfl_xor(ss, 1); ss += __shfl_xor(ss, 2);
            float r; const float* g;
            if (mixer == 0) { r = rsqrtf(ss * (1.0f / 64) + EPS) * (which == 0 ? 0.125f : 1.0f); g = F.in[I_DGQK] + (l * 2 + which) * 64 + (lane & 3) * 16; }
            else { ss += __shfl_xor(ss, 4); r = rsqrtf(ss * (1.0f / 128) + EPS) * (which == 0 ? 0.08838834764831845f : 1.0f); g = F.in[mixer == 1 ? I_DILG : I_NAG] + (l * 2 + which) * 128 + (lane & 7) * 16; }
            u32x4 w0, w1;
#pragma unroll
            for (int i = 0; i < 4; ++i) { w0[i] = pk_bf16(x[2 * i] * r * g[2 * i], x[2 * i + 1] * r * g[2 * i + 1]); w1[i] = pk_bf16(x[8 + 2 * i] * r * g[8 + 2 * i], x[8 + 2 * i + 1] * r * g[8 + 2 * i + 1]); }
            *(u32x4*)dst = w0; *(u32x4*)(dst + 8) = w1;
        }
        {
            const u32x2* src = (const u32x2*)(pr + 9216 + lane * 12); u32x2 c[3]; float ss = 0.f;
#pragma unroll
            for (int i = 0; i < 3; ++i) { c[i] = src[i]; const float a0 = bf_lo(c[i].x), a1 = bf_hi(c[i].x), a2 = bf_lo(c[i].y), a3 = bf_hi(c[i].y); ss += a0 * a0 + a1 * a1 + a2 * a2 + a3 * a3; }
            ss = wsum(ss); const float r = rsqrtf(ss * (1.0f / 768) + EPS);
            u32x2* d = (u32x2*)((bf16_t*)(F.ws + WS_T2 + TO_CQ) + (size_t)t * 768 + lane * 12);
#pragma unroll
            for (int i = 0; i < 3; ++i) { u32x2 w; w.x = pk_bf16(bf_lo(c[i].x) * r, bf_hi(c[i].x) * r); w.y = pk_bf16(bf_lo(c[i].y) * r, bf_hi(c[i].y) * r); d[i] = w; }
        }
        {
            const u32x4 c = *(const u32x4*)(pr + 9984 + lane * 8); float ss = 0.f;
#pragma unroll
            for (int i = 0; i < 4; ++i) { const float a0 = bf_lo(c[i]), a1 = bf_hi(c[i]); ss += a0 * a0 + a1 * a1; }
            ss = wsum(ss); const float r = rsqrtf(ss * (1.0f / 512) + EPS);
            u32x4 w;
#pragma unroll
            for (int i = 0; i < 4; ++i) w[i] = pk_bf16(bf_lo(c[i]) * r, bf_hi(c[i]) * r);
            *(u32x4*)((bf16_t*)(F.ws + WS_T2 + TO_CKV) + (size_t)t * 512 + lane * 8) = w;
        }
    }
}

__device__ __forceinline__ void p_post2(const Frame& F, int l) {
    const bf16_t* QR = (const bf16_t*)(F.ws + WS_O + OO_QRAW); const bf16_t* KVR = (const bf16_t*)(F.ws + WS_O + OO_KVRAW); const bf16_t* P = (const bf16_t*)(F.ws + WS_P);
    bf16_t* QD = (bf16_t*)(F.ws + WS_QKV + QO_QD); bf16_t* KD = (bf16_t*)(F.ws + WS_QKV + QO_KD); bf16_t* VD = (bf16_t*)(F.ws + WS_QKV + QO_VD);
    LAS float* L = (LAS float*)F.lds + F.wid * 3712; LAS float* q = L; LAS float* kv = L + 1536; LAS float* kr = L + 3584; LAS float* cs = L + 3648;
    const float* g0 = F.in[I_MLAG] + (size_t)(l * 2 + 0) * 192; const float* g1 = F.in[I_MLAG] + (size_t)(l * 2 + 1) * 192;
    const int lane = F.lane;
    for (int t = F.bx * NWAVES + F.wid; t < T; t += F.G * NWAVES) {
        const int b = t / S, s = t % S;
#pragma unroll
        for (int i = 0; i < 3; ++i) { const int c = lane + 64 * i; const u32x4 w = *(const u32x4*)(QR + (size_t)t * 1536 + c * 8);
            *(LAS f32x4*)(q + c * 8) = (f32x4){bf_lo(w[0]), bf_hi(w[0]), bf_lo(w[1]), bf_hi(w[1])}; *(LAS f32x4*)(q + c * 8 + 4) = (f32x4){bf_lo(w[2]), bf_hi(w[2]), bf_lo(w[3]), bf_hi(w[3])}; }
#pragma unroll
        for (int i = 0; i < 4; ++i) { const int c = lane + 64 * i; const u32x4 w = *(const u32x4*)(KVR + (size_t)t * 2048 + c * 8);
            *(LAS f32x4*)(kv + c * 8) = (f32x4){bf_lo(w[0]), bf_hi(w[0]), bf_lo(w[1]), bf_hi(w[1])}; *(LAS f32x4*)(kv + c * 8 + 4) = (f32x4){bf_lo(w[2]), bf_hi(w[2]), bf_lo(w[3]), bf_hi(w[3])}; }
        kr[lane] = __uint_as_float(((unsigned)P[(size_t)t * NINP + 10496 + lane]) << 16);
        if (lane < 32) { const float inv = exp2f(-(float)lane * (2.0f / 64.0f) * 13.287712379549449f);
            float rev = (float)s * inv * 0.15915494309189535f; rev -= rintf(rev);
            cs[lane] = __builtin_amdgcn_cosf(rev); cs[32 + lane] = __builtin_amdgcn_sinf(rev); }
        asm volatile("s_waitcnt lgkmcnt(0)" ::: "memory");
        const int h = lane >> 3, part = lane & 7;
        float qss = 0.f, kss = 0.f;
#pragma unroll
        for (int j = 0; j < 24; ++j) { const float a = q[h * 192 + part + 8 * j]; qss += a * a; }
#pragma unroll
        for (int j = 0; j < 16; ++j) { const float a = kv[h * 256 + part + 8 * j]; kss += a * a; }
#pragma unroll
        for (int j = 0; j < 8; ++j) { const float a = kr[part + 8 * j]; kss += a * a; }
        qss += __shfl_xor(qss, 1); qss += __shfl_xor(qss, 2); qss += __shfl_xor(qss, 4);
        kss += __shfl_xor(kss, 1); kss += __shfl_xor(kss, 2); kss += __shfl_xor(kss, 4);
        const float rq = rsqrtf(qss * (1.0f / 192) + EPS) * 0.07216878364870322f;
        const float rk = rsqrtf(kss * (1.0f / 192) + EPS);
#pragma unroll
        for (int i = 0; i < 3; ++i) {
            const int c = lane + 64 * i, hh = c / 24, e0 = (c % 24) * 8;
            const float rqh = __shfl(rq, hh * 8), rkh = __shfl(rk, hh * 8);
            float vq[8], vk[8];
#pragma unroll
            for (int j = 0; j < 8; ++j) {
                const int e = e0 + j;
                if (e0 < 128) { vq[j] = q[hh * 192 + e] * g0[e] * rqh; vk[j] = kv[hh * 256 + e] * g1[e] * rkh; }
                else { const int i2 = (e - 128) & 31; const float co = cs[i2], si = cs[32 + i2];
                    const float q1 = q[hh * 192 + 128 + i2] * g0[128 + i2], q2 = q[hh * 192 + 160 + i2] * g0[160 + i2];
                    const float k1 = kr[i2] * g1[128 + i2], k2 = kr[32 + i2] * g1[160 + i2];
                    if (e0 < 160) { vq[j] = (q1 * co - q2 * si) * rqh; vk[j] = (k1 * co - k2 * si) * rkh; }
                    else { vq[j] = (q2 * co + q1 * si) * rqh; vk[j] = (k2 * co + k1 * si) * rkh; } }
            }
            u32x4 wq, wk;
#pragma unroll
            for (int j = 0; j < 4; ++j) { wq[j] = pk_bf16(vq[2 * j], vq[2 * j + 1]); wk[j] = pk_bf16(vk[2 * j], vk[2 * j + 1]); }
            const size_t o = ((size_t)(b * 8 + hh) * S + s) * 192 + e0;
            *(u32x4*)(QD + o) = wq; *(u32x4*)(KD + o) = wk;
        }
#pragma unroll
        for (int i = 0; i < 2; ++i) { const int c = lane + 64 * i, hh = c >> 4, e0 = (c & 15) * 8;
            *(u32x4*)(VD + ((size_t)(b * 8 + hh) * S + s) * 128 + e0) = *(const u32x4*)(KVR + (size_t)t * 2048 + hh * 256 + 128 + e0); }
        asm volatile("s_waitcnt lgkmcnt(0)" ::: "memory");
    }
}

constexpr int SHM_V = 64 * 128 * 2, SHM_KMAX = 64 * 192 * 2, ATT_WS = 2 * SHM_V + 2 * SHM_KMAX, ATT_RPB = ATT_WS + NWAVES * 64 * 4, ATT_END = ATT_RPB + 2048;
constexpr float LOG2E = 1.4426950408889634f, ATT_THR = 8.0f;
struct AP {
    const bf16_t* Q; const bf16_t* K; const bf16_t* V;
    float* O; float* lse;
    int NT;
    int dil, l0, r0, qmask, qshift;
    int lk0, jmask, jshift;
    float nslope;
};
__device__ __forceinline__ int crow(int r, int hi) { return (r & 3) + 8 * (r >> 2) + 4 * hi; }
__device__ __forceinline__ int v_st(int k, int c) { const int kk = (k & ~0xC) | ((k & 4) << 1) | ((k & 8) >> 1); return ((kk >> 3) * 4 + (c >> 5)) * 512 + ((kk & 7) * 32 + (c & 31)) * 2; }
__device__ __forceinline__ int v_rd_base(int lane) { return ((lane & 3) << 3) | (((lane >> 2) & 3) << 6) | (((lane >> 4) & 1) << 5) | (((lane >> 5) & 1) << 8); }
constexpr int v_rd_off(int d0, int ks, int half) { return d0 * 512 + ks * 4096 + half * 2048; }
template <int OFF> __device__ __forceinline__ s16x4 tr_read(int vb) { s16x4 r; asm volatile("ds_read_b64_tr_b16 %0, %1 offset:%2" : "=&v"(r) : "v"(vb), "i"(OFF) : "memory"); return r; }
template <int D0> __device__ __forceinline__ void pv_one(f32x16& od, int vb, bf16x8 pa0, bf16x8 pa1, bf16x8 pa2, bf16x8 pa3) {
    const s16x4 l0 = tr_read<v_rd_off(D0, 0, 0)>(vb), h0 = tr_read<v_rd_off(D0, 0, 1)>(vb), l1 = tr_read<v_rd_off(D0, 1, 0)>(vb), h1 = tr_read<v_rd_off(D0, 1, 1)>(vb);
    const s16x4 l2 = tr_read<v_rd_off(D0, 2, 0)>(vb), h2 = tr_read<v_rd_off(D0, 2, 1)>(vb), l3 = tr_read<v_rd_off(D0, 3, 0)>(vb), h3 = tr_read<v_rd_off(D0, 3, 1)>(vb);
    asm volatile("s_waitcnt lgkmcnt(0)" ::: "memory"); __builtin_amdgcn_sched_barrier(0);
#define MK_PK(L, H) (bf16x8){L[0], L[1], L[2], L[3], H[0], H[1], H[2], H[3]}
    od = __builtin_amdgcn_mfma_f32_32x32x16_bf16(pa0, MK_PK(l0, h0), od, 0, 0, 0);
    od = __builtin_amdgcn_mfma_f32_32x32x16_bf16(pa1, MK_PK(l1, h1), od, 0, 0, 0);
    od = __builtin_amdgcn_mfma_f32_32x32x16_bf16(pa2, MK_PK(l2, h2), od, 0, 0, 0);
    od = __builtin_amdgcn_mfma_f32_32x32x16_bf16(pa3, MK_PK(l3, h3), od, 0, 0, 0);
#undef MK_PK
}

template <int MODE, int DQK>
__device__ __forceinline__ void attn_unit(const Frame& F, const AP p) {
    constexpr int KS = DQK / 16, PITCH = DQK * 2, SHMK = 64 * PITCH, KCH = DQK / 64;
    int tid_ = F.tid; asm volatile("" : "+v"(tid_));
    const int tid = tid_, wid = F.wid, lane = tid & 63, r32 = lane & 31, hi = lane >> 5;
    LAS char* lds = (LAS char*)F.lds;
    LAS char* V_lds = lds; LAS char* K_lds = lds + 2 * SHM_V;
    LAS float* wsl = (LAS float*)(lds + ATT_WS) + wid * 64; LAS float* li_l = wsl; LAS float* al_l = wsl + 32;
    const LAS float* rpb = (const LAS float*)(lds + ATT_RPB);
    float m_reg = -1e30f, l_reg = 0.f; f32x16 o[4];
#pragma unroll
    for (int d = 0; d < 4; ++d) o[d] = f32x16{};
    const int qi = wid * 32 + r32;
    const int tq = p.dil * (p.l0 + (qi & p.qmask)) + p.r0 + (qi >> p.qshift);
    bf16x8 qr[KS];
    { const bf16_t* Qw = p.Q + (size_t)tq * DQK + hi * 8;
#pragma unroll
      for (int d0 = 0; d0 < KS; ++d0) qr[d0] = *(const bf16x8*)(Qw + d0 * 16); }
    const int sr = tid >> 4, sc = (tid & 15) * 8, vst0 = v_st(sr, sc), vst1 = v_st(32 + sr, sc);
    const int vb0 = (int)(uintptr_t)V_lds + v_rd_base(lane);
    int krow[KCH], kcol[KCH];
#pragma unroll
    for (int i = 0; i < KCH; ++i) { const int c = tid + NTHR * i; krow[i] = c / (DQK / 8); kcol[i] = c % (DQK / 8); }
    u32x4 vs0, vs1, ksr[KCH];
#define ATT_TOK(j, row) (p.dil * (p.lk0 + 64 * ((j) & p.jmask) + (row)) + p.r0 + ((j) >> p.jshift))
#define ATT_CLAMP(t) ((t) < 0 ? 0 : ((t) > S - 1 ? S - 1 : (t)))
#define ATT_SLOAD(j) do { { const int t0 = ATT_CLAMP(ATT_TOK(j, sr)), t1 = ATT_CLAMP(ATT_TOK(j, 32 + sr)); \
        vs0 = *(const u32x4*)(p.V + (size_t)t0 * 128 + sc); vs1 = *(const u32x4*)(p.V + (size_t)t1 * 128 + sc); } \
        _Pragma("unroll") for (int _i = 0; _i < KCH; ++_i) { const int tk_ = ATT_CLAMP(ATT_TOK(j, krow[_i])); ksr[_i] = *(const u32x4*)(p.K + (size_t)tk_ * DQK + kcol[_i] * 8); } } while (0)
#define ATT_SWRITE(b) do { *(LAS u32x4*)(V_lds + (b) * SHM_V + vst0) = vs0; *(LAS u32x4*)(V_lds + (b) * SHM_V + vst1) = vs1; \
        _Pragma("unroll") for (int _i = 0; _i < KCH; ++_i) *(LAS u32x4*)(K_lds + (b) * SHMK + krow[_i] * PITCH + ((kcol[_i] * 16) ^ ((krow[_i] & 7) << 4))) = ksr[_i]; } while (0)
    ATT_SLOAD(0); ATT_SWRITE(0); __syncthreads();
    int na_rq = 0, na_cq = 0, na_rs = 0, na_cs = 0;
    if (MODE == 3) { na_rq = tq >> 6; na_cq = tq & 63; na_rs = na_rq - 4; na_rs = na_rs < 0 ? 0 : (na_rs > 24 ? 24 : na_rs); na_cs = na_cq - 8; na_cs = na_cs < 0 ? 0 : (na_cs > 48 ? 48 : na_cs); }
    for (int j = 0; j < p.NT; ++j) {
        const int cur = j & 1;
        if (j + 1 < p.NT) ATT_SLOAD(j + 1);
        f32x16 p0 = f32x16{}, p1 = f32x16{};
        { const LAS char* Ks = K_lds + cur * SHMK;
#pragma unroll
          for (int d0 = 0; d0 < KS; ++d0) { const int cb = ((d0 * 16 + hi * 8) * 2) ^ ((r32 & 7) << 4);
            const bf16x8 b0 = *(const LAS bf16x8*)(Ks + r32 * PITCH + cb), b1 = *(const LAS bf16x8*)(Ks + (32 + r32) * PITCH + cb);
            p0 = __builtin_amdgcn_mfma_f32_32x32x16_bf16(b0, qr[d0], p0, 0, 0, 0);
            p1 = __builtin_amdgcn_mfma_f32_32x32x16_bf16(b1, qr[d0], p1, 0, 0, 0);
            if ((d0 & 3) == 3) __builtin_amdgcn_sched_barrier(0); } }
        const int kt0 = ATT_TOK(j, 0);
        if (MODE == 1) {
            const float base = (float)(kt0 + 4 * hi - tq);
#pragma unroll
            for (int r = 0; r < 16; ++r) { const float c = (float)((r & 3) + 8 * (r >> 2)); p0[r] = fmaf(fabsf(base + c), p.nslope, p0[r]); p1[r] = fmaf(fabsf(base + c + 32.0f), p.nslope, p1[r]); }
        }
        if (MODE == 2) {
            const int lim = 64 * p.dil, dm = p.dil - 1;
#pragma unroll
            for (int r = 0; r < 16; ++r) {
#pragma unroll
                for (int hf = 0; hf < 2; ++hf) { const int ki = crow(r, hi) + 32 * hf, tk = kt0 + ki * p.dil, d = tk - tq, ad = d < 0 ? -d : d;
                    const bool ok = ((unsigned)tk < (unsigned)S) && (ad <= lim) && ((d & dm) == 0);
                    if (hf) p1[r] = ok ? fmaf((float)ad, p.nslope, p1[r]) : -INFINITY; else p0[r] = ok ? fmaf((float)ad, p.nslope, p0[r]) : -INFINITY; } }
        }
        if (MODE == 3) {
            asm volatile("" : "+v"(na_cq), "+v"(na_cs));
            const int rk = kt0 >> 6; const bool rowok = (rk >= na_rs) && (rk < na_rs + 8); int ri = rk - na_rq + 7; ri = ri < 0 ? 0 : (ri > 14 ? 14 : ri);
#pragma unroll
            for (int r = 0; r < 16; ++r) {
#pragma unroll
                for (int hf = 0; hf < 2; ++hf) { const int ck = crow(r, hi) + 32 * hf; int ci = ck - na_cq + 15; ci = ci < 0 ? 0 : (ci > 30 ? 30 : ci);
                    const bool ok = rowok && ((unsigned)(ck - na_cs) < 16u);
                    const float bv = rpb[ri * 31 + ci];
                    if (hf) p1[r] = ok ? p1[r] + bv : -INFINITY; else p0[r] = ok ? p0[r] + bv : -INFINITY; } }
        }
        float pmax = p0[0];
#pragma unroll
        for (int r = 1; r < 16; ++r) pmax = fmaxf(pmax, p0[r]);
#pragma unroll
        for (int r = 0; r < 16; ++r) pmax = fmaxf(pmax, p1[r]);
        { auto rr = __builtin_amdgcn_permlane32_swap(__float_as_uint(pmax), __float_as_uint(pmax), false, false); pmax = fmaxf(__uint_as_float(rr[0]), __uint_as_float(rr[1])); }
        float mn, alpha;
        if (__all(pmax - m_reg <= ATT_THR)) { mn = m_reg; alpha = 1.f; }
        else { mn = fmaxf(m_reg, pmax); alpha = __builtin_amdgcn_exp2f((m_reg - mn) * LOG2E); m_reg = mn; }
        const float mnC = -mn * LOG2E;
#pragma unroll
        for (int r = 0; r < 16; ++r) { p0[r] = __builtin_amdgcn_exp2f(fmaf(p0[r], LOG2E, mnC)); p1[r] = __builtin_amdgcn_exp2f(fmaf(p1[r], LOG2E, mnC)); }
        float ps = 0.f;
#pragma unroll
        for (int r = 0; r < 16; ++r) ps += p0[r];
#pragma unroll
        for (int r = 0; r < 16; ++r) ps += p1[r];
        { auto rr = __builtin_amdgcn_permlane32_swap(__float_as_uint(ps), __float_as_uint(ps), false, false); ps = __uint_as_float(rr[0]) + __uint_as_float(rr[1]); }
        l_reg = l_reg * alpha + ps;
        bf16x8 pa0, pa1, pa2, pa3;
#define ATT_PK4(P, BASE, OUT) do { unsigned a0 = pk_bf16(P[BASE + 0], P[BASE + 1]), a1 = pk_bf16(P[BASE + 2], P[BASE + 3]); \
        unsigned b0_ = pk_bf16(P[BASE + 4], P[BASE + 5]), b1_ = pk_bf16(P[BASE + 6], P[BASE + 7]); \
        auto r0_ = __builtin_amdgcn_permlane32_swap(a0, b0_, false, false); auto r1_ = __builtin_amdgcn_permlane32_swap(a1, b1_, false, false); \
        u32x4 w_ = {r0_[0], r1_[0], r0_[1], r1_[1]}; OUT = *reinterpret_cast<bf16x8*>(&w_); } while (0)
        ATT_PK4(p0, 0, pa0); ATT_PK4(p0, 8, pa1); ATT_PK4(p1, 0, pa2); ATT_PK4(p1, 8, pa3);
#undef ATT_PK4
        if (__any(alpha < 1.f)) { if (hi == 0) al_l[r32] = alpha; asm volatile("s_waitcnt lgkmcnt(0)" ::: "memory");
#pragma unroll
            for (int d = 0; d < 4; ++d)
#pragma unroll
                for (int r = 0; r < 16; ++r) o[d][r] *= al_l[crow(r, hi)]; }
        { const int vb = vb0 + cur * SHM_V;
          pv_one<0>(o[0], vb, pa0, pa1, pa2, pa3); pv_one<1>(o[1], vb, pa0, pa1, pa2, pa3); pv_one<2>(o[2], vb, pa0, pa1, pa2, pa3); pv_one<3>(o[3], vb, pa0, pa1, pa2, pa3); }
        if (j + 1 < p.NT) ATT_SWRITE(cur ^ 1);
        __syncthreads();
    }
    if (hi == 0) li_l[r32] = l_reg;
    asm volatile("s_waitcnt lgkmcnt(0)" ::: "memory");
    if (p.lse != nullptr && hi == 0) p.lse[(size_t)tq * 8] = m_reg + __logf(l_reg);
#pragma unroll
    for (int r = 0; r < 16; ++r) { const int orow = crow(r, hi), qo = wid * 32 + orow; const int to = p.dil * (p.l0 + (qo & p.qmask)) + p.r0 + (qo >> p.qshift);
        const float lv = li_l[orow], rl = lv > 0.f ? 1.0f / lv : 0.f;
        float* orow_p = p.O + (size_t)to * 1024 + r32;
#pragma unroll
        for (int d0 = 0; d0 < 4; ++d0) orow_p[d0 * 32] = o[d0][r] * rl; }
    asm volatile("s_waitcnt lgkmcnt(0)" ::: "memory");
#undef ATT_TOK
#undef ATT_CLAMP
#undef ATT_SLOAD
#undef ATT_SWRITE
}

__device__ __forceinline__ void p_attention(const Frame& F, int l) {
    unsigned char* qkv = F.ws + WS_QKV;
    constexpr int N_MLA = 512, N_DIFF = 1024, N_NA = 512, N_D1 = 512, N_D4 = 512, N_D16 = 512, N_ALL = N_MLA + N_DIFF + N_NA + N_D1 + N_D4 + N_D16;
    for (int u = F.bx; u < N_ALL; u += F.G) {
        int v = u, cat = 0;
        if (v >= N_MLA) { v -= N_MLA; cat = 1; if (v >= N_DIFF) { v -= N_DIFF; cat = 2; if (v >= N_NA) { v -= N_NA; cat = 3; if (v >= N_D1) { v -= N_D1; cat = 4; if (v >= N_D4) { v -= N_D4; cat = 5; } } } } }
        const int w = v & 255, rnd = v >> 8, xl = w & 7, s5 = w >> 3;
        const int sub = s5 & 7;
        AP p; p.lse = nullptr; p.dil = 1; p.r0 = 0; p.qmask = 255; p.qshift = 8; p.jmask = 63; p.jshift = 6; p.nslope = 0.f; p.lk0 = 0; p.NT = 32;
        if (cat == 1) {
            const int g = xl * 16 + rnd * 4 + (s5 >> 3), b = g >> 4, hp = g & 15, h = hp >> 1, c = hp & 1;
            p.Q = (const bf16_t*)(qkv + QO_QA) + (size_t)(b * 16 + hp) * S * 64; p.K = (const bf16_t*)(qkv + QO_KA) + (size_t)(b * 16 + hp) * S * 64; p.V = (const bf16_t*)(qkv + QO_VA) + (size_t)(b * 8 + h) * S * 128;
            p.O = (float*)(F.ws + WS_P + PO_OA + (size_t)c * SZ_F1) + (size_t)b * S * 1024 + h * 128; p.l0 = sub * 256; p.nslope = -exp2f(-(float)(h + 1));
#if !defined(MK_ATT_ONLY) || MK_ATT_ONLY == 1
            attn_unit<1, 64>(F, p);
#endif
        } else {
            const int g = xl * 8 + rnd * 4 + (s5 >> 3), b = g >> 3, h = g & 7; const size_t ho = (size_t)(b * 8 + h) * S;
            if (cat == 0) {
                p.Q = (const bf16_t*)(qkv + QO_QD) + ho * 192; p.K = (const bf16_t*)(qkv + QO_KD) + ho * 192; p.V = (const bf16_t*)(qkv + QO_VD) + ho * 128;
                p.O = (float*)(F.ws + WS_T2 + TO_OD) + (size_t)b * S * 1024 + h * 128; p.l0 = sub * 256;
#if !defined(MK_ATT_ONLY) || MK_ATT_ONLY == 0
                attn_unit<0, 192>(F, p);
#endif
            } else if (cat == 2) {
                p.Q = (const bf16_t*)(qkv + QO_QC) + ho * 128; p.K = (const bf16_t*)(qkv + QO_KC) + ho * 128; p.V = (const bf16_t*)(qkv + QO_VC) + ho * 128;
                p.O = (float*)(F.ws + WS_T2 + TO_OC) + (size_t)b * S * 1024 + h * 128; p.l0 = sub * 256;
                const int R0 = sub * 4; int first = R0 - 4; first = first < 0 ? 0 : (first > 24 ? 24 : first); int lastb = R0 - 1; lastb = lastb < 0 ? 0 : (lastb > 24 ? 24 : lastb);
                p.lk0 = first * 64; p.NT = lastb + 7 - first + 1;
                { LAS float* rp = (LAS float*)(F.lds + ATT_RPB); const float* src = F.in[I_RPB] + (size_t)(l * 8 + h) * 465; for (int i = F.tid; i < 465; i += NTHR) rp[i] = src[i]; }
#if !defined(MK_ATT_ONLY) || MK_ATT_ONLY == 3
                attn_unit<3, 128>(F, p);
#endif
            } else {
                const int br = cat - 3;
                p.Q = (const bf16_t*)(qkv + QO_QB) + ho * 128; p.K = (const bf16_t*)(qkv + QO_KB) + ho * 128; p.V = (const bf16_t*)(qkv + QO_VB) + ho * 128;
                p.O = (float*)(F.ws + WS_P + PO_OB + (size_t)br * SZ_F1) + (size_t)b * S * 1024 + h * 128;
                p.lse = (float*)(F.ws + WS_P + PO_LSE) + (size_t)br * T * 8 + (size_t)b * S * 8 + h; p.nslope = -exp2f(-(float)(h + 1));
                if (br == 0) { p.dil = 1; p.l0 = sub * 256; p.lk0 = p.l0 - 64; p.NT = 6; }
                else if (br == 1) { p.dil = 4; p.r0 = sub >> 1; p.l0 = (sub & 1) * 256; p.lk0 = p.l0 - 64; p.NT = 6; }
                else { p.dil = 16; p.r0 = sub * 2; p.l0 = 0; p.qmask = 127; p.qshift = 7; p.lk0 = 0; p.jmask = 1; p.jshift = 1; p.NT = 4; }
#if !defined(MK_ATT_ONLY) || MK_ATT_ONLY == 2
                attn_unit<2, 128>(F, p);
#endif
            }
        }
    }
}

__device__ __forceinline__ void p_post3(const Frame& F, int l) {
    const float* OA0 = (const float*)(F.ws + WS_P + PO_OA); const float* OA1 = OA0 + (size_t)T * 1024; const float* OB = (const float*)(F.ws + WS_P + PO_OB);
    const float* LSE = (const float*)(F.ws + WS_P + PO_LSE); const float* OC = (const float*)(F.ws + WS_T2 + TO_OC); const float* OD = (const float*)(F.ws + WS_T2 + TO_OD);
    bf16_t* O = (bf16_t*)(F.ws + WS_O);
    const int lane = F.lane;
    const float* lv = F.in[I_DLAM] + l * 4 * 64;
    const float s01 = wsum(lv[lane] * lv[64 + lane]), s23 = wsum(lv[128 + lane] * lv[192 + lane]);
    const float lam_init = 0.8f - 0.6f * expf(-0.3f * (float)l), lam = expf(s01) - expf(s23) + lam_init;
    const float* gout = F.in[I_DGOUT] + l * 128 + (lane & 7) * 16;
    for (int t = F.bx * NWAVES + F.wid; t < T; t += F.G * NWAVES) {
        const size_t ro = (size_t)t * 1024 + lane * 16; bf16_t* orow = O + (size_t)t * DM + lane * 16;
        {
            float d[16]; float ss = 0.f;
#pragma unroll
            for (int i = 0; i < 4; ++i) { const f32x4 a = *(const f32x4*)(OA0 + ro + 4 * i), b = *(const f32x4*)(OA1 + ro + 4 * i);
#pragma unroll
                for (int j = 0; j < 4; ++j) { d[4 * i + j] = a[j] - lam * b[j]; ss += d[4 * i + j] * d[4 * i + j]; } }
            ss += __shfl_xor(ss, 1); ss += __shfl_xor(ss, 2); ss += __shfl_xor(ss, 4);
            const float r = rsqrtf(ss * (1.0f / 128) + EPS) * (1.0f - lam_init);
            u32x4 w0, w1;
#pragma unroll
            for (int i = 0; i < 4; ++i) { w0[i] = pk_bf16(d[2 * i] * r * gout[2 * i], d[2 * i + 1] * r * gout[2 * i + 1]); w1[i] = pk_bf16(d[8 + 2 * i] * r * gout[8 + 2 * i], d[8 + 2 * i + 1] * r * gout[8 + 2 * i + 1]); }
            *(u32x4*)orow = w0; *(u32x4*)(orow + 8) = w1;
        }
        {
            const int h = lane >> 3; const float e0 = LSE[(size_t)t * 8 + h], e1 = LSE[(size_t)T * 8 + (size_t)t * 8 + h], e2 = LSE[(size_t)2 * T * 8 + (size_t)t * 8 + h];
            const float m = fmaxf(e0, fmaxf(e1, e2)); float w0 = __expf(e0 - m), w1 = __expf(e1 - m), w2 = __expf(e2 - m); const float inv = 1.0f / (w0 + w1 + w2); w0 *= inv; w1 *= inv; w2 *= inv;
            float d[16];
#pragma unroll
            for (int i = 0; i < 4; ++i) { const f32x4 a = *(const f32x4*)(OB + ro + 4 * i), b = *(const f32x4*)(OB + (size_t)T * 1024 + ro + 4 * i), c = *(const f32x4*)(OB + (size_t)2 * T * 1024 + ro + 4 * i);
#pragma unroll
                for (int j = 0; j < 4; ++j) d[4 * i + j] = w0 * a[j] + w1 * b[j] + w2 * c[j]; }
            u32x4 x0, x1;
#pragma unroll
            for (int i = 0; i < 4; ++i) { x0[i] = pk_bf16(d[2 * i], d[2 * i + 1]); x1[i] = pk_bf16(d[8 + 2 * i], d[8 + 2 * i + 1]); }
            *(u32x4*)(orow + 1024) = x0; *(u32x4*)(orow + 1024 + 8) = x1;
        }
#pragma unroll
        for (int mx = 0; mx < 2; ++mx) {
            const float* src = (mx == 0 ? OC : OD) + ro; float d[16];
#pragma unroll
            for (int i = 0; i < 4; ++i) { const f32x4 a = *(const f32x4*)(src + 4 * i); d[4 * i] = a[0]; d[4 * i + 1] = a[1]; d[4 * i + 2] = a[2]; d[4 * i + 3] = a[3]; }
            u32x4 x0, x1;
#pragma unroll
            for (int i = 0; i < 4; ++i) { x0[i] = pk_bf16(d[2 * i], d[2 * i + 1]); x1[i] = pk_bf16(d[8 + 2 * i], d[8 + 2 * i + 1]); }
            *(u32x4*)(orow + 2048 + mx * 1024) = x0; *(u32x4*)(orow + 2048 + mx * 1024 + 8) = x1;
        }
    }
}

__device__ __forceinline__ int med3i(int a, int b, int c) { return max(min(a, b), min(max(a, b), c)); }
__device__ __forceinline__ int ordkey(float v) { const int x = __float_as_int(v); return x ^ ((x >> 31) & 0x7fffffff); }
#define MK_INSERT(L, key) do { _Pragma("unroll") for (int _k = 15; _k >= 1; --_k) L[_k] = med3i((key), L[_k - 1], L[_k]); L[0] = max((key), L[0]); } while (0)
__device__ __forceinline__ void p_select(const Frame& F) {
    const float* SC = (const float*)(F.ws + WS_P + PO_SC); int* EX = (int*)(F.ws + WS_P + PO_EXP); float* GT = (float*)(F.ws + WS_P + PO_GATE);
    LAS float* L = (LAS float*)F.lds;
    const int tid = F.tid;
    for (int blk = F.bx * NWAVES + F.wid; blk < T * 8 / 64; blk += F.G * NWAVES) {
        const int pid = blk * 64 + F.lane, t = pid >> 3, h = pid & 7;
        const float* sc = SC + (size_t)t * 2048 + h * 256;
        float fa[16], fb[16];
#pragma unroll
        for (int c = 0; c < 2; ++c) {
            int Lk[16];
#pragma unroll
            for (int k = 0; k < 16; ++k) Lk[k] = (int)0x80000000;
            for (int n4 = 0; n4 < 32; ++n4) { const f32x4 v = *(const f32x4*)(sc + c * 128 + n4 * 4);
#pragma unroll
                for (int e = 0; e < 4; ++e) { const int key = (ordkey(v[e]) & ~127) | (n4 * 4 + e); MK_INSERT(Lk, key); } }
#pragma unroll
            for (int k = 0; k < 16; ++k) { const int idx = Lk[k] & 127; const float val = sc[c * 128 + idx];
                if (c == 0) fa[k] = val; else fb[k] = val;
                L[(c * 32 + k) * NTHR + tid] = val; L[(c * 32 + 16 + k) * NTHR + tid] = __int_as_float(idx); }
        }
        int Mk[16];
#pragma unroll
        for (int k = 0; k < 16; ++k) Mk[k] = (int)0x80000000;
#pragma unroll
        for (int i = 0; i < 16; ++i)
#pragma unroll
            for (int j = 0; j < 16; ++j) if ((i + 1) * (j + 1) <= 16) { const int key = (ordkey(fa[i] + fb[j]) & ~255) | (i * 16 + j); MK_INSERT(Mk, key); }
        asm volatile("s_waitcnt lgkmcnt(0)" ::: "memory");
        float sk[16]; int ek[16]; float mx = -INFINITY;
#pragma unroll
        for (int k = 0; k < 16; ++k) { const int code = Mk[k] & 255, i = code >> 4, j = code & 15;
            sk[k] = L[i * NTHR + tid] + L[(32 + j) * NTHR + tid];
            ek[k] = __float_as_int(L[(16 + i) * NTHR + tid]) * 128 + __float_as_int(L[(48 + j) * NTHR + tid]); mx = fmaxf(mx, sk[k]); }
        float sum = 0.f;
#pragma unroll
        for (int k = 0; k < 16; ++k) { sk[k] = __expf(sk[k] - mx); sum += sk[k]; }
        const float inv = 1.0f / sum;
#pragma unroll
        for (int k = 0; k < 4; ++k) { *(int4*)(EX + (size_t)t * 128 + h * 16 + 4 * k) = make_int4(ek[4 * k], ek[4 * k + 1], ek[4 * k + 2], ek[4 * k + 3]);
            *(f32x4*)(GT + (size_t)t * 128 + h * 16 + 4 * k) = (f32x4){sk[4 * k] * inv, sk[4 * k + 1] * inv, sk[4 * k + 2] * inv, sk[4 * k + 3] * inv}; }
        asm volatile("s_waitcnt lgkmcnt(0)" ::: "memory");
    }
}

__device__ __forceinline__ void p_gather(const Frame& F, int l) {
    const bf16_t* HN = (const bf16_t*)(F.ws + WS_HN); const int* EX = (const int*)(F.ws + WS_P + PO_EXP); const float* GT = (const float*)(F.ws + WS_P + PO_GATE);
    const bf16_t* U = (const bf16_t*)(F.ws + WS_W + (size_t)l * LW_END + LW_U); const bf16_t* V = (const bf16_t*)(F.ws + WS_W + (size_t)l * LW_END + LW_V);
    const int lane = F.lane;
    for (int t = F.bx * NWAVES + F.wid; t < T; t += F.G * NWAVES) {
        u32x4 hv[8];
#pragma unroll
        for (int c = 0; c < 8; ++c) hv[c] = *(const u32x4*)(HN + (size_t)t * DM + (c * 64 + lane) * 8);
        const int e0 = EX[(size_t)t * 128 + lane], e1 = EX[(size_t)t * 128 + 64 + lane]; const float g0 = GT[(size_t)t * 128 + lane], g1 = GT[(size_t)t * 128 + 64 + lane];
        float acc[64];
#pragma unroll
        for (int i = 0; i < 64; ++i) acc[i] = 0.f;
        for (int i = 0; i < 128; ++i) {
            const int e = __builtin_amdgcn_readlane(i < 64 ? e0 : e1, i & 63); const float g = __int_as_float(__builtin_amdgcn_readlane(__float_as_int(i < 64 ? g0 : g1), i & 63));
            const bf16_t* ur = U + (size_t)e * DM + lane * 8; const bf16_t* vr = V + (size_t)e * DM + lane * 8;
            u32x4 uu[8], vv[8];
#pragma unroll
            for (int c = 0; c < 8; ++c) uu[c] = *(const u32x4*)(ur + c * 512);
#pragma unroll
            for (int c = 0; c < 8; ++c) vv[c] = *(const u32x4*)(vr + c * 512);
            float z = 0.f;
#pragma unroll
            for (int c = 0; c < 8; ++c)
#pragma unroll
                for (int k = 0; k < 4; ++k) { const unsigned a = uu[c][k], b = hv[c][k]; z = __builtin_amdgcn_fdot2_f32_bf16(*(const bf2*)&a, *(const bf2*)&b, z, false); }
            z = wsum(z);
            const float w = g * 0.5f * z * (1.0f + erff(z * 0.7071067811865476f));
#pragma unroll
            for (int c = 0; c < 8; ++c)
#pragma unroll
                for (int k = 0; k < 4; ++k) { acc[c * 8 + 2 * k] = fmaf(w, bf_lo(vv[c][k]), acc[c * 8 + 2 * k]); acc[c * 8 + 2 * k + 1] = fmaf(w, bf_hi(vv[c][k]), acc[c * 8 + 2 * k + 1]); }
        }
        float* xr = F.out + (size_t)t * DM;
#pragma unroll
        for (int c = 0; c < 8; ++c) { f32x4* pp = (f32x4*)(xr + (c * 64 + lane) * 8); f32x4 a = pp[0], b = pp[1];
            a[0] += acc[c * 8 + 0]; a[1] += acc[c * 8 + 1]; a[2] += acc[c * 8 + 2]; a[3] += acc[c * 8 + 3]; b[0] += acc[c * 8 + 4]; b[1] += acc[c * 8 + 5]; b[2] += acc[c * 8 + 6]; b[3] += acc[c * 8 + 7];
            pp[0] = a; pp[1] = b; }
    }
}

constexpr int N_PHASES = 25;
__global__ void __launch_bounds__(NTHR, 2) mk_fwd(Args args) {
    extern __shared__ __attribute__((aligned(16))) unsigned char lds_raw[];
    Frame F;
#pragma unroll
    for (int i = 0; i < 20; ++i) F.in[i] = args.in[i];
    F.out = args.out; F.ws = args.ws; F.lds = (LAS unsigned char*)lds_raw;
    F.tid = threadIdx.x; F.lane = F.tid & 63; F.wid = __builtin_amdgcn_readfirstlane(F.tid >> 6); F.G = gridDim.x; F.bx = blockIdx.x;
    const int lo = args.ph_lo, hi = args.ph_hi;
    XcdBarrier bar; bar.bar = (unsigned*)(F.ws + WS_CTL); bar.x = 0; bar.st = nullptr;
    if (hi - lo > 1) {
        if (F.tid == 0) *(LAS u32x4*)(F.lds + LDS_XB) = (u32x4){0u, 0u, 0u, 0u};
        __syncthreads();
        bar = xcd_barrier_post((unsigned*)(F.ws + WS_CTL), (volatile LAS unsigned*)(F.lds + LDS_XB));
    }
#ifndef MK_ONLY
#define MK_ONLY -1
#endif
#define MK_IN(k) (lo <= (k) && (k) < hi)
#define MK_EN(s) (MK_ONLY < 0 || MK_ONLY == (s))
#define MK_FRESH() do { int t_ = threadIdx.x; asm volatile("" : "+v"(t_)); F.tid = t_; F.lane = t_ & 63; F.wid = __builtin_amdgcn_readfirstlane(t_ >> 6); } while (0)
#define MK_SEAM(k) do { if (MK_IN(k) && MK_IN((k) + 1)) xcd_barrier(bar); } while (0)
    if (MK_EN(100) && MK_IN(0)) { MK_FRESH(); p0_prologue(F); }
    MK_SEAM(0);
    for (int l = 0; l < 2; ++l) {
        const int pb = 1 + 12 * l;
        unsigned char* lw = F.ws + WS_W + (size_t)l * LW_END;
        const float* xin = (l == 0) ? F.in[I_X] : F.out;
        if (MK_EN(0) && MK_IN(pb + 0)) { MK_FRESH(); } if (MK_EN(0) && MK_IN(pb + 0)) p_norm(F, xin, (bf16_t*)(F.ws + WS_HN));
        MK_SEAM(pb + 0);
        if (MK_EN(1) && MK_IN(pb + 1)) { pg8::Gemm g{(const bf16_t*)(F.ws + WS_HN), (const bf16_t*)(lw + LW_WIN), T, NINP, DM}; pg8::StaticOrder So; So.init(T, NINP, F.G, F.bx);
            pg8::EpiBf16P E{(bf16_t*)(F.ws + WS_P), NINP}; pg8::gemm_phase<pg8::EpiBf16P, pg8::StaticOrder>(F.lds, g, So, E, nullptr); }
        MK_SEAM(pb + 1);
        if (MK_EN(2) && MK_IN(pb + 2)) { MK_FRESH(); } if (MK_EN(2) && MK_IN(pb + 2)) p_post1(F, l);
        MK_SEAM(pb + 2);
        if (MK_EN(3) && MK_IN(pb + 3)) {
            for (int gi = 0; gi < 2; ++gi) {
                pg8::Gemm g{(const bf16_t*)(F.ws + WS_T2 + (gi ? TO_CKV : TO_CQ)), (const bf16_t*)(lw + (gi ? LW_WUKV : LW_WUQ)), T, gi ? 2048 : 1536, gi ? 512 : 768}; pg8::StaticOrder So; So.init(T, g.N, F.G, F.bx);
                pg8::EpiBf16P E{(bf16_t*)(F.ws + WS_O + (gi ? OO_KVRAW : OO_QRAW)), g.N}; pg8::gemm_phase<pg8::EpiBf16P, pg8::StaticOrder>(F.lds, g, So, E, nullptr);
                __syncthreads();
            }
        }
        MK_SEAM(pb + 3);
        if (MK_EN(4) && MK_IN(pb + 4)) { MK_FRESH(); } if (MK_EN(4) && MK_IN(pb + 4)) p_post2(F, l);
        MK_SEAM(pb + 4);
        if (MK_EN(5) && MK_IN(pb + 5)) { MK_FRESH(); } if (MK_EN(5) && MK_IN(pb + 5)) p_attention(F, l);
        MK_SEAM(pb + 5);
        if (MK_EN(6) && MK_IN(pb + 6)) { MK_FRESH(); } if (MK_EN(6) && MK_IN(pb + 6)) p_post3(F, l);
        MK_SEAM(pb + 6);
        if (MK_EN(7) && MK_IN(pb + 7)) { pg8::Gemm g{(const bf16_t*)(F.ws + WS_O), (const bf16_t*)(lw + LW_WOUT), T, DM, DM}; pg8::StaticOrder So; So.init(T, DM, F.G, F.bx);
            pg8::EpiResF32 E{xin, F.out, DM}; pg8::gemm_phase<pg8::EpiResF32, pg8::StaticOrder>(F.lds, g, So, E, nullptr); }
        MK_SEAM(pb + 7);
        if (MK_EN(8) && MK_IN(pb + 8)) { MK_FRESH(); } if (MK_EN(8) && MK_IN(pb + 8)) p_norm(F, F.out, (bf16_t*)(F.ws + WS_HN));
        MK_SEAM(pb + 8);
        if (MK_EN(9) && MK_IN(pb + 9)) { pg8::Gemm g{(const bf16_t*)(F.ws + WS_HN), (const bf16_t*)(lw + LW_W2), T, 2048, DM}; pg8::StaticOrder So; So.init(T, 2048, F.G, F.bx);
            pg8::EpiF32 E{(float*)(F.ws + WS_P + PO_SC), 2048, nullptr}; pg8::gemm_phase<pg8::EpiF32, pg8::StaticOrder>(F.lds, g, So, E, nullptr); }
        MK_SEAM(pb + 9);
        if (MK_EN(10) && MK_IN(pb + 10)) { MK_FRESH(); } if (MK_EN(10) && MK_IN(pb + 10)) p_select(F);
        MK_SEAM(pb + 10);
        if (MK_EN(11) && MK_IN(pb + 11)) { MK_FRESH(); } if (MK_EN(11) && MK_IN(pb + 11)) p_gather(F, l);
        MK_SEAM(pb + 11);
    }
#undef MK_IN
#undef MK_SEAM
}
}

#ifndef MK_N_LAUNCH_MODE
#define MK_N_LAUNCH_MODE 0
#endif
extern "C" void kernel_launch(void* const* d_in, const int* in_sizes, int n_in, void* d_out, int out_size, void* d_ws, size_t ws_size, hipStream_t stream) {
    static int grid = 0;
    if (grid == 0) {
        if (n_in != 20 || out_size != mk::T * mk::DM || ws_size < mk::WS_END) { fprintf(stderr, "kernel_launch: unexpected shapes (n_in %d out %d ws %zu, need %zu)\n", n_in, out_size, ws_size, (size_t)mk::WS_END); grid = -1; return; }
        int dev = 0, cus = 0, per_cu = 0;
        if (hipGetDevice(&dev) != hipSuccess || hipDeviceGetAttribute(&cus, hipDeviceAttributeMultiprocessorCount, dev) != hipSuccess) { grid = -1; return; }
        if (hipFuncSetAttribute((const void*)mk::mk_fwd, hipFuncAttributeMaxDynamicSharedMemorySize, mk::LDS_BYTES) != hipSuccess) { fprintf(stderr, "kernel_launch: hipFuncSetAttribute failed\n"); grid = -1; return; }
        if (hipOccupancyMaxActiveBlocksPerMultiprocessor(&per_cu, (const void*)mk::mk_fwd, mk::NTHR, mk::LDS_BYTES) != hipSuccess || per_cu < 1) { fprintf(stderr, "kernel_launch: occupancy query says %d\n", per_cu); }
        (void)hipGetLastError();
        grid = cus;
    }
    if (grid < 0) return;
    (void)hipMemsetAsync((char*)d_ws + mk::WS_CTL, 0, 65536, stream);
    mk::Args a{};
    for (int i = 0; i < 20; ++i) a.in[i] = (const float*)d_in[i];
    a.out = (float*)d_out; a.ws = (unsigned char*)d_ws;
#if MK_N_LAUNCH_MODE == 1
    a.ph_lo = 0; a.ph_hi = mk::N_PHASES;
    hipLaunchKernelGGL(mk::mk_fwd, dim3(grid), dim3(mk::NTHR), mk::LDS_BYTES, stream, a);
#else
    for (int ph = 0; ph < mk::N_PHASES; ++ph) { a.ph_lo = ph; a.ph_hi = ph + 1; hipLaunchKernelGGL(mk::mk_fwd, dim3(grid), dim3(mk::NTHR), mk::LDS_BYTES, stream, a); }
#endif
    const hipError_t le = hipPeekAtLastError();
    if (le != hipSuccess) fprintf(stderr, "kernel_launch: launch failed: %s\n", hipGetErrorName(le));
}
```

```cpp
#include <hip/hip_runtime.h>
#include <cstdio>
#include <cstdint>
#include <cstddef>
namespace pg8 {
#define PG8_LAS __attribute__((address_space(3)))
typedef unsigned short bf16_t;
typedef short bf16x8 __attribute__((ext_vector_type(8)));
typedef float f32x4 __attribute__((ext_vector_type(4)));
typedef unsigned u32x4 __attribute__((ext_vector_type(4)));
typedef int i32x8 __attribute__((ext_vector_type(8)));
typedef int i32x4 __attribute__((ext_vector_type(4)));
typedef int i32x16 __attribute__((ext_vector_type(16)));
typedef int i32x32 __attribute__((ext_vector_type(32)));
typedef float f32x32 __attribute__((ext_vector_type(32)));
constexpr int BM = 256, BK = 64, HALF = 128, HTB = HALF * BK * 2  , STAGE_BYTES = 8 * HTB, NXCD = 8, WGM = 8;

__host__ __device__ __forceinline__ int lds_byte(int r, int c) { const int st = (r >> 4) * 2 + (c >> 5), rr = r & 15, cc = c & 31, ob = rr * 64 + cc * 2; return st * 1024 + (ob ^ (((ob >> 9) & 1) << 5)); }
__host__ __device__ __forceinline__ void stage_rc(int b, int& R, int& C) { const int st = b / 1024, sb = b % 1024, swz = sb ^ (((sb >> 9) & 1) << 5); R = (st >> 1) * 16 + swz / 64; C = (st & 1) * 32 + (swz % 64) / 2; }
__host__ __device__ __forceinline__ int perm32(int rho) { const int n = rho >> 4, i = rho & 15; return 8 * (i >> 2) + 4 * n + (i & 3); }

struct Unit { int pm, pn; };
struct Gemm { const bf16_t* A; const bf16_t* Bt; int M, N, K; int lda = 0; };

struct StaticOrder {
    int nM, nN, nwg, G, c;
    __host__ __device__ void init(int M, int N, int G_, int c_) { nM = M / BM; nN = N / BM; nwg = nM * nN; G = G_; c = c_; }
    __host__ __device__ bool next(int i, Unit& u) const {
        const long L = (long)i * G + c; if (L >= nwg) return false;
        int wgid = (int)L; { const int q = nwg / NXCD, r = nwg % NXCD, xcd = wgid % NXCD, off = wgid / NXCD; wgid = (xcd < r ? xcd * (q + 1) : r * (q + 1) + (xcd - r) * q) + off; }
        const int nig = WGM * nN, gid = wgid / nig, fm = gid * WGM, gsz = (nM - fm) < WGM ? (nM - fm) : WGM;
        u.pm = fm + ((wgid % nig) % gsz); u.pn = (wgid % nig) / gsz; return true;
    }
    __device__ __forceinline__ void a_ready(const Unit&) const {}
    __device__ __forceinline__ void done(const Unit&) const {}
};
__device__ __forceinline__ unsigned cvt_pk_bf16(float lo, float hi) { unsigned r; asm volatile("v_cvt_pk_bf16_f32 %0, %1, %2" : "=v"(r) : "v"(lo), "v"(hi)); return r; }
typedef float f32x2 __attribute__((ext_vector_type(2)));
struct EpiF32 {
    static constexpr bool PERM = false, AFTER_DRAIN = false;
    float* C; int ldc; const float* bias;
    __device__ __forceinline__ void operator()(const f32x4 (&acc)[2][2][4][2], const Unit& u, int wr, int wc, int fr, int fq) const {
        const int row0 = u.pm * BM + wr * 64 + fr, col0 = u.pn * BM + wc * 32 + 4 * fq;
        f32x4 bv[2][2];
#pragma unroll
        for (int bj = 0; bj < 2; ++bj)
#pragma unroll
            for (int n = 0; n < 2; ++n) bv[bj][n] = bias ? *(const f32x4*)(bias + col0 + bj * HALF + n * 16) : (f32x4){0.f, 0.f, 0.f, 0.f};
#pragma unroll
        for (int ai = 0; ai < 2; ++ai)
#pragma unroll
            for (int m = 0; m < 4; ++m) { float* rowp = C + (size_t)(row0 + ai * HALF + m * 16) * ldc + col0;
#pragma unroll
                for (int bj = 0; bj < 2; ++bj)
#pragma unroll
                    for (int n = 0; n < 2; ++n) *(f32x4*)(rowp + bj * HALF + n * 16) = acc[ai][bj][m][n] + bv[bj][n]; }
    }
};
struct EpiBf16P {
    static constexpr bool PERM = true, AFTER_DRAIN = false;
    bf16_t* O; int ldc;
    __device__ __forceinline__ void operator()(const f32x4 (&acc)[2][2][4][2], const Unit& u, int wr, int wc, int fr, int fq) const {
        const int row0 = u.pm * BM + wr * 64 + fr, col0 = u.pn * BM + wc * 32 + 8 * fq;
#pragma unroll
        for (int ai = 0; ai < 2; ++ai)
#pragma unroll
            for (int m = 0; m < 4; ++m) { bf16_t* rowp = O + (size_t)(row0 + ai * HALF + m * 16) * ldc + col0;
#pragma unroll
                for (int bj = 0; bj < 2; ++bj) { const f32x4 v0 = acc[ai][bj][m][0], v1 = acc[ai][bj][m][1];
                    u32x4 w; w.x = cvt_pk_bf16(v0[0], v0[1]); w.y = cvt_pk_bf16(v0[2], v0[3]); w.z = cvt_pk_bf16(v1[0], v1[1]); w.w = cvt_pk_bf16(v1[2], v1[3]);
                    *(u32x4*)(rowp + bj * HALF) = w; } }
    }
};
struct EpiResF32 {
    static constexpr bool PERM = false, AFTER_DRAIN = false;
    const float* res; float* out; int ldc;
    __device__ __forceinline__ void operator()(const f32x4 (&acc)[2][2][4][2], const Unit& u, int wr, int wc, int fr, int fq) const {
        const int row0 = u.pm * BM + wr * 64 + fr, col0 = u.pn * BM + wc * 32 + 4 * fq;
#pragma unroll
        for (int ai = 0; ai < 2; ++ai)
#pragma unroll
            for (int m = 0; m < 4; ++m) { const size_t off = (size_t)(row0 + ai * HALF + m * 16) * ldc + col0;
#pragma unroll
                for (int bj = 0; bj < 2; ++bj)
#pragma unroll
                    for (int n = 0; n < 2; ++n) { const size_t o = off + bj * HALF + n * 16; const f32x4 r = *(const f32x4*)(res + o); *(f32x4*)(out + o) = r + acc[ai][bj][m][n]; } }
    }
};

struct EpiG1 {
    static constexpr bool PERM = true, AFTER_DRAIN = false;
    bf16_t* O; int ldc; bf16_t* vseg;
    size_t vstride; float oscale;
    __device__ __forceinline__ void operator()(const f32x4 (&acc)[2][2][4][2], const Unit& u, int wr, int wc, int fr, int fq) const {
        const int row0 = u.pm * BM + wr * 64 + fr, colt = u.pn * BM, seg = colt >> 10;
        const bool isv = (seg == 2) || (seg == 5) || (seg == 8);
#pragma unroll
        for (int ai = 0; ai < 2; ++ai)
#pragma unroll
            for (int m = 0; m < 4; ++m) { const int row = row0 + ai * HALF + m * 16;
#pragma unroll
                for (int bj = 0; bj < 2; ++bj) { const f32x4 v0 = acc[ai][bj][m][0] * oscale, v1 = acc[ai][bj][m][1] * oscale;
                    u32x4 w; w.x = cvt_pk_bf16(v0[0], v0[1]); w.y = cvt_pk_bf16(v0[2], v0[3]); w.z = cvt_pk_bf16(v1[0], v1[1]); w.w = cvt_pk_bf16(v1[2], v1[3]);
                    bf16_t* dst;
                    if (isv) { const int h = ((colt & 1023) >> 7) + bj; dst = vseg + (size_t)seg * vstride + ((size_t)((row >> 11) * 8 + h) * 2048 + (row & 2047)) * 128 + wc * 32 + 8 * fq; }
                    else dst = O + (size_t)row * ldc + colt + bj * HALF + wc * 32 + 8 * fq;
                    *(u32x4*)dst = w; } }
    }
};
struct EpiResF32N {
    static constexpr bool PERM = false, AFTER_DRAIN = false;
    const float* res; float* out; int ldc; bf16_t* xb; float oscale;
    __device__ __forceinline__ void operator()(const f32x4 (&acc)[2][2][4][2], const Unit& u, int wr, int wc, int fr, int fq) const {
        asm volatile("" : "+v"(fr), "+v"(fq));
        const int row0 = u.pm * BM + wr * 64 + fr, col0 = u.pn * BM + wc * 32 + 4 * fq;
        typedef unsigned u32x2e __attribute__((ext_vector_type(2)));
#pragma unroll
        for (int ai = 0; ai < 2; ++ai) { f32x4 r[4][2][2];
#pragma unroll
            for (int m = 0; m < 4; ++m)
#pragma unroll
                for (int bj = 0; bj < 2; ++bj)
#pragma unroll
                    for (int n = 0; n < 2; ++n) r[m][bj][n] = *(const f32x4*)(res + (size_t)(row0 + ai * HALF + m * 16) * ldc + col0 + bj * HALF + n * 16);
            asm volatile("" ::: "memory");
#pragma unroll
            for (int m = 0; m < 4; ++m)
#pragma unroll
                for (int bj = 0; bj < 2; ++bj)
#pragma unroll
                    for (int n = 0; n < 2; ++n) { const size_t o = (size_t)(row0 + ai * HALF + m * 16) * ldc + col0 + bj * HALF + n * 16;
                        const f32x4 v = r[m][bj][n] + acc[ai][bj][m][n] * oscale; *(f32x4*)(out + o) = v;
                        u32x2e w; w.x = cvt_pk_bf16(v[0], v[1]); w.y = cvt_pk_bf16(v[2], v[3]); *(u32x2e*)(xb + o) = w; }
            asm volatile("" ::: "memory"); }
    }
};

struct EpiG1N {
    static constexpr bool PERM = true, AFTER_DRAIN = false;
    bf16_t* O; int ldc; bf16_t* qkv;
    size_t vstride; float oscale; const float* gA; const float* gB; const float* gC;
    PG8_LAS float* X;
    __device__ __forceinline__ void operator()(const f32x4 (&acc)[2][2][4][2], const Unit& u, int wr, int wc, int fr, int fq) const {
        asm volatile("" : "+v"(fr), "+v"(fq));
        const int row0 = u.pm * BM + wr * 64 + fr, colt = u.pn * BM, seg = colt >> 10, which = seg % 3, mixer = seg / 3;
        if (seg >= 9 || which == 2) {
#pragma unroll
            for (int ai = 0; ai < 2; ++ai)
#pragma unroll
                for (int m = 0; m < 4; ++m) { const int row = row0 + ai * HALF + m * 16;
#pragma unroll
                    for (int bj = 0; bj < 2; ++bj) { const f32x4 v0 = acc[ai][bj][m][0] * oscale, v1 = acc[ai][bj][m][1] * oscale;
                        u32x4 w; w.x = cvt_pk_bf16(v0[0], v0[1]); w.y = cvt_pk_bf16(v0[2], v0[3]); w.z = cvt_pk_bf16(v1[0], v1[1]); w.w = cvt_pk_bf16(v1[2], v1[3]);
                        bf16_t* dst;
                        if (seg < 9) { const int h = ((colt & 1023) >> 7) + bj; dst = qkv + (size_t)seg * vstride + ((size_t)((row >> 11) * 8 + h) * 2048 + (row & 2047)) * 128 + wc * 32 + 8 * fq; }
                        else dst = O + (size_t)row * ldc + colt + bj * HALF + wc * 32 + 8 * fq;
                        *(u32x4*)dst = w; } }
            return;
        }
        const int lane = fr + 16 * fq;
        float ss[2][4][2];
#pragma unroll
        for (int ai = 0; ai < 2; ++ai)
#pragma unroll
            for (int m = 0; m < 4; ++m)
#pragma unroll
                for (int bj = 0; bj < 2; ++bj) { const f32x4 v0 = acc[ai][bj][m][0] * oscale, v1 = acc[ai][bj][m][1] * oscale;
                    float s = (v0[0] * v0[0] + v0[1] * v0[1]) + (v0[2] * v0[2] + v0[3] * v0[3]) + (v1[0] * v1[0] + v1[1] * v1[1]) + (v1[2] * v1[2] + v1[3] * v1[3]);
                    s += __int_as_float(__builtin_amdgcn_ds_bpermute((lane ^ 16) << 2, __float_as_int(s)));
                    s += __int_as_float(__builtin_amdgcn_ds_bpermute((lane ^ 32) << 2, __float_as_int(s)));
                    ss[ai][m][bj] = s; }
        if (fq == 0) {
#pragma unroll
            for (int ai = 0; ai < 2; ++ai)
#pragma unroll
                for (int m = 0; m < 4; ++m)
#pragma unroll
                    for (int bj = 0; bj < 2; ++bj) X[(((wr * 128) + ai * 64 + m * 16 + fr) * 2 + bj) * 4 + wc] = ss[ai][m][bj]; }
        asm volatile("s_waitcnt lgkmcnt(0)" ::: "memory"); __builtin_amdgcn_s_barrier(); asm volatile("" ::: "memory");
        const float* g = (mixer == 0 ? gA + which * 64 + (wc & 1) * 32 : (mixer == 1 ? gB : gC) + which * 128 + wc * 32) + 8 * fq;
        const f32x4 g0 = *(const f32x4*)g, g1 = *(const f32x4*)(g + 4);
        const float qs = which == 0 ? (mixer == 0 ? 0.125f : 0.08838834764831845f) : 1.0f;
#pragma unroll
        for (int ai = 0; ai < 2; ++ai)
#pragma unroll
            for (int m = 0; m < 4; ++m) { const int row = row0 + ai * HALF + m * 16;
#pragma unroll
                for (int bj = 0; bj < 2; ++bj) { const f32x4 pw = *(const PG8_LAS f32x4*)(X + (((wr * 128) + ai * 64 + m * 16 + fr) * 2 + bj) * 4);
                    float tot, inv; if (mixer == 0) { tot = (wc & 2) ? (pw[2] + pw[3]) : (pw[0] + pw[1]); inv = 1.0f / 64; } else { tot = (pw[0] + pw[1]) + (pw[2] + pw[3]); inv = 1.0f / 128; }
                    const float r = rsqrtf(tot * inv + 1e-6f) * qs * oscale;
                    const f32x4 v0 = acc[ai][bj][m][0] * r * g0, v1 = acc[ai][bj][m][1] * r * g1;
                    u32x4 w; w.x = cvt_pk_bf16(v0[0], v0[1]); w.y = cvt_pk_bf16(v0[2], v0[3]); w.z = cvt_pk_bf16(v1[0], v1[1]); w.w = cvt_pk_bf16(v1[2], v1[3]);
                    const int h = ((colt & 1023) >> 7) + bj; bf16_t* dst;
                    if (mixer == 0) dst = qkv + (size_t)seg * vstride + ((size_t)((row >> 11) * 16 + 2 * h + (wc >> 1)) * 2048 + (row & 2047)) * 64 + (wc & 1) * 32 + 8 * fq;
                    else dst = qkv + (size_t)seg * vstride + ((size_t)((row >> 11) * 8 + h) * 2048 + (row & 2047)) * 128 + wc * 32 + 8 * fq;
                    *(u32x4*)dst = w; } }
    }
};

template <class Epi, class Sched, bool STAMP = false>
__device__ __forceinline__ void gemm_phase(PG8_LAS unsigned char* lds, const Gemm g, const Sched& S, const Epi& E, unsigned long long* stamps, int tid_in) {
    int tid_ = tid_in; asm volatile("" : "+v"(tid_));
    const int tid = tid_, wid = __builtin_amdgcn_readfirstlane(tid >> 6), lane = tid & 63, wr = wid >> 2, wc = wid & 3, fr = lane & 15, fq = lane >> 4;
    const int K = g.K, nt = K / BK, LDA = g.lda ? g.lda : g.K;
    int ts_lo = 0, ts_hi = 0, nts = 0; const unsigned long long rt_entry = STAMP ? (unsigned long long)wall_clock64() : 0ull;
#define PG8_STAMP() do { if (STAMP && wid == 0 && nts < 64) { const unsigned long long _c = (unsigned long long)clock64(); \
        ts_lo = (lane == nts) ? (int)(unsigned)_c : ts_lo; ts_hi = (lane == nts) ? (int)(unsigned)(_c >> 32) : ts_hi; ++nts; } } while (0)
    PG8_STAMP();
    unsigned voffA[2], voffB[2];
#pragma unroll
    for (int i = 0; i < 2; ++i) { int R, C; stage_rc(tid * 16 + i * 8192, R, C); const int Rb = Epi::PERM ? ((R & ~31) + perm32(R & 31)) : R;
        voffA[i] = (unsigned)(R * LDA + C) * 2u; voffB[i] = (unsigned)(Rb * K + C) * 2u; }
    const size_t kstep = (size_t)(BK * 2);
    const size_t hstep = (size_t)HALF * K * 2;
    const size_t tstep = 2 * hstep;
    const size_t hstepA = (size_t)HALF * LDA * 2, tstepA = 2 * hstepA;
    const unsigned ldsw = (unsigned)wid * 1024u;
    const int aoff = lds_byte(wr * 64 + fr, fq * 8), boff = lds_byte(wc * 32 + fr, fq * 8);
#define PG8_SA(b, h) (((b) * 2 + (h)) * HTB)
#define PG8_SB(b, h) ((4 + (b) * 2 + (h)) * HTB)
#define PG8_STAGE(bufoff, gbase, voff) do { _Pragma("unroll") for (int _i = 0; _i < 2; ++_i) \
        __builtin_amdgcn_global_load_lds((const unsigned*)((const char*)(gbase) + (voff)[_i]), (PG8_LAS unsigned*)(lds + (bufoff) + ldsw + _i * 8192), 16, 0, 0); } while (0)
#define PG8_LDA(dst, b, h) do { _Pragma("unroll") for (int m = 0; m < 4; ++m) _Pragma("unroll") for (int k = 0; k < 2; ++k) dst[m][k] = *(const PG8_LAS bf16x8*)(lds + PG8_SA(b, h) + aoff + m * 2048 + k * 1024); } while (0)
#define PG8_LDB(dst, b, h) do { _Pragma("unroll") for (int n = 0; n < 2; ++n) _Pragma("unroll") for (int k = 0; k < 2; ++k) dst[n][k] = *(const PG8_LAS bf16x8*)(lds + PG8_SB(b, h) + boff + n * 2048 + k * 1024); } while (0)
#define PG8_MMA(ai, bj, At, Bt) do { __builtin_amdgcn_s_setprio(1); _Pragma("unroll") for (int m = 0; m < 4; ++m) _Pragma("unroll") for (int n = 0; n < 2; ++n) _Pragma("unroll") for (int k = 0; k < 2; ++k) \
        acc[ai][bj][m][n] = __builtin_amdgcn_mfma_f32_16x16x32_bf16(Bt[n][k], At[m][k], acc[ai][bj][m][n], 0, 0, 0); __builtin_amdgcn_s_setprio(0); } while (0)
#define PG8_WAIT_V(n) asm volatile("s_waitcnt vmcnt(" #n ")" ::: "memory")
#define PG8_WAIT_L(n) asm volatile("s_waitcnt lgkmcnt(" #n ")" ::: "memory")
#define PG8_BAR __builtin_amdgcn_s_barrier()
#define PG8_SCHED __builtin_amdgcn_sched_barrier(0)
    Unit cur, nxt; int ui = 0;
    if (!S.next(0, cur)) return;
    f32x4 acc[2][2][4][2];
#pragma unroll
    for (int a = 0; a < 2; ++a)
#pragma unroll
        for (int b = 0; b < 2; ++b)
#pragma unroll
            for (int m = 0; m < 4; ++m)
#pragma unroll
                for (int n = 0; n < 2; ++n) acc[a][b][m][n] = (f32x4){0.f, 0.f, 0.f, 0.f};
    bf16x8 At[4][2], B0[2][2], B1[2][2];
    const char* cA = (const char*)g.A + (size_t)cur.pm * tstepA; const char* cB = (const char*)g.Bt + (size_t)cur.pn * tstep;
    S.a_ready(cur);
    PG8_STAGE(PG8_SB(0, 0), cB, voffB); PG8_STAGE(PG8_SA(0, 0), cA, voffA); PG8_STAGE(PG8_SB(0, 1), cB + hstep, voffB); PG8_STAGE(PG8_SA(0, 1), cA + hstepA, voffA);
    if (wr == 1) PG8_BAR;
    PG8_WAIT_V(4); PG8_BAR;
    PG8_STAGE(PG8_SB(1, 0), cB + kstep, voffB); PG8_STAGE(PG8_SA(1, 0), cA + kstep, voffA); PG8_STAGE(PG8_SB(1, 1), cB + hstep + kstep, voffB);
    PG8_WAIT_V(6); PG8_BAR;
    PG8_STAMP();
    for (;;) {
        const bool has_next = S.next(ui + 1, nxt);
        const char* nA = has_next ? (const char*)g.A + (size_t)nxt.pm * tstepA : cA; const char* nB = has_next ? (const char*)g.Bt + (size_t)nxt.pn * tstep : cB;
        for (int t = 0; t < nt; t += 2) {
            const bool last = (t == nt - 2);
            const char* a1 = cA + (size_t)(t + 1) * kstep;
            const char* a2 = last ? nA : cA + (size_t)(t + 2) * kstep; const char* b2 = last ? nB : cB + (size_t)(t + 2) * kstep;
            const char* a3 = a2 + kstep; const char* b3 = b2 + kstep;
            if (last && has_next) S.a_ready(nxt);
            PG8_LDB(B0, 0, 0); PG8_SCHED; PG8_LDA(At, 0, 0); PG8_STAGE(PG8_SA(1, 1), a1 + hstepA, voffA);
            PG8_WAIT_L(8); PG8_BAR; PG8_WAIT_L(0); PG8_MMA(0, 0, At, B0); PG8_BAR; PG8_SCHED;
            PG8_LDB(B1, 0, 1); PG8_STAGE(PG8_SB(0, 0), b2, voffB);
            PG8_BAR; PG8_WAIT_L(0); PG8_MMA(0, 1, At, B1); PG8_BAR;
            PG8_LDA(At, 0, 1); PG8_STAGE(PG8_SA(0, 0), a2, voffA);
            PG8_BAR; PG8_WAIT_L(0); PG8_MMA(1, 0, At, B0); PG8_BAR; PG8_SCHED;
            PG8_STAGE(PG8_SB(0, 1), b2 + hstep, voffB);
            PG8_WAIT_V(6); PG8_BAR; PG8_MMA(1, 1, At, B1); PG8_BAR;
            PG8_LDB(B0, 1, 0); PG8_SCHED; PG8_LDA(At, 1, 0); PG8_STAGE(PG8_SA(0, 1), a2 + hstepA, voffA);
            PG8_WAIT_L(8); PG8_BAR; PG8_WAIT_L(0); PG8_MMA(0, 0, At, B0); PG8_BAR; PG8_SCHED;
            PG8_LDB(B1, 1, 1); PG8_STAGE(PG8_SB(1, 0), b3, voffB);
            PG8_BAR; PG8_WAIT_L(0); PG8_MMA(0, 1, At, B1); PG8_BAR;
            PG8_LDA(At, 1, 1); PG8_STAGE(PG8_SA(1, 0), a3, voffA);
            PG8_BAR; PG8_WAIT_L(0); PG8_MMA(1, 0, At, B0); PG8_BAR; PG8_SCHED;
            PG8_STAGE(PG8_SB(1, 1), b3 + hstep, voffB);
            PG8_WAIT_V(6); PG8_BAR; PG8_MMA(1, 1, At, B1); PG8_BAR;
        }
        PG8_STAMP();
        if constexpr (!Epi::AFTER_DRAIN) { E(acc, cur, wr, wc, fr, fq); S.done(cur); }
        PG8_STAMP();
        if (!has_next) break;
#pragma unroll
        for (int a = 0; a < 2; ++a)
#pragma unroll
            for (int b = 0; b < 2; ++b)
#pragma unroll
                for (int m = 0; m < 4; ++m)
#pragma unroll
                    for (int n = 0; n < 2; ++n) acc[a][b][m][n] = (f32x4){0.f, 0.f, 0.f, 0.f};
        cur = nxt; cA = nA; cB = nB; ++ui;
    }
    PG8_WAIT_V(0);
    if (wr == 0) PG8_BAR;
    PG8_BAR;
    if constexpr (Epi::AFTER_DRAIN) { E.fused(acc, cur, wr, wc, fr, fq, lds, wid, lane); S.done(cur); }
    PG8_STAMP();
    if (STAMP && wid == 0) { stamps[lane] = lane < nts ? (((unsigned long long)(unsigned)ts_hi << 32) | (unsigned)ts_lo) : 0ull;
        if (lane == 62) stamps[62] = rt_entry; if (lane == 63) stamps[63] = (unsigned long long)wall_clock64(); }
#undef PG8_STAMP
#undef PG8_SA
#undef PG8_SB
#undef PG8_STAGE
#undef PG8_LDA
#undef PG8_LDB
#undef PG8_MMA
#undef PG8_WAIT_V
#undef PG8_WAIT_L
#undef PG8_BAR
#undef PG8_SCHED
}

template <class Epi, class Sched, bool STAMP = false>
__device__ __forceinline__ void gemm_phase_f8(PG8_LAS unsigned char* lds, const Gemm g, const Sched& S, const Epi& E, unsigned long long* stamps, int tid_in) {
    int tid_ = tid_in; asm volatile("" : "+v"(tid_));
    const int tid = tid_, wid = __builtin_amdgcn_readfirstlane(tid >> 6), lane = tid & 63, wr = wid >> 2, wc = wid & 3, fr = lane & 15, fq = lane >> 4;
    const int K = g.K, nt = K / 128;
    int ts_lo = 0, ts_hi = 0, nts = 0; const unsigned long long rt_entry = STAMP ? (unsigned long long)wall_clock64() : 0ull;
#define PG8_STAMP() do { if (STAMP && wid == 0 && nts < 64) { const unsigned long long _c = (unsigned long long)clock64(); \
        ts_lo = (lane == nts) ? (int)(unsigned)_c : ts_lo; ts_hi = (lane == nts) ? (int)(unsigned)(_c >> 32) : ts_hi; ++nts; } } while (0)
    PG8_STAMP();
    unsigned voffA[2], voffB[2];
#pragma unroll
    for (int i = 0; i < 2; ++i) { int R, C; stage_rc(tid * 16 + i * 8192, R, C); const int Rb = Epi::PERM ? ((R & ~31) + perm32(R & 31)) : R;
        voffA[i] = (unsigned)(R * K + C * 2); voffB[i] = (unsigned)(Rb * K + C * 2); }
    const size_t kstep = (size_t)(BK * 2);
    const size_t hstep = (size_t)HALF * K;
    const size_t tstep = 2 * hstep;
    const unsigned ldsw = (unsigned)wid * 1024u;
    const int aoff = lds_byte(wr * 64 + fr, fq * 16), boff = lds_byte(wc * 32 + fr, fq * 16);
    const int aoffk[2] = {aoff + 16 * (fq & 1), aoff + 16 * ((fq & 1) ^ 1)}, boffk[2] = {boff + 16 * (fq & 1), boff + 16 * ((fq & 1) ^ 1)};
#define PG8_SA(b, h) (((b) * 2 + (h)) * HTB)
#define PG8_SB(b, h) ((4 + (b) * 2 + (h)) * HTB)
#define PG8_STAGE(bufoff, gbase, voff) do { _Pragma("unroll") for (int _i = 0; _i < 2; ++_i) \
        __builtin_amdgcn_global_load_lds((const unsigned*)((const char*)(gbase) + (voff)[_i]), (PG8_LAS unsigned*)(lds + (bufoff) + ldsw + _i * 8192), 16, 0, 0); } while (0)
#define PG8_LDA(dst, b, h) do { _Pragma("unroll") for (int m = 0; m < 4; ++m) _Pragma("unroll") for (int k = 0; k < 2; ++k) { const i32x4 t_ = *(const PG8_LAS i32x4*)(lds + PG8_SA(b, h) + aoffk[k] + m * 2048); \
        dst[m * 8 + k * 4 + 0] = t_[0]; dst[m * 8 + k * 4 + 1] = t_[1]; dst[m * 8 + k * 4 + 2] = t_[2]; dst[m * 8 + k * 4 + 3] = t_[3]; } } while (0)
#define PG8_LDB(dst, b, h) do { _Pragma("unroll") for (int n = 0; n < 2; ++n) _Pragma("unroll") for (int k = 0; k < 2; ++k) { const i32x4 t_ = *(const PG8_LAS i32x4*)(lds + PG8_SB(b, h) + boffk[k] + n * 2048); \
        dst[n * 8 + k * 4 + 0] = t_[0]; dst[n * 8 + k * 4 + 1] = t_[1]; dst[n * 8 + k * 4 + 2] = t_[2]; dst[n * 8 + k * 4 + 3] = t_[3]; } } while (0)
#define PG8_MMA(ai, bj, At, Bt) do { __builtin_amdgcn_s_setprio(1); \
        { f32x4 c_ = __builtin_shufflevector(accv[ai][bj], accv[ai][bj], 0, 1, 2, 3); c_ = __builtin_amdgcn_mfma_scale_f32_16x16x128_f8f6f4(__builtin_shufflevector(Bt, Bt, 0, 1, 2, 3, 4, 5, 6, 7), __builtin_shufflevector(At, At, 0, 1, 2, 3, 4, 5, 6, 7), c_, 0, 0, 0, 0, 0, 0); accv[ai][bj] = __builtin_shufflevector(accv[ai][bj], __builtin_shufflevector(c_, c_, 0, 1, 2, 3, -1, -1, -1, -1, -1, -1, -1, -1, -1, -1, -1, -1, -1, -1, -1, -1, -1, -1, -1, -1, -1, -1, -1, -1, -1, -1, -1, -1), 32, 33, 34, 35, 4, 5, 6, 7, 8, 9, 10, 11, 12, 13, 14, 15, 16, 17, 18, 19, 20, 21, 22, 23, 24, 25, 26, 27, 28, 29, 30, 31); } \
        { f32x4 c_ = __builtin_shufflevector(accv[ai][bj], accv[ai][bj], 4, 5, 6, 7); c_ = __builtin_amdgcn_mfma_scale_f32_16x16x128_f8f6f4(__builtin_shufflevector(Bt, Bt, 8, 9, 10, 11, 12, 13, 14, 15), __builtin_shufflevector(At, At, 0, 1, 2, 3, 4, 5, 6, 7), c_, 0, 0, 0, 0, 0, 0); accv[ai][bj] = __builtin_shufflevector(accv[ai][bj], __builtin_shufflevector(c_, c_, 0, 1, 2, 3, -1, -1, -1, -1, -1, -1, -1, -1, -1, -1, -1, -1, -1, -1, -1, -1, -1, -1, -1, -1, -1, -1, -1, -1, -1, -1, -1, -1), 0, 1, 2, 3, 32, 33, 34, 35, 8, 9, 10, 11, 12, 13, 14, 15, 16, 17, 18, 19, 20, 21, 22, 23, 24, 25, 26, 27, 28, 29, 30, 31); } \
        { f32x4 c_ = __builtin_shufflevector(accv[ai][bj], accv[ai][bj], 8, 9, 10, 11); c_ = __builtin_amdgcn_mfma_scale_f32_16x16x128_f8f6f4(__builtin_shufflevector(Bt, Bt, 0, 1, 2, 3, 4, 5, 6, 7), __builtin_shufflevector(At, At, 8, 9, 10, 11, 12, 13, 14, 15), c_, 0, 0, 0, 0, 0, 0); accv[ai][bj] = __builtin_shufflevector(accv[ai][bj], __builtin_shufflevector(c_, c_, 0, 1, 2, 3, -1, -1, -1, -1, -1, -1, -1, -1, -1, -1, -1, -1, -1, -1, -1, -1, -1, -1, -1, -1, -1, -1, -1, -1, -1, -1, -1, -1), 0, 1, 2, 3, 4, 5, 6, 7, 32, 33, 34, 35, 12, 13, 14, 15, 16, 17, 18, 19, 20, 21, 22, 23, 24, 25, 26, 27, 28, 29, 30, 31); } \
        { f32x4 c_ = __builtin_shufflevector(accv[ai][bj], accv[ai][bj], 12, 13, 14, 15); c_ = __builtin_amdgcn_mfma_scale_f32_16x16x128_f8f6f4(__builtin_shufflevector(Bt, Bt, 8, 9, 10, 11, 12, 13, 14, 15), __builtin_shufflevector(At, At, 8, 9, 10, 11, 12, 13, 14, 15), c_, 0, 0, 0, 0, 0, 0); accv[ai][bj] = __builtin_shufflevector(accv[ai][bj], __builtin_shufflevector(c_, c_, 0, 1, 2, 3, -1, -1, -1, -1, -1, -1, -1, -1, -1, -1, -1, -1, -1, -1, -1, -1, -1, -1, -1, -1, -1, -1, -1, -1, -1, -1, -1, -1), 0, 1, 2, 3, 4, 5, 6, 7, 8, 9, 10, 11, 32, 33, 34, 35, 16, 17, 18, 19, 20, 21, 22, 23, 24, 25, 26, 27, 28, 29, 30, 31); } \
        { f32x4 c_ = __builtin_shufflevector(accv[ai][bj], accv[ai][bj], 16, 17, 18, 19); c_ = __builtin_amdgcn_mfma_scale_f32_16x16x128_f8f6f4(__builtin_shufflevector(Bt, Bt, 0, 1, 2, 3, 4, 5, 6, 7), __builtin_shufflevector(At, At, 16, 17, 18, 19, 20, 21, 22, 23), c_, 0, 0, 0, 0, 0, 0); accv[ai][bj] = __builtin_shufflevector(accv[ai][bj], __builtin_shufflevector(c_, c_, 0, 1, 2, 3, -1, -1, -1, -1, -1, -1, -1, -1, -1, -1, -1, -1, -1, -1, -1, -1, -1, -1, -1, -1, -1, -1, -1, -1, -1, -1, -1, -1), 0, 1, 2, 3, 4, 5, 6, 7, 8, 9, 10, 11, 12, 13, 14, 15, 32, 33, 34, 35, 20, 21, 22, 23, 24, 25, 26, 27, 28, 29, 30, 31); } \
        { f32x4 c_ = __builtin_shufflevector(accv[ai][bj], accv[ai][bj], 20, 21, 22, 23); c_ = __builtin_amdgcn_mfma_scale_f32_16x16x128_f8f6f4(__builtin_shufflevector(Bt, Bt, 8, 9, 10, 11, 12, 13, 14, 15), __builtin_shufflevector(At, At, 16, 17, 18, 19, 20, 21, 22, 23), c_, 0, 0, 0, 0, 0, 0); accv[ai][bj] = __builtin_shufflevector(accv[ai][bj], __builtin_shufflevector(c_, c_, 0, 1, 2, 3, -1, -1, -1, -1, -1, -1, -1, -1, -1, -1, -1, -1, -1, -1, -1, -1, -1, -1, -1, -1, -1, -1, -1, -1, -1, -1, -1, -1), 0, 1, 2, 3, 4, 5, 6, 7, 8, 9, 10, 11, 12, 13, 14, 15, 16, 17, 18, 19, 32, 33, 34, 35, 24, 25, 26, 27, 28, 29, 30, 31); } \
        { f32x4 c_ = __builtin_shufflevector(accv[ai][bj], accv[ai][bj], 24, 25, 26, 27); c_ = __builtin_amdgcn_mfma_scale_f32_16x16x128_f8f6f4(__builtin_shufflevector(Bt, Bt, 0, 1, 2, 3, 4, 5, 6, 7), __builtin_shufflevector(At, At, 24, 25, 26, 27, 28, 29, 30, 31), c_, 0, 0, 0, 0, 0, 0); accv[ai][bj] = __builtin_shufflevector(accv[ai][bj], __builtin_shufflevector(c_, c_, 0, 1, 2, 3, -1, -1, -1, -1, -1, -1, -1, -1, -1, -1, -1, -1, -1, -1, -1, -1, -1, -1, -1, -1, -1, -1, -1, -1, -1, -1, -1, -1), 0, 1, 2, 3, 4, 5, 6, 7, 8, 9, 10, 11, 12, 13, 14, 15, 16, 17, 18, 19, 20, 21, 22, 23, 32, 33, 34, 35, 28, 29, 30, 31); } \
        { f32x4 c_ = __builtin_shufflevector(accv[ai][bj], accv[ai][bj], 28, 29, 30, 31); c_ = __builtin_amdgcn_mfma_scale_f32_16x16x128_f8f6f4(__builtin_shufflevector(Bt, Bt, 8, 9, 10, 11, 12, 13, 14, 15), __builtin_shufflevector(At, At, 24, 25, 26, 27, 28, 29, 30, 31), c_, 0, 0, 0, 0, 0, 0); accv[ai][bj] = __builtin_shufflevector(accv[ai][bj], __builtin_shufflevector(c_, c_, 0, 1, 2, 3, -1, -1, -1, -1, -1, -1, -1, -1, -1, -1, -1, -1, -1, -1, -1, -1, -1, -1, -1, -1, -1, -1, -1, -1, -1, -1, -1, -1), 0, 1, 2, 3, 4, 5, 6, 7, 8, 9, 10, 11, 12, 13, 14, 15, 16, 17, 18, 19, 20, 21, 22, 23, 24, 25, 26, 27, 32, 33, 34, 35); } \
        __builtin_amdgcn_s_setprio(0); } while (0)
#define PG8_WAIT_V(n) asm volatile("s_waitcnt vmcnt(" #n ")" ::: "memory")
#define PG8_WAIT_L(n) asm volatile("s_waitcnt lgkmcnt(" #n ")" ::: "memory")
#define PG8_BAR __builtin_amdgcn_s_barrier()
#define PG8_SCHED __builtin_amdgcn_sched_barrier(0)
    Unit cur, nxt; int ui = 0;
    if (!S.next(0, cur)) return;
    f32x32 accv[2][2];
#pragma unroll
    for (int a = 0; a < 2; ++a)
#pragma unroll
        for (int b = 0; b < 2; ++b) accv[a][b] = f32x32{};
    i32x32 At; i32x16 B0, B1;
    const char* cA = (const char*)g.A + (size_t)cur.pm * tstep; const char* cB = (const char*)g.Bt + (size_t)cur.pn * tstep;
    S.a_ready(cur);
    PG8_STAGE(PG8_SB(0, 0), cB, voffB); PG8_STAGE(PG8_SA(0, 0), cA, voffA); PG8_STAGE(PG8_SB(0, 1), cB + hstep, voffB); PG8_STAGE(PG8_SA(0, 1), cA + hstep, voffA);
    if (wr == 1) PG8_BAR;
    PG8_WAIT_V(4); PG8_BAR;
    PG8_STAGE(PG8_SB(1, 0), cB + kstep, voffB); PG8_STAGE(PG8_SA(1, 0), cA + kstep, voffA); PG8_STAGE(PG8_SB(1, 1), cB + hstep + kstep, voffB);
    PG8_WAIT_V(6); PG8_BAR;
    PG8_STAMP();
    for (;;) {
        const bool has_next = S.next(ui + 1, nxt);
        const char* nA = has_next ? (const char*)g.A + (size_t)nxt.pm * tstep : cA; const char* nB = has_next ? (const char*)g.Bt + (size_t)nxt.pn * tstep : cB;
        for (int t = 0; t < nt; t += 2) {
            const bool last = (t == nt - 2);
            const char* a1 = cA + (size_t)(t + 1) * kstep;
            const char* a2 = last ? nA : cA + (size_t)(t + 2) * kstep; const char* b2 = last ? nB : cB + (size_t)(t + 2) * kstep;
            const char* a3 = a2 + kstep; const char* b3 = b2 + kstep;
            if (last && has_next) S.a_ready(nxt);
            PG8_LDB(B0, 0, 0); PG8_SCHED; PG8_LDA(At, 0, 0); PG8_STAGE(PG8_SA(1, 1), a1 + hstep, voffA);
            PG8_WAIT_L(8); PG8_BAR; PG8_WAIT_L(0); PG8_MMA(0, 0, At, B0); PG8_BAR; PG8_SCHED;
            PG8_LDB(B1, 0, 1); PG8_STAGE(PG8_SB(0, 0), b2, voffB);
            PG8_BAR; PG8_WAIT_L(0); PG8_MMA(0, 1, At, B1); PG8_BAR;
            PG8_LDA(At, 0, 1); PG8_STAGE(PG8_SA(0, 0), a2, voffA);
            PG8_BAR; PG8_WAIT_L(0); PG8_MMA(1, 0, At, B0); PG8_BAR; PG8_SCHED;
            PG8_STAGE(PG8_SB(0, 1), b2 + hstep, voffB);
            PG8_WAIT_V(6); PG8_BAR; PG8_MMA(1, 1, At, B1); PG8_BAR;
            PG8_LDB(B0, 1, 0); PG8_SCHED; PG8_LDA(At, 1, 0); PG8_STAGE(PG8_SA(0, 1), a2 + hstep, voffA);
            PG8_WAIT_L(8); PG8_BAR; PG8_WAIT_L(0); PG8_MMA(0, 0, At, B0); PG8_BAR; PG8_SCHED;
            PG8_LDB(B1, 1, 1); PG8_STAGE(PG8_SB(1, 0), b3, voffB);
            PG8_BAR; PG8_WAIT_L(0); PG8_MMA(0, 1, At, B1); PG8_BAR;
            PG8_LDA(At, 1, 1); PG8_STAGE(PG8_SA(1, 0), a3, voffA);
            PG8_BAR; PG8_WAIT_L(0); PG8_MMA(1, 0, At, B0); PG8_BAR; PG8_SCHED;
            PG8_STAGE(PG8_SB(1, 1), b3 + hstep, voffB);
            PG8_WAIT_V(6); PG8_BAR; PG8_MMA(1, 1, At, B1); PG8_BAR;
        }
        PG8_STAMP();
        if constexpr (!Epi::AFTER_DRAIN) { f32x4 acc[2][2][4][2];
#pragma unroll
            for (int a = 0; a < 2; ++a)
#pragma unroll
                for (int b = 0; b < 2; ++b)
#pragma unroll
                    for (int m = 0; m < 4; ++m)
#pragma unroll
                        for (int n = 0; n < 2; ++n) { const int q_ = 4 * (m * 2 + n); acc[a][b][m][n] = (f32x4){accv[a][b][q_], accv[a][b][q_ + 1], accv[a][b][q_ + 2], accv[a][b][q_ + 3]}; }
            E(acc, cur, wr, wc, fr, fq); S.done(cur); }
        PG8_STAMP();
        if (!has_next) break;
#pragma unroll
        for (int a = 0; a < 2; ++a)
#pragma unroll
            for (int b = 0; b < 2; ++b) accv[a][b] = f32x32{};
        cur = nxt; cA = nA; cB = nB; ++ui;
    }
    PG8_WAIT_V(0);
    if (wr == 0) PG8_BAR;
    PG8_BAR;
    static_assert(!Epi::AFTER_DRAIN, "no fused epilogues in the fp8 body");
    PG8_STAMP();
    if (STAMP && wid == 0) { stamps[lane] = lane < nts ? (((unsigned long long)(unsigned)ts_hi << 32) | (unsigned)ts_lo) : 0ull;
        if (lane == 62) stamps[62] = rt_entry; if (lane == 63) stamps[63] = (unsigned long long)wall_clock64(); }
#undef PG8_STAMP
#undef PG8_SA
#undef PG8_SB
#undef PG8_STAGE
#undef PG8_LDA
#undef PG8_LDB
#undef PG8_MMA
#undef PG8_WAIT_V
#undef PG8_WAIT_L
#undef PG8_BAR
#undef PG8_SCHED
}

}

#define XB_TMO      128
#define XB_XCNT(j)  (256  + 64 * (j))
#define XB_XSUB(j)  (1280 + 64 * (j))
#define XB_XGEN(j)  (2304 + 64 * (j))
#define XB_TOP      3328
#define XB_TOPGEN   3392
#define XCD_BAR_WORDS 3456
#define XB_SPIN_CAP (1u << 18)
#define LAS __attribute__((address_space(3)))

__device__ __forceinline__ unsigned xb_ld(unsigned* p)              { return __hip_atomic_load(p, __ATOMIC_RELAXED, __HIP_MEMORY_SCOPE_AGENT); }
__device__ __forceinline__ unsigned xb_add(unsigned* p, unsigned v) { return __hip_atomic_fetch_add(p, v, __ATOMIC_RELAXED, __HIP_MEMORY_SCOPE_AGENT); }
__device__ __forceinline__ unsigned xb_xcc_id() { return (unsigned)__builtin_amdgcn_s_getreg((3 << 11) | 20) & 0xFu; }
#define XB_SPIN(cond, bar) do { unsigned _sp = 0; while (cond) { __builtin_amdgcn_s_sleep(1); \
    if ((++_sp & 255u) == 0u) { if (xb_ld(&(bar)[XB_TMO])) break; if (_sp > XB_SPIN_CAP) { atomicAdd(&(bar)[XB_TMO], 1u); break; } } } } while (0)

struct XcdBarrier {
    unsigned* bar; unsigned x; unsigned G;
    volatile LAS unsigned* st;
};

__device__ __forceinline__ XcdBarrier xcd_barrier_post(unsigned* bar, volatile LAS unsigned* st, bool t0  ) {
    XcdBarrier b; b.bar = bar; b.x = xb_xcc_id(); b.st = st; b.G = 0u;
    if (t0) (void)xb_add(&bar[XB_XCNT(b.x)], 1u);
    return b;
}
__device__ __forceinline__ void xcd_barrier_complete(unsigned* bar, unsigned x, unsigned G, unsigned& nloc, unsigned& nx) {
    unsigned sum, cnt, mine, sp = 0u;
    for (;;) {
        sum = 0u; cnt = 0u; mine = 0u;
#pragma unroll
        for (unsigned j = 0; j < 16; ++j) { const unsigned c = xb_ld(&bar[XB_XCNT(j)]); sum += c; cnt += (c > 0u) ? 1u : 0u; mine = (j == x) ? c : mine; }
        if (sum == G) break;
        __builtin_amdgcn_s_sleep(1);
        if ((++sp & 255u) == 0u) { if (xb_ld(&bar[XB_TMO])) break; if (sp > XB_SPIN_CAP) { atomicAdd(&bar[XB_TMO], 1u); break; } }
    }
    nloc = mine > 0u ? mine : 1u; nx = cnt > 0u ? cnt : 1u;
}

__device__ __forceinline__ void xcd_barrier(const XcdBarrier& b, bool t0  ) {
    asm volatile("s_waitcnt vmcnt(0)" ::: "memory");
    __syncthreads();
    if (t0) {
        unsigned* bar = b.bar;
        __builtin_amdgcn_s_waitcnt(0);
        unsigned nloc = b.st[0], nx = b.st[1];
        if (nloc == 0u) { xcd_barrier_complete(bar, b.x, b.G, nloc, nx); b.st[0] = nloc; b.st[1] = nx; }
        const unsigned old = xb_add(&bar[XB_XSUB(b.x)], 1u);
        const unsigned gen = old / nloc;
        if (old + 1u == (gen + 1u) * nloc) {
            __builtin_amdgcn_fence(__ATOMIC_RELEASE, "agent");
            asm volatile("s_waitcnt vmcnt(0)" ::: "memory");
            const unsigned og = xb_add(&bar[XB_TOP], 1u);
            const unsigned tg = og / nx;
            if (og + 1u == (tg + 1u) * nx) xb_add(&bar[XB_TOPGEN], 1u);
            else XB_SPIN(xb_ld(&bar[XB_TOPGEN]) == tg, bar);
            __builtin_amdgcn_fence(__ATOMIC_ACQUIRE, "agent");
            xb_add(&bar[XB_XGEN(b.x)], 1u);
            asm volatile("s_waitcnt vmcnt(0)" ::: "memory");
        } else {
            XB_SPIN(xb_ld(&bar[XB_XGEN(b.x)]) == gen, bar);
            __builtin_amdgcn_fence(__ATOMIC_ACQUIRE, "agent");
            asm volatile("s_waitcnt vmcnt(0)" ::: "memory");
        }
    }
    __syncthreads();
}


namespace mk {
typedef unsigned short bf16_t;
typedef short bf16x8 __attribute__((ext_vector_type(8)));
typedef short s16x4 __attribute__((ext_vector_type(4)));
typedef float f32x16 __attribute__((ext_vector_type(16)));
typedef float f32x4 __attribute__((ext_vector_type(4)));
typedef unsigned u32x4 __attribute__((ext_vector_type(4)));
typedef unsigned u32x2 __attribute__((ext_vector_type(2)));
typedef __bf16 bf2 __attribute__((ext_vector_type(2)));
typedef float f32x16v __attribute__((ext_vector_type(16)));
typedef float f32x32v __attribute__((ext_vector_type(32)));
typedef unsigned u32x6 __attribute__((ext_vector_type(6)));
typedef _Float16 h16x32 __attribute__((ext_vector_type(32)));
typedef _Float16 h16x2 __attribute__((ext_vector_type(2)));

constexpr int TT = 16384, T = 8192, S = 2048, NB = 4, DM = 4096, NIN = 10560, NINP = 10752, NH = 8, NEXP = 16384;
constexpr float EPS = 1e-6f;
constexpr float O8_SCALE = 32.0f, WOUT8_SCALE = 2048.0f;
constexpr float HN8_SCALE = 16.0f, WIN8_SCALE = 2048.0f;
constexpr float U_SCALE = 128.0f, V_SCALE = 5.656854249f;
constexpr int NWAVES = 8, NTHR = 512;
constexpr int LDS_BYTES = 143360;
constexpr int LDS_XB = 131072;
constexpr int LDS_G1X = 131072 + 1024;

constexpr size_t SZ_WIN = (size_t)NINP * DM * 2, SZ_WOUT = (size_t)DM * DM * 2, SZ_W2 = (size_t)2048 * DM * 2, SZ_WUQ = (size_t)1536 * 768 * 2, SZ_WUKV = (size_t)2048 * 512 * 2,
                 SZ_TAB = (size_t)NEXP * 3072;
constexpr size_t LW_WIN = 0, LW_WOUT = LW_WIN + SZ_WIN, LW_W2 = LW_WOUT + SZ_WOUT, LW_WUQ = LW_W2 + SZ_W2, LW_WUKV = LW_WUQ + SZ_WUQ, LW_U = LW_WUKV + SZ_WUKV, LW_V = LW_U + SZ_TAB,
                 LW_END = LW_V + SZ_TAB;
constexpr size_t WS_CTL = 0, WS_SSQ = 65536, WS_W = 65536 + 2 * 65536;
constexpr size_t WS_HN = WS_W + 2 * LW_END, SZ_HN = (size_t)T * DM * 2, WS_P = WS_HN + SZ_HN, SZ_P = (size_t)T * NINP * 2;
constexpr size_t SZ_H1 = (size_t)T * 1024 * 2;
constexpr size_t WS_QKV = WS_P + SZ_P;
constexpr size_t QO_QA = 0, QO_KA = SZ_H1, QO_VA = 2 * SZ_H1, QO_QB = 3 * SZ_H1, QO_KB = 4 * SZ_H1, QO_VB = 5 * SZ_H1, QO_QC = 6 * SZ_H1, QO_KC = 7 * SZ_H1, QO_VC = 8 * SZ_H1,
                 QO_QD = 9 * SZ_H1, SZ_QD = (size_t)T * 1536 * 2, QO_KD = QO_QD + SZ_QD, QO_VD = QO_KD + SZ_QD, SZ_QKV = QO_VD + SZ_H1;
constexpr size_t WS_O = WS_QKV + SZ_QKV, SZ_O = (size_t)T * DM * 2, WS_T2 = WS_O + SZ_O, SZ_T2 = (size_t)2 * T * 1024 * 4, WS_END = WS_T2 + SZ_T2;
constexpr size_t SZ_F1 = (size_t)T * 1024 * 4;
constexpr size_t PO_OA = 0, PO_OB = 2 * SZ_H1, PO_LSE = 5 * SZ_H1, SZ_LSE = (size_t)3 * T * 8 * 4;
static_assert(PO_LSE + SZ_LSE <= SZ_P, "P alias");
constexpr size_t PO_SC = 0, SZ_SC = (size_t)T * 2048 * 4, PO_EXP = SZ_SC, SZ_EG = (size_t)T * 128 * 4, PO_GATE = PO_EXP + SZ_EG;
static_assert(PO_GATE + SZ_EG <= SZ_P, "P alias 2");
constexpr size_t OO_QRAW = 0, OO_KVRAW = (size_t)T * 1536 * 2;
static_assert(OO_KVRAW + (size_t)T * 2048 * 2 <= SZ_O, "O alias");
constexpr size_t TO_HN8 = 0;
constexpr size_t TO_CQ = 0, TO_CKV = (size_t)T * 768 * 2;
constexpr size_t ACT_SZ = WS_END - WS_HN, WS_TOTAL = WS_HN + 2 * ACT_SZ;
constexpr size_t TO_OC = 0, TO_OD = SZ_F1;

struct Args { const float* in[20]; float* out; unsigned char* ws; };
enum { I_X = 0, I_GMIX, I_WIN, I_WOUT, I_DLAM, I_DGQK, I_DGOUT, I_DILG, I_NAG, I_RPB, I_GCQ, I_GCKV, I_WUQ, I_WUKV, I_MLAG, I_GFFN, I_PWQ, I_PSK, I_PU, I_PV };

struct Frame {
    const Args* a; float* out; unsigned char* ws; LAS unsigned char* lds;
    int tid, lane, wid;
    int rank, nwg;
};

#ifdef MK_XCDSPLIT
__device__ __forceinline__ int sid() { return ((int)blockIdx.x >> 2) & 1; }
__device__ __forceinline__ int wg_rank() { return (((int)blockIdx.x >> 3) << 2) | ((int)blockIdx.x & 3); }
#else
__device__ __forceinline__ int sid() { return ((int)blockIdx.x >> 3) & 1; }
__device__ __forceinline__ int wg_rank() { return (((int)blockIdx.x >> 4) << 3) | ((int)blockIdx.x & 7); }
#endif
__device__ __forceinline__ int wg_count() { return (int)gridDim.x >> 1; }

#define MK_DPP_ADD(v, ctrl) v += __int_as_float(__builtin_amdgcn_update_dpp(0, __float_as_int(v), ctrl, 0xF, 0xF, true))
__device__ __forceinline__ float wave_total(float v) {
    MK_DPP_ADD(v, 0xB1); MK_DPP_ADD(v, 0x4E); MK_DPP_ADD(v, 0x141); MK_DPP_ADD(v, 0x140);
    const int vi = __float_as_int(v);
    return (__int_as_float(__builtin_amdgcn_readlane(vi, 0)) + __int_as_float(__builtin_amdgcn_readlane(vi, 16))) + (__int_as_float(__builtin_amdgcn_readlane(vi, 32)) + __int_as_float(__builtin_amdgcn_readlane(vi, 48)));
}
__device__ __forceinline__ float wsum(float v) { return wave_total(v); }
__device__ __forceinline__ float sum4(float v) { MK_DPP_ADD(v, 0xB1); MK_DPP_ADD(v, 0x4E); return v; }
__device__ __forceinline__ float sum8(float v) { MK_DPP_ADD(v, 0xB1); MK_DPP_ADD(v, 0x4E); MK_DPP_ADD(v, 0x141); return v; }
__device__ __forceinline__ unsigned pk_bf16(float lo, float hi) { unsigned r; asm volatile("v_cvt_pk_bf16_f32 %0, %1, %2" : "=v"(r) : "v"(lo), "v"(hi)); return r; }
__device__ __forceinline__ unsigned pk_fp8x4(float a, float b, float c, float d) {
    a = fminf(fmaxf(a, -448.f), 448.f); b = fminf(fmaxf(b, -448.f), 448.f); c = fminf(fmaxf(c, -448.f), 448.f); d = fminf(fmaxf(d, -448.f), 448.f);
    int p = 0; p = __builtin_amdgcn_cvt_pk_fp8_f32(a, b, p, false); p = __builtin_amdgcn_cvt_pk_fp8_f32(c, d, p, true); return (unsigned)p; }
__device__ __forceinline__ float bf_lo(unsigned w) { return __uint_as_float(w << 16); }
__device__ __forceinline__ float bf_hi(unsigned w) { return __uint_as_float(w & 0xffff0000u); }

template <bool F8> __device__ __forceinline__ void transpose_tile4(const Frame& F, const float* __restrict__ src, int N, int K, bf16_t* __restrict__ dst, const float* __restrict__ gain, int k0, int n0) {
    LAS float* tile = (LAS float*)F.lds;
    const int r = F.tid >> 4, c4 = F.tid & 15;
    f32x4 v[8]; float g[8];
#pragma unroll
    for (int i = 0; i < 8; ++i) { const int k = r + 32 * i; v[i] = *(const f32x4*)(src + (size_t)(k0 + k) * N + n0 + c4 * 4); g[i] = gain ? gain[k0 + k] : 1.0f; }
#pragma unroll
    for (int i = 0; i < 8; ++i) { const int k = r + 32 * i;
        tile[k * 65 + c4 * 4 + 0] = v[i][0] * g[i]; tile[k * 65 + c4 * 4 + 1] = v[i][1] * g[i]; tile[k * 65 + c4 * 4 + 2] = v[i][2] * g[i]; tile[k * 65 + c4 * 4 + 3] = v[i][3] * g[i]; }
    __syncthreads();
    const int n = F.tid >> 3, k8 = F.tid & 7;
#pragma unroll
    for (int q = 0; q < 4; ++q) { float e[8];
#pragma unroll
        for (int j = 0; j < 8; ++j) e[j] = tile[(q * 64 + k8 * 8 + j) * 65 + n];
        if (F8) { u32x2 w; w.x = pk_fp8x4(e[0] * 2048.0f, e[1] * 2048.0f, e[2] * 2048.0f, e[3] * 2048.0f); w.y = pk_fp8x4(e[4] * 2048.0f, e[5] * 2048.0f, e[6] * 2048.0f, e[7] * 2048.0f);
            *(u32x2*)((unsigned char*)dst + (size_t)(n0 + n) * K + k0 + q * 64 + k8 * 8) = w; }
        else { u32x4 w; w.x = pk_bf16(e[0], e[1]); w.y = pk_bf16(e[2], e[3]); w.z = pk_bf16(e[4], e[5]); w.w = pk_bf16(e[6], e[7]);
            *(u32x4*)(dst + (size_t)(n0 + n) * K + k0 + q * 64 + k8 * 8) = w; } }
    __syncthreads();
}

__device__ __forceinline__ void p0_w2t(const Frame& F, int rank, int nwg) {
    {
        LAS float* SK = (LAS float*)F.lds;
        LAS float* WQ = (LAS float*)(F.lds + 65536);
        for (int u = rank; u < 2 * 16 * 64; u += nwg) {
            const int l = u >> 10, hc = (u >> 6) & 15, k0 = (u & 63) * 64;
            const float* sk = F.a->in[I_PSK] + (size_t)(l * 16 + hc) * 128 * 128;
            const float* wq = F.a->in[I_PWQ] + (size_t)l * DM * 2048 + (size_t)k0 * 2048 + hc * 128;
#pragma unroll
            for (int i = 0; i < 8; ++i) { const int idx = F.tid + NTHR * i, row = idx >> 5, c4 = idx & 31; *(LAS f32x4*)(SK + row * 128 + c4 * 4) = *(const f32x4*)(sk + row * 128 + c4 * 4); }
#pragma unroll
            for (int i = 0; i < 4; ++i) { const int idx = F.tid + NTHR * i, row = idx >> 5, c4 = idx & 31; *(LAS f32x4*)(WQ + row * 132 + c4 * 4) = *(const f32x4*)(wq + (size_t)row * 2048 + c4 * 4); }
            __syncthreads();
            const int k = F.lane, ng = F.wid;
            float acc[16];
#pragma unroll
            for (int j = 0; j < 16; ++j) acc[j] = 0.f;
            for (int d4 = 0; d4 < 32; ++d4) { const f32x4 w = *(const LAS f32x4*)(WQ + k * 132 + d4 * 4);
#pragma unroll
                for (int j = 0; j < 16; ++j) { const f32x4 s = *(const LAS f32x4*)(SK + (ng * 16 + j) * 128 + d4 * 4); acc[j] += w[0] * s[0] + w[1] * s[1] + w[2] * s[2] + w[3] * s[3]; } }
            const float g = F.a->in[I_GFFN][l * DM + k0 + k];
            bf16_t* w2 = (bf16_t*)(F.a->ws + WS_W + (size_t)l * LW_END + LW_W2);
#pragma unroll
            for (int j = 0; j < 16; ++j) w2[(size_t)(hc * 128 + ng * 16 + j) * DM + k0 + k] = (bf16_t)(pk_bf16(acc[j] * g, 0.f) & 0xffffu);
            __syncthreads();
        }
    }
}

__device__ __forceinline__ void p0_a(const Frame& F) {
    constexpr int N_WIN = 16 * 165;
    for (int r = (int)blockIdx.x; r < N_WIN; r += (int)gridDim.x)
        transpose_tile4<true>(F, F.a->in[I_WIN], NIN, DM, (bf16_t*)(F.a->ws + WS_W + LW_WIN), F.a->in[I_GMIX], (r & 15) * 256, (r >> 4) * 64);
    for (int i = (int)blockIdx.x * NTHR + F.tid; i < 2 * 192 * DM / 16; i += (int)gridDim.x * NTHR) { const int l = i / (192 * DM / 16), o = i % (192 * DM / 16);
        *(u32x4*)(F.a->ws + WS_W + (size_t)l * LW_END + LW_WIN + (size_t)NIN * DM + (size_t)o * 16) = (u32x4){0u, 0u, 0u, 0u}; }
}

__device__ __forceinline__ void p0_b(const Frame& F, int rank, int nwg) {
    constexpr int N_WIN = 16 * 165, N_WOUT = 16 * 64, N_UQ = 3 * 24, N_UKV = 2 * 32, N_L = N_WIN + N_WOUT + N_UQ + N_UKV;
    for (int u = N_WIN + rank; u < 2 * N_L; u += nwg) {
        const int l = u / N_L; int r = u % N_L; unsigned char* lw = F.a->ws + WS_W + (size_t)l * LW_END;
        if (r < N_WIN) { transpose_tile4<true>(F, F.a->in[I_WIN] + (size_t)l * DM * NIN, NIN, DM, (bf16_t*)(lw + LW_WIN), F.a->in[I_GMIX] + l * DM, (r & 15) * 256, (r >> 4) * 64); continue; }
        r -= N_WIN;
        if (r < N_WOUT) { transpose_tile4<true>(F, F.a->in[I_WOUT] + (size_t)l * DM * DM, DM, DM, (bf16_t*)(lw + LW_WOUT), nullptr, (r & 15) * 256, (r >> 4) * 64); continue; }
        r -= N_WOUT;
        if (r < N_UQ) { transpose_tile4<false>(F, F.a->in[I_WUQ] + (size_t)l * 768 * 1536, 1536, 768, (bf16_t*)(lw + LW_WUQ), F.a->in[I_GCQ] + l * 768, (r % 3) * 256, (r / 3) * 64); continue; }
        r -= N_UQ;
        transpose_tile4<false>(F, F.a->in[I_WUKV] + (size_t)l * 512 * 2048, 2048, 512, (bf16_t*)(lw + LW_WUKV), F.a->in[I_GCKV] + l * 512, (r & 1) * 256, (r >> 1) * 64);
    }
    {
        constexpr size_t NIT = (size_t)NEXP * 64;
        const size_t stride = (size_t)nwg * NTHR; const int nit = (int)((4 * NIT - (size_t)rank * NTHR + stride - 1) / stride);
        const int slot = (rank * 13) % nit; int it = 0;
        for (size_t base = (size_t)rank * NTHR; base < 4 * NIT; base += stride, ++it) {
            if (it == slot) p0_w2t(F, rank, nwg);
            const size_t i = base + F.tid;
            const int tb = (int)(i / NIT); const size_t o = i % NIT; const int l = tb >> 1, isv = tb & 1; const size_t row = o >> 6; const int ln = (int)(o & 63);
            const float* src = (isv ? F.a->in[I_PV] : F.a->in[I_PU]) + (size_t)l * NEXP * DM + row * DM + 4 * ln; const float* g = F.a->in[I_GFFN] + l * DM + 4 * ln;
            const float sc = isv ? V_SCALE : U_SCALE;
            f32x4 x[16];
#pragma unroll
            for (int c = 0; c < 16; ++c) { x[c] = *(const f32x4*)(src + c * 256); if (!isv) x[c] *= *(const f32x4*)(g + c * 256);
#pragma unroll
                for (int j = 0; j < 4; ++j) x[c][j] = fminf(fmaxf(x[c][j] * sc, -7.5f), 7.5f); }
            u32x4 w[3];
#pragma unroll
            for (int q = 0; q < 2; ++q) { f32x16v s0, s1;
#pragma unroll
                for (int c = 0; c < 8; ++c) { s0[2 * c] = x[8 * q + c][0]; s1[2 * c] = x[8 * q + c][1]; s0[2 * c + 1] = x[8 * q + c][2]; s1[2 * c + 1] = x[8 * q + c][3]; }
                const u32x6 p = __builtin_amdgcn_cvt_scalef32_2xpk16_fp6_f32(s0, s1, 1.0f);
#pragma unroll
                for (int k = 0; k < 6; ++k) w[(6 * q + k) >> 2][(6 * q + k) & 3] = p[k]; }
            unsigned char* dst = F.a->ws + WS_W + (size_t)l * LW_END + (isv ? LW_V : LW_U) + row * 3072 + ln * 48;
#pragma unroll
            for (int k = 0; k < 3; ++k) *(u32x4*)(dst + 16 * k) = w[k];
        }
    }
}

__device__ __forceinline__ void p_norm(const Frame& F, const float* __restrict__ x, bf16_t* __restrict__ hn) {
    for (int t = F.rank * NWAVES + F.wid; t < T; t += F.nwg * NWAVES) {
        const f32x4* xr = (const f32x4*)(x + (size_t)t * DM);
        f32x4 v[16]; float ss = 0.f;
#pragma unroll
        for (int i = 0; i < 16; ++i) { v[i] = xr[i * 64 + F.lane]; ss += v[i][0] * v[i][0] + v[i][1] * v[i][1] + v[i][2] * v[i][2] + v[i][3] * v[i][3]; }
        ss = wsum(ss);
        const float r = rsqrtf(ss * (1.0f / DM) + EPS);
        unsigned* o = (unsigned*)((unsigned char*)hn + (size_t)t * DM); const float r8 = r * HN8_SCALE;
#pragma unroll
        for (int i = 0; i < 16; ++i) o[i * 64 + F.lane] = pk_fp8x4(v[i][0] * r8, v[i][1] * r8, v[i][2] * r8, v[i][3] * r8);
    }
}

__device__ __forceinline__ void unpack16(const u32x4 a, const u32x4 b, float (&x)[16]) {
#pragma unroll
    for (int i = 0; i < 4; ++i) { x[2 * i] = bf_lo(a[i]); x[2 * i + 1] = bf_hi(a[i]); x[8 + 2 * i] = bf_lo(b[i]); x[8 + 2 * i + 1] = bf_hi(b[i]); }
}
__device__ __forceinline__ void p_post1(const Frame& F, int l) {
    const bf16_t* P = (const bf16_t*)(F.ws + WS_P);
    for (int t = F.rank * NWAVES + F.wid; t < T; t += F.nwg * NWAVES) {
        const bf16_t* pr = P + (size_t)t * NINP; const int lane = F.lane;
        u32x2 cq3[3]; u32x4 ckv4;
#pragma unroll
        for (int i = 0; i < 3; ++i) cq3[i] = ((const u32x2*)(pr + 9216 + lane * 12))[i];
        ckv4 = *(const u32x4*)(pr + 9984 + lane * 8);
        {
            u32x2 c[3]; float ss = 0.f;
#pragma unroll
            for (int i = 0; i < 3; ++i) { c[i] = cq3[i]; const float a0 = bf_lo(c[i].x), a1 = bf_hi(c[i].x), a2 = bf_lo(c[i].y), a3 = bf_hi(c[i].y); ss += a0 * a0 + a1 * a1 + a2 * a2 + a3 * a3; }
            ss = wsum(ss); const float r = rsqrtf(ss * (1.0f / 768) + EPS);
            u32x2* d = (u32x2*)((bf16_t*)(F.ws + WS_T2 + TO_CQ) + (size_t)t * 768 + lane * 12);
#pragma unroll
            for (int i = 0; i < 3; ++i) { u32x2 w; w.x = pk_bf16(bf_lo(c[i].x) * r, bf_hi(c[i].x) * r); w.y = pk_bf16(bf_lo(c[i].y) * r, bf_hi(c[i].y) * r); d[i] = w; }
        }
        {
            const u32x4 c = ckv4; float ss = 0.f;
#pragma unroll
            for (int i = 0; i < 4; ++i) { const float a0 = bf_lo(c[i]), a1 = bf_hi(c[i]); ss += a0 * a0 + a1 * a1; }
            ss = wsum(ss); const float r = rsqrtf(ss * (1.0f / 512) + EPS);
            u32x4 w;
#pragma unroll
            for (int i = 0; i < 4; ++i) w[i] = pk_bf16(bf_lo(c[i]) * r, bf_hi(c[i]) * r);
            *(u32x4*)((bf16_t*)(F.ws + WS_T2 + TO_CKV) + (size_t)t * 512 + lane * 8) = w;
        }
    }
}

__device__ __forceinline__ void p_post2(const Frame& F, int l) {
    const bf16_t* QR = (const bf16_t*)(F.ws + WS_O + OO_QRAW); const bf16_t* KVR = (const bf16_t*)(F.ws + WS_O + OO_KVRAW); const bf16_t* P = (const bf16_t*)(F.ws + WS_P);
    bf16_t* QD = (bf16_t*)(F.ws + WS_QKV + QO_QD); bf16_t* KD = (bf16_t*)(F.ws + WS_QKV + QO_KD); bf16_t* VD = (bf16_t*)(F.ws + WS_QKV + QO_VD);
    LAS float* L = (LAS float*)F.lds + F.wid * 3712; LAS float* q = L; LAS float* kv = L + 1536; LAS float* kr = L + 3584; LAS float* cs = L + 3648;
    const float* g0 = F.a->in[I_MLAG] + (size_t)(l * 2 + 0) * 192; const float* g1 = F.a->in[I_MLAG] + (size_t)(l * 2 + 1) * 192;
    const int lane = F.lane;
    for (int t = F.rank * NWAVES + F.wid; t < T; t += F.nwg * NWAVES) {
        const int b = t / S, s = t % S;
        float aq, akv;
        { const bf16_t* pr = P + (size_t)t * NINP; float sq = 0.f, sk = 0.f;
#pragma unroll
          for (int i = 0; i < 3; ++i) { const u32x2 c2 = ((const u32x2*)(pr + 9216 + lane * 12))[i]; const float a0 = bf_lo(c2.x), a1 = bf_hi(c2.x), a2 = bf_lo(c2.y), a3 = bf_hi(c2.y); sq += (a0 * a0 + a1 * a1) + (a2 * a2 + a3 * a3); }
          { const u32x4 c4 = *(const u32x4*)(pr + 9984 + lane * 8);
#pragma unroll
            for (int i = 0; i < 4; ++i) { const float a0 = bf_lo(c4[i]), a1 = bf_hi(c4[i]); sk += a0 * a0 + a1 * a1; } }
          aq = rsqrtf(wave_total(sq) * (1.0f / 768) + EPS); akv = rsqrtf(wave_total(sk) * (1.0f / 512) + EPS); }
#pragma unroll
        for (int i = 0; i < 3; ++i) { const int c = lane + 64 * i; const u32x4 w = *(const u32x4*)(QR + (size_t)t * 1536 + c * 8);
            *(LAS f32x4*)(q + c * 8) = (f32x4){bf_lo(w[0]), bf_hi(w[0]), bf_lo(w[1]), bf_hi(w[1])}; *(LAS f32x4*)(q + c * 8 + 4) = (f32x4){bf_lo(w[2]), bf_hi(w[2]), bf_lo(w[3]), bf_hi(w[3])}; }
#pragma unroll
        for (int i = 0; i < 4; ++i) { const int c = lane + 64 * i; const u32x4 w = *(const u32x4*)(KVR + (size_t)t * 2048 + c * 8);
            *(LAS f32x4*)(kv + c * 8) = (f32x4){bf_lo(w[0]), bf_hi(w[0]), bf_lo(w[1]), bf_hi(w[1])}; *(LAS f32x4*)(kv + c * 8 + 4) = (f32x4){bf_lo(w[2]), bf_hi(w[2]), bf_lo(w[3]), bf_hi(w[3])}; }
        u32x4 vcp[2];
#pragma unroll
        for (int i = 0; i < 2; ++i) { const int c = lane + 64 * i; vcp[i] = *(const u32x4*)(KVR + (size_t)t * 2048 + (c >> 4) * 256 + 128 + (c & 15) * 8); }
        kr[lane] = __uint_as_float(((unsigned)P[(size_t)t * NINP + 10496 + lane]) << 16);
        if (lane < 32) { const float inv = exp2f(-(float)lane * (2.0f / 64.0f) * 13.287712379549449f);
            float rev = (float)s * inv * 0.15915494309189535f; rev -= rintf(rev);
            cs[lane] = __builtin_amdgcn_cosf(rev); cs[32 + lane] = __builtin_amdgcn_sinf(rev); }
        asm volatile("s_waitcnt lgkmcnt(0)" ::: "memory");
        const int h = lane >> 3, part = lane & 7;
        float qss = 0.f, kss = 0.f;
#pragma unroll
        for (int j = 0; j < 24; ++j) { const float a = q[h * 192 + part + 8 * j]; qss += a * a; }
#pragma unroll
        for (int j = 0; j < 16; ++j) { const float a = kv[h * 256 + part + 8 * j]; kss += a * a; }
        kss *= akv * akv;
#pragma unroll
        for (int j = 0; j < 8; ++j) { const float a = kr[part + 8 * j]; kss += a * a; }
        qss = sum8(qss); kss = sum8(kss);
        const float rq = rsqrtf(aq * aq * qss * (1.0f / 192) + EPS) * aq * 0.07216878364870322f;
        const float rk = rsqrtf(kss * (1.0f / 192) + EPS);
#pragma unroll
        for (int i = 0; i < 3; ++i) {
            const int c = lane + 64 * i, hh = c / 24, e0 = (c % 24) * 8;
            const float rqh = __int_as_float(__builtin_amdgcn_ds_bpermute(hh * 32, __float_as_int(rq))), rkh = __int_as_float(__builtin_amdgcn_ds_bpermute(hh * 32, __float_as_int(rk)));
            float vq[8], vk[8];
#pragma unroll
            for (int j = 0; j < 8; ++j) {
                const int e = e0 + j;
                if (e0 < 128) { vq[j] = q[hh * 192 + e] * g0[e] * rqh; vk[j] = kv[hh * 256 + e] * akv * g1[e] * rkh; }
                else { const int i2 = (e - 128) & 31; const float co = cs[i2], si = cs[32 + i2];
                    const float q1 = q[hh * 192 + 128 + i2] * g0[128 + i2], q2 = q[hh * 192 + 160 + i2] * g0[160 + i2];
                    const float k1 = kr[i2] * g1[128 + i2], k2 = kr[32 + i2] * g1[160 + i2];
                    if (e0 < 160) { vq[j] = (q1 * co - q2 * si) * rqh; vk[j] = (k1 * co - k2 * si) * rkh; }
                    else { vq[j] = (q2 * co + q1 * si) * rqh; vk[j] = (k2 * co + k1 * si) * rkh; } }
            }
            u32x4 wq, wk;
#pragma unroll
            for (int j = 0; j < 4; ++j) { wq[j] = pk_bf16(vq[2 * j], vq[2 * j + 1]); wk[j] = pk_bf16(vk[2 * j], vk[2 * j + 1]); }
            const size_t o = ((size_t)(b * 8 + hh) * S + s) * 192 + e0;
            *(u32x4*)(QD + o) = wq; *(u32x4*)(KD + o) = wk;
        }
#pragma unroll
        for (int i = 0; i < 2; ++i) { const int c = lane + 64 * i, hh = c >> 4, e0 = (c & 15) * 8;
            u32x4 wv;
#pragma unroll
            for (int j = 0; j < 4; ++j) wv[j] = pk_bf16(bf_lo(vcp[i][j]) * akv, bf_hi(vcp[i][j]) * akv);
            *(u32x4*)(VD + ((size_t)(b * 8 + hh) * S + s) * 128 + e0) = wv; }
        asm volatile("s_waitcnt lgkmcnt(0)" ::: "memory");
    }
}

constexpr int SHM_V = 64 * 128 * 2, SHM_KMAX = 64 * 192 * 2, ATT_WS = 2 * SHM_V + 2 * SHM_KMAX, ATT_RPB = ATT_WS + NWAVES * 64 * 4, ATT_END = ATT_RPB + 15 * 128 * 4;
constexpr float LOG2E = 1.4426950408889634f, ATT_THR = 8.0f;
struct AP {
    const bf16_t* Q; const bf16_t* K; const bf16_t* V;
    bf16_t* O; int opitch; int o8; float* lse;
    int NT;
    int dil, l0, r0, qmask, qshift;
    int lk0, jmask, jshift;
    float nslope;
    int qinfo;
};
__device__ __forceinline__ int crow(int r, int hi) { return (r & 3) + 8 * (r >> 2) + 4 * hi; }
template <int DQK> __device__ __forceinline__ int kswz(int row) { return (DQK == 128 ? (row & 15) : ((row >> 1) & 7)) << 4; }
__device__ __forceinline__ int v_st(int k, int c) { const int kk = (k & ~0xC) | ((k & 4) << 1) | ((k & 8) >> 1); return ((kk >> 3) * 4 + (c >> 5)) * 512 + ((kk & 7) * 32 + (c & 31)) * 2; }
__device__ __forceinline__ int v_rd_base(int lane) { return ((lane & 3) << 3) | (((lane >> 2) & 3) << 6) | (((lane >> 4) & 1) << 5) | (((lane >> 5) & 1) << 8); }
constexpr int v_rd_off(int d0, int ks, int half) { return d0 * 512 + ks * 4096 + half * 2048; }
template <int OFF> __device__ __forceinline__ s16x4 tr_read(int vb) { s16x4 r; asm volatile("ds_read_b64_tr_b16 %0, %1 offset:%2" : "=&v"(r) : "v"(vb), "i"(OFF) : "memory"); return r; }
template <int D0> __device__ __forceinline__ void pv_one(f32x16& od, int vb, bf16x8 pa0, bf16x8 pa1, bf16x8 pa2, bf16x8 pa3) {
    const s16x4 l0 = tr_read<v_rd_off(D0, 0, 0)>(vb), h0 = tr_read<v_rd_off(D0, 0, 1)>(vb), l1 = tr_read<v_rd_off(D0, 1, 0)>(vb), h1 = tr_read<v_rd_off(D0, 1, 1)>(vb);
    const s16x4 l2 = tr_read<v_rd_off(D0, 2, 0)>(vb), h2 = tr_read<v_rd_off(D0, 2, 1)>(vb), l3 = tr_read<v_rd_off(D0, 3, 0)>(vb), h3 = tr_read<v_rd_off(D0, 3, 1)>(vb);
    asm volatile("s_waitcnt lgkmcnt(0)" ::: "memory"); __builtin_amdgcn_sched_barrier(0);
#define MK_PK(L, H) (bf16x8){L[0], L[1], L[2], L[3], H[0], H[1], H[2], H[3]}
    od = __builtin_amdgcn_mfma_f32_32x32x16_bf16(pa0, MK_PK(l0, h0), od, 0, 0, 0);
    od = __builtin_amdgcn_mfma_f32_32x32x16_bf16(pa1, MK_PK(l1, h1), od, 0, 0, 0);
    od = __builtin_amdgcn_mfma_f32_32x32x16_bf16(pa2, MK_PK(l2, h2), od, 0, 0, 0);
    od = __builtin_amdgcn_mfma_f32_32x32x16_bf16(pa3, MK_PK(l3, h3), od, 0, 0, 0);
#undef MK_PK
}

#define MK_TR8(D0, vb, L0, H0, L1, H1, L2, H2, L3, H3) do { L0 = tr_read<v_rd_off(D0, 0, 0)>(vb); H0 = tr_read<v_rd_off(D0, 0, 1)>(vb); L1 = tr_read<v_rd_off(D0, 1, 0)>(vb); H1 = tr_read<v_rd_off(D0, 1, 1)>(vb); \
        L2 = tr_read<v_rd_off(D0, 2, 0)>(vb); H2 = tr_read<v_rd_off(D0, 2, 1)>(vb); L3 = tr_read<v_rd_off(D0, 3, 0)>(vb); H3 = tr_read<v_rd_off(D0, 3, 1)>(vb); } while (0)
#define MK_PKV(L, H) (bf16x8){L[0], L[1], L[2], L[3], H[0], H[1], H[2], H[3]}
#define MK_MM4(od, L0, H0, L1, H1, L2, H2, L3, H3) do { od = __builtin_amdgcn_mfma_f32_32x32x16_bf16(pa0, MK_PKV(L0, H0), od, 0, 0, 0); od = __builtin_amdgcn_mfma_f32_32x32x16_bf16(pa1, MK_PKV(L1, H1), od, 0, 0, 0); \
        od = __builtin_amdgcn_mfma_f32_32x32x16_bf16(pa2, MK_PKV(L2, H2), od, 0, 0, 0); od = __builtin_amdgcn_mfma_f32_32x32x16_bf16(pa3, MK_PKV(L3, H3), od, 0, 0, 0); } while (0)
__device__ __forceinline__ void pv_all(f32x16 (&o)[4], int vb, bf16x8 pa0, bf16x8 pa1, bf16x8 pa2, bf16x8 pa3) {
    s16x4 a0, a1, a2, a3, a4, a5, a6, a7, b0, b1, b2, b3, b4, b5, b6, b7;
    __builtin_amdgcn_sched_barrier(0);
    MK_TR8(0, vb, a0, a1, a2, a3, a4, a5, a6, a7);
    MK_TR8(1, vb, b0, b1, b2, b3, b4, b5, b6, b7);
    asm volatile("s_waitcnt lgkmcnt(8)" : "+v"(a0), "+v"(a1), "+v"(a2), "+v"(a3), "+v"(a4), "+v"(a5), "+v"(a6), "+v"(a7) :: "memory"); __builtin_amdgcn_sched_barrier(0);
    MK_MM4(o[0], a0, a1, a2, a3, a4, a5, a6, a7);
    __builtin_amdgcn_sched_barrier(0);
    MK_TR8(2, vb, a0, a1, a2, a3, a4, a5, a6, a7);
    asm volatile("s_waitcnt lgkmcnt(8)" : "+v"(b0), "+v"(b1), "+v"(b2), "+v"(b3), "+v"(b4), "+v"(b5), "+v"(b6), "+v"(b7) :: "memory"); __builtin_amdgcn_sched_barrier(0);
    MK_MM4(o[1], b0, b1, b2, b3, b4, b5, b6, b7);
    __builtin_amdgcn_sched_barrier(0);
    MK_TR8(3, vb, b0, b1, b2, b3, b4, b5, b6, b7);
    asm volatile("s_waitcnt lgkmcnt(8)" : "+v"(a0), "+v"(a1), "+v"(a2), "+v"(a3), "+v"(a4), "+v"(a5), "+v"(a6), "+v"(a7) :: "memory"); __builtin_amdgcn_sched_barrier(0);
    MK_MM4(o[2], a0, a1, a2, a3, a4, a5, a6, a7);
    asm volatile("s_waitcnt lgkmcnt(0)" : "+v"(b0), "+v"(b1), "+v"(b2), "+v"(b3), "+v"(b4), "+v"(b5), "+v"(b6), "+v"(b7) :: "memory"); __builtin_amdgcn_sched_barrier(0);
    MK_MM4(o[3], b0, b1, b2, b3, b4, b5, b6, b7);
}
#undef MK_TR8
#undef MK_MM4
#undef MK_PKV


constexpr unsigned QN = 448u, QEND = 0xffffu;
constexpr int LDS_QS = LDS_XB + 64;
__device__ __forceinline__ unsigned q_pop(unsigned* ctr, unsigned q) {
    unsigned v = xb_add(&ctr[64 * q], 1u);
    if (v < QN) return (q << 9) | v;
    for (;;) {
        unsigned best = 0xffffffffu, bq = 0u;
#pragma unroll
        for (unsigned j = 0; j < (unsigned)NB; ++j) { const unsigned c = xb_ld(&ctr[64 * j]); if (c < best) { best = c; bq = j; } }
        if (best >= QN) return QEND;
        v = xb_add(&ctr[64 * bq], 1u);
        if (v < QN) return (bq << 9) | v;
    }
}
#define MK_QHOOK() do { if (tid == 0) { const unsigned nx_ = q_pop((unsigned*)(F.a->ws + WS_CTL) + 12288 + 256 * (p.qinfo >> 8), (unsigned)(p.qinfo >> 1) & 3u); \
        *(volatile LAS unsigned*)(lds + LDS_QS + 4 * (p.qinfo & 1)) = nx_; } } while (0)

template <int MODE, int DQK>
__device__ __forceinline__ void attn_unit(const Frame& F, const AP p) {
    constexpr int KS = DQK / 16, PITCH = DQK * 2, SHMK = 64 * PITCH, KCH = DQK / 64;
    int tid_ = F.tid; asm volatile("" : "+v"(tid_));
    const int tid = tid_, wid = __builtin_amdgcn_readfirstlane(tid >> 6), lane = tid & 63, r32 = lane & 31, hi = lane >> 5;
    LAS char* lds = (LAS char*)F.lds;
    LAS char* V_lds = lds; LAS char* K_lds = lds + 2 * SHM_V;
    LAS float* wsl = (LAS float*)(lds + ATT_WS) + wid * 64; LAS float* li_l = wsl; LAS float* al_l = wsl + 32;
    const LAS float* rpb = (const LAS float*)(lds + ATT_RPB);
    float m_reg = -1e30f, l_reg = 0.f; f32x16 o[4];
#pragma unroll
    for (int d = 0; d < 4; ++d) o[d] = f32x16{};
    const int qi = wid * 32 + r32;
    const int tq = p.dil * (p.l0 + (qi & p.qmask)) + p.r0 + (qi >> p.qshift);
    bf16x8 qr[KS];
    { const bf16_t* Qw = p.Q + (size_t)tq * DQK + hi * 8;
#pragma unroll
      for (int d0 = 0; d0 < KS; ++d0) qr[d0] = *(const bf16x8*)(Qw + d0 * 16); }
    const int sr = tid >> 4, sc = (tid & 15) * 8, vst0 = v_st(sr, sc), vst1 = v_st(32 + sr, sc);
    const int vb0 = (int)(uintptr_t)V_lds + v_rd_base(lane);
    int krow[KCH], kcol[KCH];
#pragma unroll
    for (int i = 0; i < KCH; ++i) { const int c = tid + NTHR * i; krow[i] = c / (DQK / 8); kcol[i] = c % (DQK / 8); }
    u32x4 vs0, vs1, ksr[KCH];
#define ATT_TOK(j, row) (p.dil * (p.lk0 + 64 * ((j) & p.jmask) + (row)) + p.r0 + ((j) >> p.jshift))
#define ATT_CLAMP(t) ((t) < 0 ? 0 : ((t) > S - 1 ? S - 1 : (t)))
#define ATT_SLOAD(j) do { { const int t0 = ATT_CLAMP(ATT_TOK(j, sr)), t1 = ATT_CLAMP(ATT_TOK(j, 32 + sr)); \
        vs0 = *(const u32x4*)(p.V + (size_t)t0 * 128 + sc); vs1 = *(const u32x4*)(p.V + (size_t)t1 * 128 + sc); } \
        _Pragma("unroll") for (int _i = 0; _i < KCH; ++_i) { const int tk_ = ATT_CLAMP(ATT_TOK(j, krow[_i])); ksr[_i] = *(const u32x4*)(p.K + (size_t)tk_ * DQK + kcol[_i] * 8); } } while (0)
#define ATT_SWRITE(b) do { *(LAS u32x4*)(V_lds + (b) * SHM_V + vst0) = vs0; *(LAS u32x4*)(V_lds + (b) * SHM_V + vst1) = vs1; \
        _Pragma("unroll") for (int _i = 0; _i < KCH; ++_i) *(LAS u32x4*)(K_lds + (b) * SHMK + krow[_i] * PITCH + ((kcol[_i] * 16) ^ kswz<DQK>(krow[_i]))) = ksr[_i]; } while (0)
    ATT_SLOAD(0); MK_QHOOK(); ATT_SWRITE(0); __syncthreads();
    int na_rq = 0, na_cq = 0, na_rs = 0, na_cs = 0;
    if (MODE == 3) { na_rq = tq >> 6; na_cq = tq & 63; na_rs = na_rq - 4; na_rs = na_rs < 0 ? 0 : (na_rs > 24 ? 24 : na_rs); na_cs = na_cq - 8; na_cs = na_cs < 0 ? 0 : (na_cs > 48 ? 48 : na_cs); }
    for (int j = 0; j < p.NT; ++j) {
        const int cur = j & 1;
        if (j + 1 < p.NT) ATT_SLOAD(j + 1);
        const int kt0 = ATT_TOK(j, 0);
        bool skip = false;
        if (MODE == 2) { const int tq_lo = __builtin_amdgcn_readfirstlane(tq), tq_hi = tq_lo + 31 * p.dil, lim = 64 * p.dil;
            skip = (kt0 > tq_hi + lim) || (kt0 + 63 * p.dil < tq_lo - lim) || (((kt0 - tq_lo) & (p.dil - 1)) != 0); }
        if (MODE == 3) { const int rs_u = __builtin_amdgcn_readfirstlane(na_rs), rk = kt0 >> 6; skip = (rk < rs_u) || (rk >= rs_u + 8); }
        if (!skip) {
        f32x16 p0 = f32x16{}, p1 = f32x16{};
        { const LAS char* Ks = K_lds + cur * SHMK + r32 * PITCH; const int sw = kswz<DQK>(r32);
          bf16x8 c0 = *(const LAS bf16x8*)(Ks + ((hi * 16) ^ sw)), c1 = *(const LAS bf16x8*)(Ks + 32 * PITCH + ((hi * 16) ^ sw));
#pragma unroll
          for (int d0 = 0; d0 < KS; ++d0) { bf16x8 n0 = c0, n1 = c1;
            if (d0 + 1 < KS) { const int cb = (((d0 + 1) * 16 + hi * 8) * 2) ^ sw; n0 = *(const LAS bf16x8*)(Ks + cb); n1 = *(const LAS bf16x8*)(Ks + 32 * PITCH + cb); }
            __builtin_amdgcn_sched_barrier(0);
            p0 = __builtin_amdgcn_mfma_f32_32x32x16_bf16(c0, qr[d0], p0, 0, 0, 0);
            p1 = __builtin_amdgcn_mfma_f32_32x32x16_bf16(c1, qr[d0], p1, 0, 0, 0);
            __builtin_amdgcn_sched_barrier(0);
            c0 = n0; c1 = n1; } }
        if (MODE == 1) {
            const float base = (float)(kt0 + 4 * hi - tq);
#pragma unroll
            for (int r = 0; r < 16; ++r) { const float c = (float)((r & 3) + 8 * (r >> 2)); p0[r] = fmaf(fabsf(base + c), p.nslope, p0[r]); p1[r] = fmaf(fabsf(base + c + 32.0f), p.nslope, p1[r]); }
        }
        if (MODE == 2) {
            const int lim = 64 * p.dil, dm = p.dil - 1;
#pragma unroll
            for (int r = 0; r < 16; ++r) {
#pragma unroll
                for (int hf = 0; hf < 2; ++hf) { const int ki = crow(r, hi) + 32 * hf, tk = kt0 + ki * p.dil, d = tk - tq, ad = d < 0 ? -d : d;
                    const bool ok = ((unsigned)tk < (unsigned)S) && (ad <= lim) && ((d & dm) == 0);
                    if (hf) p1[r] = ok ? fmaf((float)ad, p.nslope, p1[r]) : -INFINITY; else p0[r] = ok ? fmaf((float)ad, p.nslope, p0[r]) : -INFINITY; } }
        }
        if (MODE == 3) {
            asm volatile("" : "+v"(na_cq), "+v"(na_cs));
            const int rk = kt0 >> 6; const bool rowok = (rk >= na_rs) && (rk < na_rs + 8); int ri = rk - na_rq + 7; ri = ri < 0 ? 0 : (ri > 14 ? 14 : ri);
            const LAS float* rb = rpb + ri * 128 + (63 - na_cq) + 4 * hi;
            const int cw = 4 * hi - na_cs;
#pragma unroll
            for (int r = 0; r < 16; ++r) {
#pragma unroll
                for (int hf = 0; hf < 2; ++hf) { const int c0 = (r & 3) + 8 * (r >> 2) + 32 * hf;
                    const bool ok = rowok && ((unsigned)(cw + c0) < 16u);
                    const float bv = rb[c0];
                    if (hf) p1[r] = ok ? p1[r] + bv : -INFINITY; else p0[r] = ok ? p0[r] + bv : -INFINITY; } }
        }
        float pmax = p0[0];
#pragma unroll
        for (int r = 1; r < 16; ++r) pmax = fmaxf(pmax, p0[r]);
#pragma unroll
        for (int r = 0; r < 16; ++r) pmax = fmaxf(pmax, p1[r]);
        { auto rr = __builtin_amdgcn_permlane32_swap(__float_as_uint(pmax), __float_as_uint(pmax), false, false); pmax = fmaxf(__uint_as_float(rr[0]), __uint_as_float(rr[1])); }
        float mn, alpha;
        if (__all(pmax - m_reg <= ATT_THR)) { mn = m_reg; alpha = 1.f; }
        else { mn = fmaxf(m_reg, pmax); alpha = __builtin_amdgcn_exp2f((m_reg - mn) * LOG2E); m_reg = mn; }
        const float mnC = -mn * LOG2E;
#pragma unroll
        for (int r = 0; r < 16; ++r) { p0[r] = __builtin_amdgcn_exp2f(fmaf(p0[r], LOG2E, mnC)); p1[r] = __builtin_amdgcn_exp2f(fmaf(p1[r], LOG2E, mnC)); }
        float ps = 0.f;
#pragma unroll
        for (int r = 0; r < 16; ++r) ps += p0[r];
#pragma unroll
        for (int r = 0; r < 16; ++r) ps += p1[r];
        { auto rr = __builtin_amdgcn_permlane32_swap(__float_as_uint(ps), __float_as_uint(ps), false, false); ps = __uint_as_float(rr[0]) + __uint_as_float(rr[1]); }
        l_reg = l_reg * alpha + ps;
        bf16x8 pa0, pa1, pa2, pa3;
#define ATT_PK4(P, BASE, OUT) do { unsigned a0 = pk_bf16(P[BASE + 0], P[BASE + 1]), a1 = pk_bf16(P[BASE + 2], P[BASE + 3]); \
        unsigned b0_ = pk_bf16(P[BASE + 4], P[BASE + 5]), b1_ = pk_bf16(P[BASE + 6], P[BASE + 7]); \
        auto r0_ = __builtin_amdgcn_permlane32_swap(a0, b0_, false, false); auto r1_ = __builtin_amdgcn_permlane32_swap(a1, b1_, false, false); \
        u32x4 w_ = {r0_[0], r1_[0], r0_[1], r1_[1]}; OUT = *reinterpret_cast<bf16x8*>(&w_); } while (0)
        ATT_PK4(p0, 0, pa0); ATT_PK4(p0, 8, pa1); ATT_PK4(p1, 0, pa2); ATT_PK4(p1, 8, pa3);
#undef ATT_PK4
        if (__any(alpha < 1.f)) { if (hi == 0) al_l[r32] = alpha; asm volatile("s_waitcnt lgkmcnt(0)" ::: "memory");
#pragma unroll
            for (int d = 0; d < 4; ++d)
#pragma unroll
                for (int r = 0; r < 16; ++r) o[d][r] *= al_l[crow(r, hi)]; }
        { const int vb = vb0 + cur * SHM_V;
          pv_all(o, vb, pa0, pa1, pa2, pa3); }
        }
        if (j + 1 < p.NT) ATT_SWRITE(cur ^ 1);
        __syncthreads();
    }
    if (hi == 0) li_l[r32] = l_reg;
    asm volatile("s_waitcnt lgkmcnt(0)" ::: "memory");
    if (p.lse != nullptr && hi == 0) p.lse[(size_t)tq * 8] = m_reg + __logf(l_reg);
#pragma unroll
    for (int r = 0; r < 16; ++r) { const int orow = crow(r, hi), qo = wid * 32 + orow; const int to = p.dil * (p.l0 + (qo & p.qmask)) + p.r0 + (qo >> p.qshift);
        const float lv = li_l[orow], rl = lv > 0.f ? 1.0f / lv : 0.f;
        bf16_t* orow_p = p.O + (size_t)to * p.opitch + r32;
#pragma unroll
        for (int d0 = 0; d0 < 4; ++d0) { const float ov = o[d0][r] * rl; if (p.o8) ((unsigned char*)p.O)[(size_t)to * p.opitch + r32 + d0 * 32] = (unsigned char)(pk_fp8x4(ov * O8_SCALE, 0.f, 0.f, 0.f) & 0xffu); else orow_p[d0 * 32] = (bf16_t)(pk_bf16(ov, 0.f) & 0xffffu); } }
    asm volatile("s_waitcnt lgkmcnt(0)" ::: "memory");
#undef ATT_TOK
#undef ATT_CLAMP
#undef ATT_SLOAD
#undef ATT_SWRITE
}


template <int MODE, int DQK>
__device__ __forceinline__ void attn_unit_p(const Frame& F, const AP p) {
    constexpr int KS = DQK / 16, PITCH = DQK * 2, SHMK = 64 * PITCH, KCH = DQK / 64;
    int tid_ = F.tid; asm volatile("" : "+v"(tid_));
    const int tid = tid_, wid = __builtin_amdgcn_readfirstlane(tid >> 6), lane = tid & 63, r32 = lane & 31, hi = lane >> 5;
    LAS char* lds = (LAS char*)F.lds;
    LAS char* V_lds = lds; LAS char* K_lds = lds + 2 * SHM_V;
    LAS float* wsl = (LAS float*)(lds + ATT_WS) + wid * 64; LAS float* li_l = wsl; LAS float* al_l = wsl + 32;
    float m_reg = -1e30f, l_reg = 0.f; f32x16 o[4];
#pragma unroll
    for (int d = 0; d < 4; ++d) o[d] = f32x16{};
    const int tq = p.l0 + wid * 32 + r32;
    bf16x8 qr[KS];
    { const bf16_t* Qw = p.Q + (size_t)tq * DQK + hi * 8;
#pragma unroll
      for (int d0 = 0; d0 < KS; ++d0) qr[d0] = *(const bf16x8*)(Qw + d0 * 16); }
    const int sr = tid >> 4, sc = (tid & 15) * 8, vst0 = v_st(sr, sc), vst1 = v_st(32 + sr, sc);
    const int vb0 = (int)(uintptr_t)V_lds + v_rd_base(lane);
    int krow[KCH], kcol[KCH];
#pragma unroll
    for (int i = 0; i < KCH; ++i) { const int c = tid + NTHR * i; krow[i] = c / (DQK / 8); kcol[i] = c % (DQK / 8); }
    u32x4 vsE0, vsE1, ksE[KCH], vsO0, vsO1, ksO[KCH];
#define AP_SLOAD(S, j) do { const int t0_ = p.lk0 + 64 * (j); vs##S##0 = *(const u32x4*)(p.V + (size_t)(t0_ + sr) * 128 + sc); vs##S##1 = *(const u32x4*)(p.V + (size_t)(t0_ + 32 + sr) * 128 + sc); \
        _Pragma("unroll") for (int _i = 0; _i < KCH; ++_i) ks##S[_i] = *(const u32x4*)(p.K + (size_t)(t0_ + krow[_i]) * DQK + kcol[_i] * 8); } while (0)
#define AP_SWRITE(b, S) do { *(LAS u32x4*)(V_lds + (b) * SHM_V + vst0) = vs##S##0; *(LAS u32x4*)(V_lds + (b) * SHM_V + vst1) = vs##S##1; \
        _Pragma("unroll") for (int _i = 0; _i < KCH; ++_i) *(LAS u32x4*)(K_lds + (b) * SHMK + krow[_i] * PITCH + ((kcol[_i] * 16) ^ kswz<DQK>(krow[_i]))) = ks##S[_i]; } while (0)
#define AP_QKT(P0, P1, b) do { P0 = f32x16{}; P1 = f32x16{}; const LAS char* Ks_ = K_lds + (b) * SHMK + r32 * PITCH; const int sw_ = kswz<DQK>(r32); \
        bf16x8 c0_ = *(const LAS bf16x8*)(Ks_ + ((hi * 16) ^ sw_)), c1_ = *(const LAS bf16x8*)(Ks_ + 32 * PITCH + ((hi * 16) ^ sw_)); \
        _Pragma("unroll") for (int d0 = 0; d0 < KS; ++d0) { bf16x8 n0_ = c0_, n1_ = c1_; \
            if (d0 + 1 < KS) { const int cb_ = (((d0 + 1) * 16 + hi * 8) * 2) ^ sw_; n0_ = *(const LAS bf16x8*)(Ks_ + cb_); n1_ = *(const LAS bf16x8*)(Ks_ + 32 * PITCH + cb_); } \
            P0 = __builtin_amdgcn_mfma_f32_32x32x16_bf16(c0_, qr[d0], P0, 0, 0, 0); P1 = __builtin_amdgcn_mfma_f32_32x32x16_bf16(c1_, qr[d0], P1, 0, 0, 0); c0_ = n0_; c1_ = n1_; } } while (0)
#define AP_PARTIAL(P0, P1, j, MN, AL) do { \
        if (MODE == 1) { const float base_ = (float)(p.lk0 + 64 * (j) + 4 * hi - tq); \
            _Pragma("unroll") for (int r = 0; r < 16; ++r) { const float c_ = (float)((r & 3) + 8 * (r >> 2)); P0[r] = fmaf(fabsf(base_ + c_), p.nslope, P0[r]); P1[r] = fmaf(fabsf(base_ + c_ + 32.0f), p.nslope, P1[r]); } } \
        float pmax_ = P0[0]; \
        _Pragma("unroll") for (int r = 1; r < 16; ++r) pmax_ = fmaxf(pmax_, P0[r]); \
        _Pragma("unroll") for (int r = 0; r < 16; ++r) pmax_ = fmaxf(pmax_, P1[r]); \
        { auto rr_ = __builtin_amdgcn_permlane32_swap(__float_as_uint(pmax_), __float_as_uint(pmax_), false, false); pmax_ = fmaxf(__uint_as_float(rr_[0]), __uint_as_float(rr_[1])); } \
        if (__builtin_expect(__all(pmax_ - m_reg <= ATT_THR), 1)) { MN = m_reg; AL = 1.f; } \
        else { MN = fmaxf(m_reg, pmax_); AL = __builtin_amdgcn_exp2f((m_reg - MN) * LOG2E); m_reg = MN; } \
        { const float mnC_ = -MN * LOG2E; \
          _Pragma("unroll") for (int r = 0; r < 16; ++r) { P0[r] = fmaf(P0[r], LOG2E, mnC_); P1[r] = fmaf(P1[r], LOG2E, mnC_); } \
          _Pragma("unroll") for (int r = 0; r < 16; ++r) P0[r] = __builtin_amdgcn_exp2f(P0[r]); } } while (0)
#define AP_PK4(P, BASE, OUT) do { unsigned a0 = pk_bf16(P[BASE + 0], P[BASE + 1]), a1 = pk_bf16(P[BASE + 2], P[BASE + 3]); \
        unsigned b0_ = pk_bf16(P[BASE + 4], P[BASE + 5]), b1_ = pk_bf16(P[BASE + 6], P[BASE + 7]); \
        auto r0_ = __builtin_amdgcn_permlane32_swap(a0, b0_, false, false); auto r1_ = __builtin_amdgcn_permlane32_swap(a1, b1_, false, false); \
        u32x4 w_ = {r0_[0], r1_[0], r0_[1], r1_[1]}; OUT = *reinterpret_cast<bf16x8*>(&w_); } while (0)
#define AP_FINISH(P0, P1, AL) do { \
        _Pragma("unroll") for (int r = 0; r < 16; ++r) P1[r] = __builtin_amdgcn_exp2f(P1[r]); \
        float ps_ = 0.f; \
        _Pragma("unroll") for (int r = 0; r < 16; ++r) ps_ += P0[r]; \
        _Pragma("unroll") for (int r = 0; r < 16; ++r) ps_ += P1[r]; \
        { auto rr_ = __builtin_amdgcn_permlane32_swap(__float_as_uint(ps_), __float_as_uint(ps_), false, false); ps_ = __uint_as_float(rr_[0]) + __uint_as_float(rr_[1]); } \
        l_reg = l_reg * (AL) + ps_; \
        AP_PK4(P0, 0, pa0); AP_PK4(P0, 8, pa1); AP_PK4(P1, 0, pa2); AP_PK4(P1, 8, pa3); } while (0)
#define AP_PV(b) do { const int vb_ = vb0 + (b) * SHM_V; pv_all(o, vb_, pa0, pa1, pa2, pa3); } while (0)
#define AP_RESC(a) do { if (__any((a) < 1.f)) { if (hi == 0) al_l[r32] = (a); asm volatile("s_waitcnt lgkmcnt(0)" ::: "memory"); \
        _Pragma("unroll") for (int d = 0; d < 4; ++d) _Pragma("unroll") for (int r = 0; r < 16; ++r) o[d][r] *= al_l[crow(r, hi)]; } } while (0)
#define AP_SB() __builtin_amdgcn_sched_barrier(0)
    f32x16 pA0, pA1, pB0, pB1; float mnA, mnB, alA, alB; bf16x8 pa0, pa1, pa2, pa3; const int NT = p.NT;
    AP_SLOAD(E, 0); MK_QHOOK(); AP_SWRITE(0, E); __syncthreads();
    AP_QKT(pA0, pA1, 0); AP_PARTIAL(pA0, pA1, 0, mnA, alA);
    AP_SLOAD(O, 1); if (2 < NT) AP_SLOAD(E, 2);
    AP_SWRITE(1, O); __syncthreads();
    for (int j = 1; j + 1 < NT; j += 2) {
        AP_SB(); AP_QKT(pB0, pB1, 1); AP_FINISH(pA0, pA1, alA); AP_SB();
        AP_SLOAD(O, j + 2); AP_SB();
        AP_PV(0); AP_PARTIAL(pB0, pB1, j, mnB, alB);
        __syncthreads(); AP_SWRITE(0, E);
        AP_RESC(alB); __syncthreads();
        AP_SB(); AP_QKT(pA0, pA1, 0); AP_FINISH(pB0, pB1, alB); AP_SB();
        if (j + 3 < NT) AP_SLOAD(E, j + 3); AP_SB();
        AP_PV(1); AP_PARTIAL(pA0, pA1, j + 1, mnA, alA);
        __syncthreads(); AP_SWRITE(1, O);
        AP_RESC(alA); __syncthreads();
    }
    AP_SB(); AP_QKT(pB0, pB1, 1); AP_FINISH(pA0, pA1, alA); AP_SB();
    AP_PV(0); AP_PARTIAL(pB0, pB1, NT - 1, mnB, alB);
    __syncthreads(); AP_RESC(alB);
    AP_FINISH(pB0, pB1, alB); AP_SB();
    AP_PV(1);
    (void)mnA; (void)mnB;
    if (hi == 0) li_l[r32] = l_reg;
    asm volatile("s_waitcnt lgkmcnt(0)" ::: "memory");
#pragma unroll
    for (int r = 0; r < 16; ++r) { const int orow = crow(r, hi), to = p.l0 + wid * 32 + orow;
        const float lv = li_l[orow], rl = lv > 0.f ? 1.0f / lv : 0.f;
        bf16_t* orow_p = p.O + (size_t)to * p.opitch + r32;
#pragma unroll
        for (int d0 = 0; d0 < 4; ++d0) { const float ov = o[d0][r] * rl; if (p.o8) ((unsigned char*)p.O)[(size_t)to * p.opitch + r32 + d0 * 32] = (unsigned char)(pk_fp8x4(ov * O8_SCALE, 0.f, 0.f, 0.f) & 0xffu); else orow_p[d0 * 32] = (bf16_t)(pk_bf16(ov, 0.f) & 0xffffu); } }
    asm volatile("s_waitcnt lgkmcnt(0)" ::: "memory");
    __syncthreads();
#undef AP_SLOAD
#undef AP_SWRITE
#undef AP_QKT
#undef AP_PARTIAL
#undef AP_PK4
#undef AP_FINISH
#undef AP_PV
#undef AP_RESC
#undef AP_SB
}

__device__ __forceinline__ void p_attention(const Frame& F, int l, int gs) {
    unsigned char* qkv = F.ws + WS_QKV;
    constexpr int N_MLA = 512, N_DIFF = 1024, N_NA = 512, N_D1 = 512, N_D4 = 512, N_D16 = 512, N_ALL = N_MLA + N_DIFF + N_NA + N_D1 + N_D4 + N_D16;
    static_assert(N_ALL == 8 * (int)QN, "queue size");
    const int ls = 2 * l + gs;
    unsigned* qctr = (unsigned*)(F.a->ws + WS_CTL) + 12288 + 256 * ls;
    volatile LAS unsigned* qs = (volatile LAS unsigned*)(F.lds + LDS_QS);
    { int t_ = F.tid; asm volatile("" : "+v"(t_)); if (t_ == 0) qs[0] = q_pop(qctr, xb_xcc_id() & 3u); }
    __syncthreads();
    for (int par = 0; ; par ^= 1) {
        const int u = __builtin_amdgcn_readfirstlane((int)qs[par]);
        if (u == (int)QEND) break;
        const int xl = u >> 9, qi_ = u & 511, sub = qi_ & 7; int v = qi_ >> 3, cat = 0;
        if (v >= 8) { v -= 8; cat = 1; if (v >= 16) { v -= 16; cat = 2; if (v >= 8) { v -= 8; cat = 3; if (v >= 8) { v -= 8; cat = 4; if (v >= 8) { v -= 8; cat = 5; } } } } }
        AP p; p.qinfo = (ls << 8) | (xl << 1) | (par ^ 1); p.lse = nullptr; p.opitch = 1024; p.o8 = 0; p.dil = 1; p.r0 = 0; p.qmask = 255; p.qshift = 8; p.jmask = 63; p.jshift = 6; p.nslope = 0.f; p.lk0 = 0; p.NT = 32;
        if (cat == 1) {
            const int b = xl, hp = 15 - v, h = hp >> 1, c = hp & 1;
            p.Q = (const bf16_t*)(qkv + QO_QA) + (size_t)(b * 16 + hp) * S * 64; p.K = (const bf16_t*)(qkv + QO_KA) + (size_t)(b * 16 + hp) * S * 64; p.V = (const bf16_t*)(qkv + QO_VA) + (size_t)(b * 8 + h) * S * 128;
            p.O = (bf16_t*)(F.ws + WS_P + PO_OA + (size_t)c * SZ_H1) + (size_t)b * S * 1024 + h * 128; p.l0 = sub * 256; p.nslope = -exp2f(-(float)(h + 1));
            {
                const int dmax = 1 << (h + 7), q0 = sub * 256; int jlo = (q0 - dmax + 1) >> 6; jlo = jlo < 0 ? 0 : jlo; int jhi = (q0 + 255 + dmax - 1) >> 6; jhi = jhi > 31 ? 31 : jhi;
                if (((jhi - jlo + 1) & 1) != 0) { if (jlo > 0) --jlo; else ++jhi; }
                p.lk0 = 64 * jlo; p.NT = jhi - jlo + 1; }
#if !defined(MK_ATT_ONLY) || MK_ATT_ONLY == 1
            attn_unit_p<1, 64>(F, p);
#endif
        } else {
            const int b = xl, h = v; const size_t ho = (size_t)(b * 8 + h) * S;
            if (cat == 0) {
                p.Q = (const bf16_t*)(qkv + QO_QD) + ho * 192; p.K = (const bf16_t*)(qkv + QO_KD) + ho * 192; p.V = (const bf16_t*)(qkv + QO_VD) + ho * 128;
                p.O = (bf16_t*)(F.ws + WS_O + (size_t)b * S * DM + 3072 + h * 128); p.opitch = DM; p.o8 = 1; p.l0 = sub * 256;
#if !defined(MK_ATT_ONLY) || MK_ATT_ONLY == 0
                attn_unit<0, 192>(F, p);
#endif
            } else if (cat == 2) {
                p.Q = (const bf16_t*)(qkv + QO_QC) + ho * 128; p.K = (const bf16_t*)(qkv + QO_KC) + ho * 128; p.V = (const bf16_t*)(qkv + QO_VC) + ho * 128;
                p.O = (bf16_t*)(F.ws + WS_O + (size_t)b * S * DM + 2048 + h * 128); p.opitch = DM; p.o8 = 1; p.l0 = sub * 256;
                const int R0 = sub * 4; int first = R0 - 4; first = first < 0 ? 0 : (first > 24 ? 24 : first); int lastb = R0 - 1; lastb = lastb < 0 ? 0 : (lastb > 24 ? 24 : lastb);
                p.lk0 = first * 64; p.NT = lastb + 7 - first + 1;
                { LAS float* rp = (LAS float*)(F.lds + ATT_RPB); const float* src = F.a->in[I_RPB] + (size_t)(l * 8 + h) * 465; int ti = F.tid; asm volatile("" : "+v"(ti)); if (ti < 465) rp[(ti / 31) * 128 + 48 + (ti % 31)] = src[ti]; }
#if !defined(MK_ATT_ONLY) || MK_ATT_ONLY == 3
                attn_unit<3, 128>(F, p);
#endif
            } else {
                const int br = cat - 3;
                p.Q = (const bf16_t*)(qkv + QO_QB) + ho * 128; p.K = (const bf16_t*)(qkv + QO_KB) + ho * 128; p.V = (const bf16_t*)(qkv + QO_VB) + ho * 128;
                p.O = (bf16_t*)(F.ws + WS_P + PO_OB + (size_t)br * SZ_H1) + (size_t)b * S * 1024 + h * 128;
                p.lse = (float*)(F.ws + WS_P + PO_LSE) + (size_t)br * T * 8 + (size_t)b * S * 8 + h; p.nslope = -exp2f(-(float)(h + 1));
                if (br == 0) { p.dil = 1; p.l0 = sub * 256; p.lk0 = p.l0 - 64; p.NT = 6; }
                else if (br == 1) { p.dil = 4; p.r0 = sub >> 1; p.l0 = (sub & 1) * 256; p.lk0 = p.l0 - 64; p.NT = 6; }
                else { p.dil = 16; p.r0 = sub * 2; p.l0 = 0; p.qmask = 127; p.qshift = 7; p.lk0 = 0; p.jmask = 1; p.jshift = 1; p.NT = 4; }
#if !defined(MK_ATT_ONLY) || MK_ATT_ONLY == 2
                attn_unit<2, 128>(F, p);
#endif
            }
        }
    }
}

__device__ __forceinline__ void p_post3(const Frame& F, int l) {
    const bf16_t* OA0 = (const bf16_t*)(F.ws + WS_P + PO_OA); const bf16_t* OA1 = OA0 + (size_t)T * 1024; const bf16_t* OB = (const bf16_t*)(F.ws + WS_P + PO_OB);
    const float* LSE = (const float*)(F.ws + WS_P + PO_LSE);
    unsigned char* O = F.ws + WS_O;
    const int lane = F.lane;
    const float* lv = F.a->in[I_DLAM] + l * 4 * 64;
    const float s01 = wsum(lv[lane] * lv[64 + lane]), s23 = wsum(lv[128 + lane] * lv[192 + lane]);
    const float lam_init = 0.8f - 0.6f * expf(-0.3f * (float)l), lam = expf(s01) - expf(s23) + lam_init;
    const float* gout = F.a->in[I_DGOUT] + l * 128 + (lane & 7) * 16;
    for (int t = F.rank * NWAVES + F.wid; t < T; t += F.nwg * NWAVES) {
        const size_t ro = (size_t)t * 1024 + lane * 16; unsigned char* orow = O + (size_t)t * DM + lane * 16;
        const int h = lane >> 3;
        u32x4 ra[2], rb[2], r0[2], r1[2], r2[2];
#pragma unroll
        for (int i = 0; i < 2; ++i) { ra[i] = *(const u32x4*)(OA0 + ro + 8 * i); rb[i] = *(const u32x4*)(OA1 + ro + 8 * i); r0[i] = *(const u32x4*)(OB + ro + 8 * i);
            r1[i] = *(const u32x4*)(OB + (size_t)T * 1024 + ro + 8 * i); r2[i] = *(const u32x4*)(OB + (size_t)2 * T * 1024 + ro + 8 * i); }
        float e0 = LSE[(size_t)t * 8 + h], e1 = LSE[(size_t)T * 8 + (size_t)t * 8 + h], e2 = LSE[(size_t)2 * T * 8 + (size_t)t * 8 + h];
        asm volatile("" : "+v"(e0), "+v"(e1), "+v"(e2) :: "memory");
        {
            float xa[16], xb[16], d[16]; unpack16(ra[0], ra[1], xa); unpack16(rb[0], rb[1], xb); float ss = 0.f;
#pragma unroll
            for (int j = 0; j < 16; ++j) { d[j] = xa[j] - lam * xb[j]; ss += d[j] * d[j]; }
            ss = sum8(ss);
            const float r = rsqrtf(ss * (1.0f / 128) + EPS) * (1.0f - lam_init);
            u32x4 w0; const float r8 = r * O8_SCALE;
#pragma unroll
            for (int i = 0; i < 4; ++i) w0[i] = pk_fp8x4(d[4 * i] * r8 * gout[4 * i], d[4 * i + 1] * r8 * gout[4 * i + 1], d[4 * i + 2] * r8 * gout[4 * i + 2], d[4 * i + 3] * r8 * gout[4 * i + 3]);
            *(u32x4*)orow = w0;
        }
        {
            const float m = fmaxf(e0, fmaxf(e1, e2)); float w0 = __expf(e0 - m), w1 = __expf(e1 - m), w2 = __expf(e2 - m); const float inv = 1.0f / (w0 + w1 + w2); w0 *= inv; w1 *= inv; w2 *= inv;
            float x0[16], x1[16], x2[16], d[16]; unpack16(r0[0], r0[1], x0); unpack16(r1[0], r1[1], x1); unpack16(r2[0], r2[1], x2);
#pragma unroll
            for (int j = 0; j < 16; ++j) d[j] = w0 * x0[j] + w1 * x1[j] + w2 * x2[j];
            u32x4 y0;
#pragma unroll
            for (int i = 0; i < 4; ++i) y0[i] = pk_fp8x4(d[4 * i] * O8_SCALE, d[4 * i + 1] * O8_SCALE, d[4 * i + 2] * O8_SCALE, d[4 * i + 3] * O8_SCALE);
            *(u32x4*)(orow + 1024) = y0;
        }
    }
}

__device__ __forceinline__ int med3i(int a, int b, int c) { return max(min(a, b), min(max(a, b), c)); }
__device__ __forceinline__ int ordkey(float v) { const int x = __float_as_int(v); return x ^ ((x >> 31) & 0x7fffffff); }
#define MK_INSERT(L, key) do { _Pragma("unroll") for (int _k = 15; _k >= 1; --_k) L[_k] = med3i((key), L[_k - 1], L[_k]); L[0] = max((key), L[0]); } while (0)
__device__ __forceinline__ void p_select(const Frame& F, int l) {
    const float* SC = (const float*)(F.ws + WS_P + PO_SC); int* EX = (int*)(F.ws + WS_P + PO_EXP); float* GT = (float*)(F.ws + WS_P + PO_GATE);
    LAS float* L = (LAS float*)F.lds;
    const int tid = F.tid;
    for (int blk = F.rank * NWAVES + F.wid; blk < T * 8 / 64; blk += F.nwg * NWAVES) {
        const int pid = blk * 64 + F.lane, t = pid >> 3, h = pid & 7;
        const float* sc = SC + (size_t)t * 2048 + h * 256;
        float fa[16], fb[16];
#pragma unroll
        for (int c = 0; c < 2; ++c) {
            int Lk[16];
#pragma unroll
            for (int k = 0; k < 16; ++k) Lk[k] = (int)0x80000000;
            for (int n32 = 0; n32 < 4; ++n32) { f32x4 v[8];
#pragma unroll
                for (int q = 0; q < 8; ++q) v[q] = *(const f32x4*)(sc + c * 128 + n32 * 32 + q * 4);
#pragma unroll
                for (int q = 0; q < 8; ++q)
#pragma unroll
                    for (int e = 0; e < 4; ++e) { const int key = (ordkey(v[q][e]) & ~127) | (n32 * 32 + q * 4 + e); MK_INSERT(Lk, key); } }
#pragma unroll
            for (int k = 0; k < 16; ++k) { const int idx = Lk[k] & 127; const float val = sc[c * 128 + idx];
                if (c == 0) fa[k] = val; else fb[k] = val;
                L[(c * 32 + k) * NTHR + tid] = val; L[(c * 32 + 16 + k) * NTHR + tid] = __int_as_float(idx); }
        }
        int Mk[16];
#pragma unroll
        for (int k = 0; k < 16; ++k) Mk[k] = (int)0x80000000;
#pragma unroll
        for (int i = 0; i < 16; ++i)
#pragma unroll
            for (int j = 0; j < 16; ++j) if ((i + 1) * (j + 1) <= 16) { const int key = (ordkey(fa[i] + fb[j]) & ~255) | (i * 16 + j); MK_INSERT(Mk, key); }
        asm volatile("s_waitcnt lgkmcnt(0)" ::: "memory");
        float sk[16]; int ek[16]; float mx = -INFINITY;
#pragma unroll
        for (int k = 0; k < 16; ++k) { const int code = Mk[k] & 255, i = code >> 4, j = code & 15;
            sk[k] = L[i * NTHR + tid] + L[(32 + j) * NTHR + tid];
            ek[k] = __float_as_int(L[(16 + i) * NTHR + tid]) * 128 + __float_as_int(L[(48 + j) * NTHR + tid]); mx = fmaxf(mx, sk[k]); }
        const float inv = 1.0f; (void)mx;
#pragma unroll
        for (int k = 0; k < 4; ++k) { *(int4*)(EX + (size_t)t * 128 + h * 16 + 4 * k) = make_int4(ek[4 * k], ek[4 * k + 1], ek[4 * k + 2], ek[4 * k + 3]);
            *(f32x4*)(GT + (size_t)t * 128 + h * 16 + 4 * k) = (f32x4){sk[4 * k] * inv, sk[4 * k + 1] * inv, sk[4 * k + 2] * inv, sk[4 * k + 3] * inv}; }
        asm volatile("s_waitcnt lgkmcnt(0)" ::: "memory");
    }
}

typedef float f32x2 __attribute__((ext_vector_type(2)));
typedef _Float16 h16x2 __attribute__((ext_vector_type(2)));
__device__ __forceinline__ void p_gather(const Frame& F, int l, int gs) {
    const bf16_t* HN = (const bf16_t*)(F.ws + WS_HN); const int* EX = (const int*)(F.ws + WS_P + PO_EXP); const float* GT = (const float*)(F.ws + WS_P + PO_GATE);
    const unsigned char* U = F.a->ws + WS_W + (size_t)l * LW_END + LW_U; const unsigned char* V = F.a->ws + WS_W + (size_t)l * LW_END + LW_V;
#define MK_LANE() ({ unsigned z_ = 0u; asm volatile("" : "+v"(z_)); (int)__builtin_amdgcn_mbcnt_hi(~0u, __builtin_amdgcn_mbcnt_lo(~0u, z_)); })
    unsigned* tctr = (unsigned*)(F.a->ws + WS_CTL) + 14336 + 64 * (2 * l + gs);
#define MK_TPOP(ln) ({ unsigned v_ = 0u; if ((ln) == 0) v_ = xb_add(tctr, 1u); v_; })
    int tnext = __builtin_amdgcn_readfirstlane((int)MK_TPOP(MK_LANE()));
    for (int t = tnext; t < T; t = tnext) {
        int lane = MK_LANE();
        const unsigned tv = MK_TPOP(lane);
        h16x2 hh[32];
        float ssq = 0.f;
#pragma unroll
        for (int c = 0; c < 16; ++c) { const u32x2 a = *(const u32x2*)(HN + (size_t)t * DM + c * 256 + 4 * lane); const float a0 = bf_lo(a.x), a1 = bf_hi(a.x), a2 = bf_lo(a.y), a3 = bf_hi(a.y);
            ssq += (a0 * a0 + a1 * a1) + (a2 * a2 + a3 * a3); hh[2 * c] = (h16x2){(_Float16)a0, (_Float16)a1}; hh[2 * c + 1] = (h16x2){(_Float16)a2, (_Float16)a3}; }
        const float rstd = rsqrtf(wave_total(ssq) * (1.0f / DM) + EPS);
        tnext = __builtin_amdgcn_readfirstlane((int)tv); asm volatile("" : "+s"(tnext));
        const int e0 = EX[(size_t)t * 128 + lane], e1 = EX[(size_t)t * 128 + 64 + lane]; float g0 = GT[(size_t)t * 128 + lane] * rstd, g1 = GT[(size_t)t * 128 + 64 + lane] * rstd;
        {
            float m0 = g0, m1 = g1;
#define MK_DPP_MAX(v, ctrl) v = fmaxf(v, __int_as_float(__builtin_amdgcn_update_dpp(0, __float_as_int(v), ctrl, 0xF, 0xF, true)))
            MK_DPP_MAX(m0, 0xB1); MK_DPP_MAX(m0, 0x4E); MK_DPP_MAX(m0, 0x141); MK_DPP_MAX(m0, 0x140); MK_DPP_MAX(m1, 0xB1); MK_DPP_MAX(m1, 0x4E); MK_DPP_MAX(m1, 0x141); MK_DPP_MAX(m1, 0x140);
#undef MK_DPP_MAX
            g0 = __expf(g0 - m0); g1 = __expf(g1 - m1); float s0 = g0, s1 = g1;
            MK_DPP_ADD(s0, 0xB1); MK_DPP_ADD(s0, 0x4E); MK_DPP_ADD(s0, 0x141); MK_DPP_ADD(s0, 0x140); MK_DPP_ADD(s1, 0xB1); MK_DPP_ADD(s1, 0x4E); MK_DPP_ADD(s1, 0x141); MK_DPP_ADD(s1, 0x140);
            g0 /= s0; g1 /= s1; }
        const float zs = rstd * (1.0f / U_SCALE);
#define MK_GRP(w, q) (u32x6){w[(6 * (q) + 0) >> 2][(6 * (q) + 0) & 3], w[(6 * (q) + 1) >> 2][(6 * (q) + 1) & 3], w[(6 * (q) + 2) >> 2][(6 * (q) + 2) & 3], w[(6 * (q) + 3) >> 2][(6 * (q) + 3) & 3], w[(6 * (q) + 4) >> 2][(6 * (q) + 4) & 3], w[(6 * (q) + 5) >> 2][(6 * (q) + 5) & 3]}
#define MK_ROWS(buf, TAB, k) do { const int ev_ = (k) < 16 ? e0 : e1; _Pragma("unroll") for (int j_ = 0; j_ < 4; ++j_) { const int e_ = __builtin_amdgcn_readlane(ev_, (4 * (k) + j_) & 63); \
            const unsigned char* r_ = TAB + (size_t)e_ * 3072 + lane * 48; _Pragma("unroll") for (int c_ = 0; c_ < 3; ++c_) buf[j_][c_] = *(const u32x4*)(r_ + c_ * 16); } } while (0)
        int wv0 = 0, wv1 = 0;
#define MK_DPPF(v, ctrl) __int_as_float(__builtin_amdgcn_update_dpp(0, __float_as_int(v), ctrl, 0xF, 0xF, true))
#define MK_UCOMP(buf, k) do { float p_[4]; _Pragma("unroll") for (int j_ = 0; j_ < 4; ++j_) { float za_ = 0.f, zb_ = 0.f; \
            _Pragma("unroll") for (int q_ = 0; q_ < 2; ++q_) { const h16x32 d_ = __builtin_amdgcn_cvt_scalef32_pk32_f16_fp6(MK_GRP(buf[j_], q_), 1.0f); \
                _Pragma("unroll") for (int p2_ = 0; p2_ < 16; p2_ += 2) { za_ = __builtin_amdgcn_fdot2((h16x2){d_[2 * p2_], d_[2 * p2_ + 1]}, hh[q_ * 16 + p2_], za_, false); \
                    zb_ = __builtin_amdgcn_fdot2((h16x2){d_[2 * p2_ + 2], d_[2 * p2_ + 3]}, hh[q_ * 16 + p2_ + 1], zb_, false); } } \
            p_[j_] = za_ + zb_; } \
            const bool o0_ = (lane & 1) != 0, o1_ = (lane & 2) != 0; \
            const float r01_ = (o0_ ? p_[1] : p_[0]) + MK_DPPF((o0_ ? p_[0] : p_[1]), 0xB1), r23_ = (o0_ ? p_[3] : p_[2]) + MK_DPPF((o0_ ? p_[2] : p_[3]), 0xB1); \
            float r_ = (o1_ ? r23_ : r01_) + MK_DPPF((o1_ ? r01_ : r23_), 0x4E); \
            r_ += MK_DPPF(r_, 0x124); r_ += MK_DPPF(r_, 0x128); \
            { auto s_ = __builtin_amdgcn_permlane16_swap(__float_as_uint(r_), __float_as_uint(r_), false, false); r_ = __uint_as_float(s_[0]) + __uint_as_float(s_[1]); } \
            { auto s_ = __builtin_amdgcn_permlane32_swap(__float_as_uint(r_), __float_as_uint(r_), false, false); r_ = __uint_as_float(s_[0]) + __uint_as_float(s_[1]); } \
            const bool me_ = (lane >> 2) == ((k) & 15); \
            if ((k) < 16) wv0 = me_ ? __float_as_int(r_) : wv0; else wv1 = me_ ? __float_as_int(r_) : wv1; } while (0)
        {
            u32x4 b0[4][3], b1[4][3], b2[4][3];
            MK_ROWS(b0, U, 0); MK_ROWS(b1, U, 1);
            for (int k = 0; k < 30; k += 3) { MK_ROWS(b2, U, k + 2); MK_UCOMP(b0, k); MK_ROWS(b0, U, k + 3); MK_UCOMP(b1, k + 1); MK_ROWS(b1, U, k + 4); MK_UCOMP(b2, k + 2); }
            MK_UCOMP(b0, 30); MK_UCOMP(b1, 31);
        }
        {
            const float z0 = __int_as_float(wv0) * zs, z1 = __int_as_float(wv1) * zs;
            wv0 = __float_as_int(g0 * 0.5f * z0 * (1.0f + erff(z0 * 0.7071067811865476f)) * (1.0f / V_SCALE));
            wv1 = __float_as_int(g1 * 0.5f * z1 * (1.0f + erff(z1 * 0.7071067811865476f)) * (1.0f / V_SCALE)); }
        f32x2 acc[32];
#pragma unroll
        for (int i = 0; i < 32; ++i) acc[i] = (f32x2){0.f, 0.f};
#define MK_VCOMP(buf, k) do { const int wv_ = (k) < 16 ? wv0 : wv1; _Pragma("unroll") for (int j_ = 0; j_ < 4; ++j_) { const float w_ = __int_as_float(__builtin_amdgcn_readlane(wv_, (4 * (k) + j_) & 63)); const f32x2 w2_ = (f32x2){w_, w_}; \
            _Pragma("unroll") for (int q_ = 0; q_ < 2; ++q_) { const f32x32v d_ = __builtin_amdgcn_cvt_scalef32_pk32_f32_fp6(MK_GRP(buf[j_], q_), 1.0f); \
                _Pragma("unroll") for (int p_ = 0; p_ < 16; ++p_) acc[q_ * 16 + p_] = __builtin_elementwise_fma((f32x2){d_[2 * p_], d_[2 * p_ + 1]}, w2_, acc[q_ * 16 + p_]); } } } while (0)
        {
            u32x4 b0[4][3], b1[4][3];
            MK_ROWS(b0, V, 0);
            for (int k = 0; k < 32; k += 2) { MK_ROWS(b1, V, k + 1); MK_VCOMP(b0, k); if (k + 2 < 32) MK_ROWS(b0, V, k + 2); MK_VCOMP(b1, k + 1); }
        }
#undef MK_ROWS
#undef MK_UCOMP
#undef MK_DPPF
#undef MK_VCOMP
#undef MK_GRP
        asm volatile("" : "+v"(lane));
        float* xr = F.out + (size_t)t * DM + 4 * lane; f32x4 xo[16]; float ss = 0.f;
#pragma unroll
        for (int c = 0; c < 16; ++c) xo[c] = *(const f32x4*)(xr + c * 256);
#pragma unroll
        for (int c = 0; c < 16; ++c) { f32x4 a = xo[c]; const int q = c >> 3, pb_ = 2 * (c & 7);
            a[0] += acc[q * 16 + pb_].x; a[1] += acc[q * 16 + pb_].y; a[2] += acc[q * 16 + pb_ + 1].x; a[3] += acc[q * 16 + pb_ + 1].y; *(f32x4*)(xr + c * 256) = a; xo[c] = a;
            ss += (a[0] * a[0] + a[1] * a[1]) + (a[2] * a[2] + a[3] * a[3]); }
        if (l == 0) {
            const float r = rsqrtf(wave_total(ss) * (1.0f / DM) + EPS) * HN8_SCALE; unsigned char* hr = F.ws + WS_T2 + TO_HN8 + (size_t)t * DM + 4 * lane;
#pragma unroll
            for (int c = 0; c < 16; ++c) *(unsigned*)(hr + c * 256) = pk_fp8x4(xo[c][0] * r, xo[c][1] * r, xo[c][2] * r, xo[c][3] * r); }
    }
#undef MK_TPOP
#undef MK_LANE
}

__global__ void __launch_bounds__(NTHR, 2) mk_fwd(Args args) {
    extern __shared__ __attribute__((aligned(16))) unsigned char lds_raw[];
    Frame F;
    F.a = &args;
    F.out = args.out; F.ws = args.ws; F.lds = (LAS unsigned char*)lds_raw;
    const int wave_id = __builtin_amdgcn_readfirstlane((int)threadIdx.x >> 6);
#define MK_TID() ({ unsigned z_ = 0u; asm volatile("" : "+v"(z_)); wave_id * 64 + (int)__builtin_amdgcn_mbcnt_hi(~0u, __builtin_amdgcn_mbcnt_lo(~0u, z_)); })
    F.tid = MK_TID(); F.lane = F.tid & 63; F.wid = wave_id; F.rank = (int)blockIdx.x; F.nwg = (int)gridDim.x;
#define MK_BAR_PTR(full) ((unsigned*)(args.ws + WS_CTL) + ((full) ? 0 : 4096 * (1 + sid())))
    if (MK_TID() == 0) *(LAS u32x4*)(F.lds + LDS_XB) = (u32x4){0u, 0u, 0u, 0u};
    __syncthreads();
    (void)xcd_barrier_post(MK_BAR_PTR(1), (volatile LAS unsigned*)(F.lds + LDS_XB), MK_TID() == 0);
    (void)xcd_barrier_post(MK_BAR_PTR(0), (volatile LAS unsigned*)(F.lds + LDS_XB + 8), MK_TID() == 0);
#ifndef MK_ONLY
#define MK_ONLY -1
#endif
#define MK_EN(s) (MK_ONLY < 0 || MK_ONLY == (s))
#define MK_FRESH(gs, all) do { int t_ = MK_TID(); asm volatile("" : "+v"(t_)); F.tid = t_; F.lane = t_ & 63; F.wid = __builtin_amdgcn_readfirstlane(t_ >> 6); \
        F.rank = (all) ? (int)blockIdx.x : wg_rank(); F.nwg = (all) ? (int)gridDim.x : wg_count(); \
        __attribute__((address_space(1))) unsigned char* w_ = (__attribute__((address_space(1))) unsigned char*)(args.ws + (size_t)(gs) * ACT_SZ); \
        __attribute__((address_space(1))) float* o_ = (__attribute__((address_space(1))) float*)(args.out + (size_t)(gs) * T * DM); \
        asm volatile("" : "+s"(w_), "+s"(o_)); F.ws = (unsigned char*)w_; F.out = (float*)o_; } while (0)
#define MK_BAR(full) do { XcdBarrier b_; b_.bar = MK_BAR_PTR(full); b_.x = xb_xcc_id(); b_.G = (full) ? gridDim.x : (gridDim.x >> 1); b_.st = (volatile LAS unsigned*)(F.lds + LDS_XB + ((full) ? 0 : 8)); \
        xcd_barrier(b_, MK_TID() == 0); } while (0)
    if (MK_EN(100)) { MK_FRESH(0, 1); p0_a(F); MK_FRESH(0, 1); p0_b(F, (int)blockIdx.x, (int)gridDim.x);
        for (int gs = 0; gs < 2; ++gs) { MK_FRESH(gs, 1); p_norm(F, F.a->in[I_X] + (size_t)gs * T * DM, (bf16_t*)(F.ws + WS_T2 + TO_HN8)); } }
    MK_BAR(1);
#ifndef MK_NHEAD
#define MK_NHEAD 4
#endif
#ifndef MK_JTAIL
#define MK_JTAIL 15
#endif
    const int nsteps = (sid() == 0) ? (18 + 18 - MK_JTAIL) : (MK_NHEAD + 18);
    for (int i = 0; i < nsteps; ++i) {
        int gs, g, all, nall;
        if (sid() == 0) { if (i < 18) { gs = 0; g = i; all = i < MK_NHEAD; nall = (i + 1 < MK_NHEAD) || (i + 1 >= 18); } else { gs = 1; g = MK_JTAIL + (i - 18); all = 1; nall = 1; } }
        else { if (i < MK_NHEAD) { gs = 0; g = i; all = 1; nall = (i + 1 < MK_NHEAD); } else { gs = 1; g = i - MK_NHEAD; all = g >= MK_JTAIL; nall = (g + 1 >= MK_JTAIL); } }
        const int l = g >= 9 ? 1 : 0, st = g - 9 * l;
#define lw (F.a->ws + WS_W + (size_t)l * LW_END)
#define xin ((l == 0) ? (F.a->in[I_X] + (size_t)gs * T * DM) : (const float*)F.out)
        MK_FRESH(gs, all);
        if (st == 0) {
            if (MK_EN(1)) { pg8::Gemm gm{(const bf16_t*)(F.ws + WS_T2 + TO_HN8), (const bf16_t*)(lw + LW_WIN), T, NINP, DM}; pg8::StaticOrder So; So.init(T, NINP, F.nwg, F.rank);
                pg8::EpiG1N E{(bf16_t*)(F.ws + WS_P), NINP, (bf16_t*)(F.ws + WS_QKV), SZ_H1 / 2, 1.0f / (HN8_SCALE * WIN8_SCALE), F.a->in[I_DGQK] + l * 128, F.a->in[I_DILG] + l * 256, F.a->in[I_NAG] + l * 256, (LAS float*)(F.lds + LDS_G1X)};
                pg8::gemm_phase_f8<pg8::EpiG1N, pg8::StaticOrder>(F.lds, gm, So, E, nullptr, MK_TID()); }
        } else if (st == 1) {
            if (MK_EN(3)) {
                for (int gi = 0; gi < 2; ++gi) {
                    pg8::Gemm gm{(const bf16_t*)(F.ws + WS_P) + (gi ? 9984 : 9216), (const bf16_t*)(lw + (gi ? LW_WUKV : LW_WUQ)), T, gi ? 2048 : 1536, gi ? 512 : 768, NINP}; pg8::StaticOrder So; So.init(T, gm.N, F.nwg, F.rank);
                    pg8::EpiBf16P E{(bf16_t*)(F.ws + WS_O + (gi ? OO_KVRAW : OO_QRAW)), gm.N}; pg8::gemm_phase<pg8::EpiBf16P, pg8::StaticOrder>(F.lds, gm, So, E, nullptr, MK_TID());
                    __syncthreads();
                }
            }
        } else if (st == 2) { if (MK_EN(4)) p_post2(F, l);
        } else if (st == 3) { if (MK_EN(5)) p_attention(F, l, gs);
        } else if (st == 4) { if (MK_EN(6)) p_post3(F, l);
        } else if (st == 5) {
            if (MK_EN(7)) { pg8::Gemm gm{(const bf16_t*)(F.ws + WS_O), (const bf16_t*)(lw + LW_WOUT), T, DM, DM}; pg8::StaticOrder So; So.init(T, DM, F.nwg, F.rank);
                pg8::EpiResF32N E{xin, F.out, DM, (bf16_t*)(F.ws + WS_HN), 1.0f / (O8_SCALE * WOUT8_SCALE)}; pg8::gemm_phase_f8<pg8::EpiResF32N, pg8::StaticOrder>(F.lds, gm, So, E, nullptr, MK_TID()); }
        } else if (st == 6) {
            if (MK_EN(9)) { pg8::Gemm gm{(const bf16_t*)(F.ws + WS_HN), (const bf16_t*)(lw + LW_W2), T, 2048, DM}; pg8::StaticOrder So; So.init(T, 2048, F.nwg, F.rank);
                pg8::EpiF32 E{(float*)(F.ws + WS_P + PO_SC), 2048, nullptr}; pg8::gemm_phase<pg8::EpiF32, pg8::StaticOrder>(F.lds, gm, So, E, nullptr, MK_TID()); }
        } else if (st == 7) { if (MK_EN(10)) p_select(F, l);
        } else { if (MK_EN(11)) p_gather(F, l, gs); }
        if (i + 1 < nsteps) { if (all || nall) MK_BAR(1); else MK_BAR(0); }
#undef lw
#undef xin
    }
}
}

extern "C" void kernel_launch(void* const* d_in, const int* in_sizes, int n_in, void* d_out, int out_size, void* d_ws, size_t ws_size, hipStream_t stream) {
    static int grid = 0;
    if (grid == 0) {
        if (n_in != 20 || out_size != mk::TT * mk::DM || ws_size < mk::WS_TOTAL) { fprintf(stderr, "kernel_launch: unexpected shapes (n_in %d out %d ws %zu, need %zu)\n", n_in, out_size, ws_size, (size_t)mk::WS_TOTAL); grid = -1; return; }
        int dev = 0, cus = 0, per_cu = 0;
        if (hipGetDevice(&dev) != hipSuccess || hipDeviceGetAttribute(&cus, hipDeviceAttributeMultiprocessorCount, dev) != hipSuccess) { grid = -1; return; }
        if (hipFuncSetAttribute((const void*)mk::mk_fwd, hipFuncAttributeMaxDynamicSharedMemorySize, mk::LDS_BYTES) != hipSuccess) { fprintf(stderr, "kernel_launch: hipFuncSetAttribute failed\n"); grid = -1; return; }
        if (hipOccupancyMaxActiveBlocksPerMultiprocessor(&per_cu, (const void*)mk::mk_fwd, mk::NTHR, mk::LDS_BYTES) != hipSuccess || per_cu < 1) { fprintf(stderr, "kernel_launch: occupancy query says %d\n", per_cu); }
        (void)hipGetLastError();
        grid = cus & ~15;
    }
    if (grid < 0) return;
    (void)hipMemsetAsync((char*)d_ws + mk::WS_CTL, 0, 65536, stream);
    mk::Args a{};
    for (int i = 0; i < 20; ++i) a.in[i] = (const float*)d_in[i];
    a.out = (float*)d_out; a.ws = (unsigned char*)d_ws;
    hipLaunchKernelGGL(mk::mk_fwd, dim3(grid), dim3(mk::NTHR), mk::LDS_BYTES, stream, a);
    const hipError_t le = hipPeekAtLastError();
    if (le != hipSuccess) fprintf(stderr, "kernel_launch: launch failed: %s\n", hipGetErrorName(le));
}
```

```cpp
#include <hip/hip_runtime.h>
#include <cstdio>
#include <cstdint>
#include <cstddef>
namespace pg8 {
#define PG8_LAS __attribute__((address_space(3)))
typedef unsigned short bf16_t;
typedef short bf16x8 __attribute__((ext_vector_type(8)));
typedef float f32x4 __attribute__((ext_vector_type(4)));
typedef unsigned u32x4 __attribute__((ext_vector_type(4)));
typedef int i32x8 __attribute__((ext_vector_type(8)));
typedef int i32x4 __attribute__((ext_vector_type(4)));
typedef int i32x16 __attribute__((ext_vector_type(16)));
typedef int i32x32 __attribute__((ext_vector_type(32)));
typedef float f32x32 __attribute__((ext_vector_type(32)));
constexpr int BM = 256, BK = 64, HALF = 128, HTB = HALF * BK * 2  , STAGE_BYTES = 8 * HTB, NXCD = 8, WGM = 8;

__host__ __device__ __forceinline__ int lds_byte(int r, int c) { const int st = (r >> 4) * 2 + (c >> 5), rr = r & 15, cc = c & 31, ob = rr * 64 + cc * 2; return st * 1024 + (ob ^ (((ob >> 9) & 1) << 5)); }
__host__ __device__ __forceinline__ void stage_rc(int b, int& R, int& C) { const int st = b / 1024, sb = b % 1024, swz = sb ^ (((sb >> 9) & 1) << 5); R = (st >> 1) * 16 + swz / 64; C = (st & 1) * 32 + (swz % 64) / 2; }
__host__ __device__ __forceinline__ int perm32(int rho) { const int n = rho >> 4, i = rho & 15; return 8 * (i >> 2) + 4 * n + (i & 3); }

struct Unit { int pm, pn; };
struct Gemm { const bf16_t* A; const bf16_t* Bt; int M, N, K; int lda = 0; };

struct StaticOrder {
    int nM, nN, nwg, G, c;
    __host__ __device__ void init(int M, int N, int G_, int c_) { nM = M / BM; nN = N / BM; nwg = nM * nN; G = G_; c = c_; }
    __host__ __device__ bool next(int i, Unit& u) const {
        const long L = (long)i * G + c; if (L >= nwg) return false;
        int wgid = (int)L; { const int q = nwg / NXCD, r = nwg % NXCD, xcd = wgid % NXCD, off = wgid / NXCD; wgid = (xcd < r ? xcd * (q + 1) : r * (q + 1) + (xcd - r) * q) + off; }
        const int nig = WGM * nN, gid = wgid / nig, fm = gid * WGM, gsz = (nM - fm) < WGM ? (nM - fm) : WGM;
        u.pm = fm + ((wgid % nig) % gsz); u.pn = (wgid % nig) / gsz; return true;
    }
    __device__ __forceinline__ void a_ready(const Unit&) const {}
    __device__ __forceinline__ void done(const Unit&) const {}
};
__device__ __forceinline__ unsigned cvt_pk_bf16(float lo, float hi) { unsigned r; asm volatile("v_cvt_pk_bf16_f32 %0, %1, %2" : "=v"(r) : "v"(lo), "v"(hi)); return r; }
typedef float f32x2 __attribute__((ext_vector_type(2)));
struct EpiF32 {
    static constexpr bool PERM = false, AFTER_DRAIN = false;
    float* C; int ldc; const float* bias;
    __device__ __forceinline__ void operator()(const f32x4 (&acc)[2][2][4][2], const Unit& u, int wr, int wc, int fr, int fq) const {
        const int row0 = u.pm * BM + wr * 64 + fr, col0 = u.pn * BM + wc * 32 + 4 * fq;
        f32x4 bv[2][2];
#pragma unroll
        for (int bj = 0; bj < 2; ++bj)
#pragma unroll
            for (int n = 0; n < 2; ++n) bv[bj][n] = bias ? *(const f32x4*)(bias + col0 + bj * HALF + n * 16) : (f32x4){0.f, 0.f, 0.f, 0.f};
#pragma unroll
        for (int ai = 0; ai < 2; ++ai)
#pragma unroll
            for (int m = 0; m < 4; ++m) { float* rowp = C + (size_t)(row0 + ai * HALF + m * 16) * ldc + col0;
#pragma unroll
                for (int bj = 0; bj < 2; ++bj)
#pragma unroll
                    for (int n = 0; n < 2; ++n) *(f32x4*)(rowp + bj * HALF + n * 16) = acc[ai][bj][m][n] + bv[bj][n]; }
    }
};
struct EpiBf16P {
    static constexpr bool PERM = true, AFTER_DRAIN = false;
    bf16_t* O; int ldc;
    __device__ __forceinline__ void operator()(const f32x4 (&acc)[2][2][4][2], const Unit& u, int wr, int wc, int fr, int fq) const {
        const int row0 = u.pm * BM + wr * 64 + fr, col0 = u.pn * BM + wc * 32 + 8 * fq;
#pragma unroll
        for (int ai = 0; ai < 2; ++ai)
#pragma unroll
            for (int m = 0; m < 4; ++m) { bf16_t* rowp = O + (size_t)(row0 + ai * HALF + m * 16) * ldc + col0;
#pragma unroll
                for (int bj = 0; bj < 2; ++bj) { const f32x4 v0 = acc[ai][bj][m][0], v1 = acc[ai][bj][m][1];
                    u32x4 w; w.x = cvt_pk_bf16(v0[0], v0[1]); w.y = cvt_pk_bf16(v0[2], v0[3]); w.z = cvt_pk_bf16(v1[0], v1[1]); w.w = cvt_pk_bf16(v1[2], v1[3]);
                    *(u32x4*)(rowp + bj * HALF) = w; } }
    }
};
struct EpiResF32 {
    static constexpr bool PERM = false, AFTER_DRAIN = false;
    const float* res; float* out; int ldc;
    __device__ __forceinline__ void operator()(const f32x4 (&acc)[2][2][4][2], const Unit& u, int wr, int wc, int fr, int fq) const {
        const int row0 = u.pm * BM + wr * 64 + fr, col0 = u.pn * BM + wc * 32 + 4 * fq;
#pragma unroll
        for (int ai = 0; ai < 2; ++ai)
#pragma unroll
            for (int m = 0; m < 4; ++m) { const size_t off = (size_t)(row0 + ai * HALF + m * 16) * ldc + col0;
#pragma unroll
                for (int bj = 0; bj < 2; ++bj)
#pragma unroll
                    for (int n = 0; n < 2; ++n) { const size_t o = off + bj * HALF + n * 16; const f32x4 r = *(const f32x4*)(res + o); *(f32x4*)(out + o) = r + acc[ai][bj][m][n]; } }
    }
};

struct EpiG1 {
    static constexpr bool PERM = true, AFTER_DRAIN = false;
    bf16_t* O; int ldc; bf16_t* vseg;
    size_t vstride; float oscale;
    __device__ __forceinline__ void operator()(const f32x4 (&acc)[2][2][4][2], const Unit& u, int wr, int wc, int fr, int fq) const {
        const int row0 = u.pm * BM + wr * 64 + fr, colt = u.pn * BM, seg = colt >> 10;
        const bool isv = (seg == 2) || (seg == 5) || (seg == 8);
#pragma unroll
        for (int ai = 0; ai < 2; ++ai)
#pragma unroll
            for (int m = 0; m < 4; ++m) { const int row = row0 + ai * HALF + m * 16;
#pragma unroll
                for (int bj = 0; bj < 2; ++bj) { const f32x4 v0 = acc[ai][bj][m][0] * oscale, v1 = acc[ai][bj][m][1] * oscale;
                    u32x4 w; w.x = cvt_pk_bf16(v0[0], v0[1]); w.y = cvt_pk_bf16(v0[2], v0[3]); w.z = cvt_pk_bf16(v1[0], v1[1]); w.w = cvt_pk_bf16(v1[2], v1[3]);
                    bf16_t* dst;
                    if (isv) { const int h = ((colt & 1023) >> 7) + bj; dst = vseg + (size_t)seg * vstride + ((size_t)((row >> 11) * 8 + h) * 2048 + (row & 2047)) * 128 + wc * 32 + 8 * fq; }
                    else dst = O + (size_t)row * ldc + colt + bj * HALF + wc * 32 + 8 * fq;
                    *(u32x4*)dst = w; } }
    }
};
struct EpiResF32N {
    static constexpr bool PERM = false, AFTER_DRAIN = false;
    const float* res; float* out; int ldc; bf16_t* xb; float oscale;
    __device__ __forceinline__ void operator()(const f32x4 (&acc)[2][2][4][2], const Unit& u, int wr, int wc, int fr, int fq) const {
        asm volatile("" : "+v"(fr), "+v"(fq));
        const int row0 = u.pm * BM + wr * 64 + fr, col0 = u.pn * BM + wc * 32 + 4 * fq;
        typedef unsigned u32x2e __attribute__((ext_vector_type(2)));
#pragma unroll
        for (int ai = 0; ai < 2; ++ai) { f32x4 r[4][2][2];
#pragma unroll
            for (int m = 0; m < 4; ++m)
#pragma unroll
                for (int bj = 0; bj < 2; ++bj)
#pragma unroll
                    for (int n = 0; n < 2; ++n) r[m][bj][n] = *(const f32x4*)(res + (size_t)(row0 + ai * HALF + m * 16) * ldc + col0 + bj * HALF + n * 16);
            asm volatile("" ::: "memory");
#pragma unroll
            for (int m = 0; m < 4; ++m)
#pragma unroll
                for (int bj = 0; bj < 2; ++bj)
#pragma unroll
                    for (int n = 0; n < 2; ++n) { const size_t o = (size_t)(row0 + ai * HALF + m * 16) * ldc + col0 + bj * HALF + n * 16;
                        const f32x4 v = r[m][bj][n] + acc[ai][bj][m][n] * oscale; *(f32x4*)(out + o) = v;
                        u32x2e w; w.x = cvt_pk_bf16(v[0], v[1]); w.y = cvt_pk_bf16(v[2], v[3]); *(u32x2e*)(xb + o) = w; }
            asm volatile("" ::: "memory"); }
    }
};

struct EpiG1N {
    static constexpr bool PERM = true, AFTER_DRAIN = false;
    bf16_t* O; int ldc; bf16_t* qkv;
    size_t vstride; float oscale; const float* gA; const float* gB; const float* gC;
    PG8_LAS float* X;
    __device__ __forceinline__ void operator()(const f32x4 (&acc)[2][2][4][2], const Unit& u, int wr, int wc, int fr, int fq) const {
        asm volatile("" : "+v"(fr), "+v"(fq));
        const int row0 = u.pm * BM + wr * 64 + fr, colt = u.pn * BM, seg = colt >> 10, which = seg % 3, mixer = seg / 3;
        if (seg >= 9 || which == 2) {
#pragma unroll
            for (int ai = 0; ai < 2; ++ai)
#pragma unroll
                for (int m = 0; m < 4; ++m) { const int row = row0 + ai * HALF + m * 16;
#pragma unroll
                    for (int bj = 0; bj < 2; ++bj) { const f32x4 v0 = acc[ai][bj][m][0] * oscale, v1 = acc[ai][bj][m][1] * oscale;
                        u32x4 w; w.x = cvt_pk_bf16(v0[0], v0[1]); w.y = cvt_pk_bf16(v0[2], v0[3]); w.z = cvt_pk_bf16(v1[0], v1[1]); w.w = cvt_pk_bf16(v1[2], v1[3]);
                        bf16_t* dst;
                        if (seg < 9) { const int h = ((colt & 1023) >> 7) + bj; dst = qkv + (size_t)seg * vstride + ((size_t)((row >> 11) * 8 + h) * 2048 + (row & 2047)) * 128 + wc * 32 + 8 * fq; }
                        else dst = O + (size_t)row * ldc + colt + bj * HALF + wc * 32 + 8 * fq;
                        *(u32x4*)dst = w; } }
            return;
        }
        const int lane = fr + 16 * fq;
        float ss[2][4][2];
#pragma unroll
        for (int ai = 0; ai < 2; ++ai)
#pragma unroll
            for (int m = 0; m < 4; ++m)
#pragma unroll
                for (int bj = 0; bj < 2; ++bj) { const f32x4 v0 = acc[ai][bj][m][0] * oscale, v1 = acc[ai][bj][m][1] * oscale;
                    float s = (v0[0] * v0[0] + v0[1] * v0[1]) + (v0[2] * v0[2] + v0[3] * v0[3]) + (v1[0] * v1[0] + v1[1] * v1[1]) + (v1[2] * v1[2] + v1[3] * v1[3]);
                    s += __int_as_float(__builtin_amdgcn_ds_bpermute((lane ^ 16) << 2, __float_as_int(s)));
                    s += __int_as_float(__builtin_amdgcn_ds_bpermute((lane ^ 32) << 2, __float_as_int(s)));
                    ss[ai][m][bj] = s; }
        if (fq == 0) {
#pragma unroll
            for (int ai = 0; ai < 2; ++ai)
#pragma unroll
                for (int m = 0; m < 4; ++m)
#pragma unroll
                    for (int bj = 0; bj < 2; ++bj) X[(((wr * 128) + ai * 64 + m * 16 + fr) * 2 + bj) * 4 + wc] = ss[ai][m][bj]; }
        asm volatile("s_waitcnt lgkmcnt(0)" ::: "memory"); __builtin_amdgcn_s_barrier(); asm volatile("" ::: "memory");
        const float* g = (mixer == 0 ? gA + which * 64 + (wc & 1) * 32 : (mixer == 1 ? gB : gC) + which * 128 + wc * 32) + 8 * fq;
        const f32x4 g0 = *(const f32x4*)g, g1 = *(const f32x4*)(g + 4);
        const float qs = which == 0 ? (mixer == 0 ? 0.125f : 0.08838834764831845f) : 1.0f;
#pragma unroll
        for (int ai = 0; ai < 2; ++ai)
#pragma unroll
            for (int m = 0; m < 4; ++m) { const int row = row0 + ai * HALF + m * 16;
#pragma unroll
                for (int bj = 0; bj < 2; ++bj) { const f32x4 pw = *(const PG8_LAS f32x4*)(X + (((wr * 128) + ai * 64 + m * 16 + fr) * 2 + bj) * 4);
                    float tot, inv; if (mixer == 0) { tot = (wc & 2) ? (pw[2] + pw[3]) : (pw[0] + pw[1]); inv = 1.0f / 64; } else { tot = (pw[0] + pw[1]) + (pw[2] + pw[3]); inv = 1.0f / 128; }
                    const float r = rsqrtf(tot * inv + 1e-6f) * qs * oscale;
                    const f32x4 v0 = acc[ai][bj][m][0] * r * g0, v1 = acc[ai][bj][m][1] * r * g1;
                    u32x4 w; w.x = cvt_pk_bf16(v0[0], v0[1]); w.y = cvt_pk_bf16(v0[2], v0[3]); w.z = cvt_pk_bf16(v1[0], v1[1]); w.w = cvt_pk_bf16(v1[2], v1[3]);
                    const int h = ((colt & 1023) >> 7) + bj; bf16_t* dst;
                    if (mixer == 0) dst = qkv + (size_t)seg * vstride + ((size_t)((row >> 11) * 16 + 2 * h + (wc >> 1)) * 2048 + (row & 2047)) * 64 + (wc & 1) * 32 + 8 * fq;
                    else dst = qkv + (size_t)seg * vstride + ((size_t)((row >> 11) * 8 + h) * 2048 + (row & 2047)) * 128 + wc * 32 + 8 * fq;
                    *(u32x4*)dst = w; } }
    }
};

template <class Epi, class Sched, bool STAMP = false>
__device__ __forceinline__ void gemm_phase(PG8_LAS unsigned char* lds, const Gemm g, const Sched& S, const Epi& E, unsigned long long* stamps, int tid_in) {
    int tid_ = tid_in; asm volatile("" : "+v"(tid_));
    const int tid = tid_, wid = __builtin_amdgcn_readfirstlane(tid >> 6), lane = tid & 63, wr = wid >> 2, wc = wid & 3, fr = lane & 15, fq = lane >> 4;
    const int K = g.K, nt = K / BK, LDA = g.lda ? g.lda : g.K;
    int ts_lo = 0, ts_hi = 0, nts = 0; const unsigned long long rt_entry = STAMP ? (unsigned long long)wall_clock64() : 0ull;
#define PG8_STAMP() do { if (STAMP && wid == 0 && nts < 64) { const unsigned long long _c = (unsigned long long)clock64(); \
        ts_lo = (lane == nts) ? (int)(unsigned)_c : ts_lo; ts_hi = (lane == nts) ? (int)(unsigned)(_c >> 32) : ts_hi; ++nts; } } while (0)
    PG8_STAMP();
    unsigned voffA[2], voffB[2];
#pragma unroll
    for (int i = 0; i < 2; ++i) { int R, C; stage_rc(tid * 16 + i * 8192, R, C); const int Rb = Epi::PERM ? ((R & ~31) + perm32(R & 31)) : R;
        voffA[i] = (unsigned)(R * LDA + C) * 2u; voffB[i] = (unsigned)(Rb * K + C) * 2u; }
    const size_t kstep = (size_t)(BK * 2);
    const size_t hstep = (size_t)HALF * K * 2;
    const size_t tstep = 2 * hstep;
    const size_t hstepA = (size_t)HALF * LDA * 2, tstepA = 2 * hstepA;
    const unsigned ldsw = (unsigned)wid * 1024u;
    const int aoff = lds_byte(wr * 64 + fr, fq * 8), boff = lds_byte(wc * 32 + fr, fq * 8);
#define PG8_SA(b, h) (((b) * 2 + (h)) * HTB)
#define PG8_SB(b, h) ((4 + (b) * 2 + (h)) * HTB)
#define PG8_STAGE(bufoff, gbase, voff) do { _Pragma("unroll") for (int _i = 0; _i < 2; ++_i) \
        __builtin_amdgcn_global_load_lds((const unsigned*)((const char*)(gbase) + (voff)[_i]), (PG8_LAS unsigned*)(lds + (bufoff) + ldsw + _i * 8192), 16, 0, 0); } while (0)
#define PG8_LDA(dst, b, h) do { _Pragma("unroll") for (int m = 0; m < 4; ++m) _Pragma("unroll") for (int k = 0; k < 2; ++k) dst[m][k] = *(const PG8_LAS bf16x8*)(lds + PG8_SA(b, h) + aoff + m * 2048 + k * 1024); } while (0)
#define PG8_LDB(dst, b, h) do { _Pragma("unroll") for (int n = 0; n < 2; ++n) _Pragma("unroll") for (int k = 0; k < 2; ++k) dst[n][k] = *(const PG8_LAS bf16x8*)(lds + PG8_SB(b, h) + boff + n * 2048 + k * 1024); } while (0)
#define PG8_MMA(ai, bj, At, Bt) do { __builtin_amdgcn_s_setprio(1); _Pragma("unroll") for (int m = 0; m < 4; ++m) _Pragma("unroll") for (int n = 0; n < 2; ++n) _Pragma("unroll") for (int k = 0; k < 2; ++k) \
        acc[ai][bj][m][n] = __builtin_amdgcn_mfma_f32_16x16x32_bf16(Bt[n][k], At[m][k], acc[ai][bj][m][n], 0, 0, 0); __builtin_amdgcn_s_setprio(0); } while (0)
#define PG8_WAIT_V(n) asm volatile("s_waitcnt vmcnt(" #n ")" ::: "memory")
#define PG8_WAIT_L(n) asm volatile("s_waitcnt lgkmcnt(" #n ")" ::: "memory")
#define PG8_BAR __builtin_amdgcn_s_barrier()
#define PG8_SCHED __builtin_amdgcn_sched_barrier(0)
    Unit cur, nxt; int ui = 0;
    if (!S.next(0, cur)) return;
    f32x4 acc[2][2][4][2];
#pragma unroll
    for (int a = 0; a < 2; ++a)
#pragma unroll
        for (int b = 0; b < 2; ++b)
#pragma unroll
            for (int m = 0; m < 4; ++m)
#pragma unroll
                for (int n = 0; n < 2; ++n) acc[a][b][m][n] = (f32x4){0.f, 0.f, 0.f, 0.f};
    bf16x8 At[4][2], B0[2][2], B1[2][2];
    const char* cA = (const char*)g.A + (size_t)cur.pm * tstepA; const char* cB = (const char*)g.Bt + (size_t)cur.pn * tstep;
    S.a_ready(cur);
    PG8_STAGE(PG8_SB(0, 0), cB, voffB); PG8_STAGE(PG8_SA(0, 0), cA, voffA); PG8_STAGE(PG8_SB(0, 1), cB + hstep, voffB); PG8_STAGE(PG8_SA(0, 1), cA + hstepA, voffA);
    if (wr == 1) PG8_BAR;
    PG8_WAIT_V(4); PG8_BAR;
    PG8_STAGE(PG8_SB(1, 0), cB + kstep, voffB); PG8_STAGE(PG8_SA(1, 0), cA + kstep, voffA); PG8_STAGE(PG8_SB(1, 1), cB + hstep + kstep, voffB);
    PG8_WAIT_V(6); PG8_BAR;
    PG8_STAMP();
    for (;;) {
        const bool has_next = S.next(ui + 1, nxt);
        const char* nA = has_next ? (const char*)g.A + (size_t)nxt.pm * tstepA : cA; const char* nB = has_next ? (const char*)g.Bt + (size_t)nxt.pn * tstep : cB;
        for (int t = 0; t < nt; t += 2) {
            const bool last = (t == nt - 2);
            const char* a1 = cA + (size_t)(t + 1) * kstep;
            const char* a2 = last ? nA : cA + (size_t)(t + 2) * kstep; const char* b2 = last ? nB : cB + (size_t)(t + 2) * kstep;
            const char* a3 = a2 + kstep; const char* b3 = b2 + kstep;
            if (last && has_next) S.a_ready(nxt);
            PG8_LDB(B0, 0, 0); PG8_SCHED; PG8_LDA(At, 0, 0); PG8_STAGE(PG8_SA(1, 1), a1 + hstepA, voffA);
            PG8_WAIT_L(8); PG8_BAR; PG8_WAIT_L(0); PG8_MMA(0, 0, At, B0); PG8_BAR; PG8_SCHED;
            PG8_LDB(B1, 0, 1); PG8_STAGE(PG8_SB(0, 0), b2, voffB);
            PG8_BAR; PG8_WAIT_L(0); PG8_MMA(0, 1, At, B1); PG8_BAR;
            PG8_LDA(At, 0, 1); PG8_STAGE(PG8_SA(0, 0), a2, voffA);
            PG8_BAR; PG8_WAIT_L(0); PG8_MMA(1, 0, At, B0); PG8_BAR; PG8_SCHED;
            PG8_STAGE(PG8_SB(0, 1), b2 + hstep, voffB);
            PG8_WAIT_V(6); PG8_BAR; PG8_MMA(1, 1, At, B1); PG8_BAR;
            PG8_LDB(B0, 1, 0); PG8_SCHED; PG8_LDA(At, 1, 0); PG8_STAGE(PG8_SA(0, 1), a2 + hstepA, voffA);
            PG8_WAIT_L(8); PG8_BAR; PG8_WAIT_L(0); PG8_MMA(0, 0, At, B0); PG8_BAR; PG8_SCHED;
            PG8_LDB(B1, 1, 1); PG8_STAGE(PG8_SB(1, 0), b3, voffB);
            PG8_BAR; PG8_WAIT_L(0); PG8_MMA(0, 1, At, B1); PG8_BAR;
            PG8_LDA(At, 1, 1); PG8_STAGE(PG8_SA(1, 0), a3, voffA);
            PG8_BAR; PG8_WAIT_L(0); PG8_MMA(1, 0, At, B0); PG8_BAR; PG8_SCHED;
            PG8_STAGE(PG8_SB(1, 1), b3 + hstep, voffB);
            PG8_WAIT_V(6); PG8_BAR; PG8_MMA(1, 1, At, B1); PG8_BAR;
        }
        PG8_STAMP();
        if constexpr (!Epi::AFTER_DRAIN) { E(acc, cur, wr, wc, fr, fq); S.done(cur); }
        PG8_STAMP();
        if (!has_next) break;
#pragma unroll
        for (int a = 0; a < 2; ++a)
#pragma unroll
            for (int b = 0; b < 2; ++b)
#pragma unroll
                for (int m = 0; m < 4; ++m)
#pragma unroll
                    for (int n = 0; n < 2; ++n) acc[a][b][m][n] = (f32x4){0.f, 0.f, 0.f, 0.f};
        cur = nxt; cA = nA; cB = nB; ++ui;
    }
    PG8_WAIT_V(0);
    if (wr == 0) PG8_BAR;
    PG8_BAR;
    if constexpr (Epi::AFTER_DRAIN) { E.fused(acc, cur, wr, wc, fr, fq, lds, wid, lane); S.done(cur); }
    PG8_STAMP();
    if (STAMP && wid == 0) { stamps[lane] = lane < nts ? (((unsigned long long)(unsigned)ts_hi << 32) | (unsigned)ts_lo) : 0ull;
        if (lane == 62) stamps[62] = rt_entry; if (lane == 63) stamps[63] = (unsigned long long)wall_clock64(); }
#undef PG8_STAMP
#undef PG8_SA
#undef PG8_SB
#undef PG8_STAGE
#undef PG8_LDA
#undef PG8_LDB
#undef PG8_MMA
#undef PG8_WAIT_V
#undef PG8_WAIT_L
#undef PG8_BAR
#undef PG8_SCHED
}

template <class Epi, class Sched, bool STAMP = false>
__device__ __forceinline__ void gemm_phase_f8(PG8_LAS unsigned char* lds, const Gemm g, const Sched& S, const Epi& E, unsigned long long* stamps, int tid_in) {
    int tid_ = tid_in; asm volatile("" : "+v"(tid_));
    const int tid = tid_, wid = __builtin_amdgcn_readfirstlane(tid >> 6), lane = tid & 63, wr = wid >> 2, wc = wid & 3, fr = lane & 15, fq = lane >> 4;
    const int K = g.K, nt = K / 128;
    int ts_lo = 0, ts_hi = 0, nts = 0; const unsigned long long rt_entry = STAMP ? (unsigned long long)wall_clock64() : 0ull;
#define PG8_STAMP() do { if (STAMP && wid == 0 && nts < 64) { const unsigned long long _c = (unsigned long long)clock64(); \
        ts_lo = (lane == nts) ? (int)(unsigned)_c : ts_lo; ts_hi = (lane == nts) ? (int)(unsigned)(_c >> 32) : ts_hi; ++nts; } } while (0)
    PG8_STAMP();
    unsigned voffA[2], voffB[2];
#pragma unroll
    for (int i = 0; i < 2; ++i) { int R, C; stage_rc(tid * 16 + i * 8192, R, C); const int Rb = Epi::PERM ? ((R & ~31) + perm32(R & 31)) : R;
        voffA[i] = (unsigned)(R * K + C * 2); voffB[i] = (unsigned)(Rb * K + C * 2); }
    const size_t kstep = (size_t)(BK * 2);
    const size_t hstep = (size_t)HALF * K;
    const size_t tstep = 2 * hstep;
    const unsigned ldsw = (unsigned)wid * 1024u;
    const int aoff = lds_byte(wr * 64 + fr, fq * 16), boff = lds_byte(wc * 32 + fr, fq * 16);
    const int aoffk[2] = {aoff + 16 * (fq & 1), aoff + 16 * ((fq & 1) ^ 1)}, boffk[2] = {boff + 16 * (fq & 1), boff + 16 * ((fq & 1) ^ 1)};
#define PG8_SA(b, h) (((b) * 2 + (h)) * HTB)
#define PG8_SB(b, h) ((4 + (b) * 2 + (h)) * HTB)
#define PG8_STAGE(bufoff, gbase, voff) do { _Pragma("unroll") for (int _i = 0; _i < 2; ++_i) \
        __builtin_amdgcn_global_load_lds((const unsigned*)((const char*)(gbase) + (voff)[_i]), (PG8_LAS unsigned*)(lds + (bufoff) + ldsw + _i * 8192), 16, 0, 0); } while (0)
#define PG8_LDA(dst, b, h) do { _Pragma("unroll") for (int m = 0; m < 4; ++m) _Pragma("unroll") for (int k = 0; k < 2; ++k) { const i32x4 t_ = *(const PG8_LAS i32x4*)(lds + PG8_SA(b, h) + aoffk[k] + m * 2048); \
        dst[m * 8 + k * 4 + 0] = t_[0]; dst[m * 8 + k * 4 + 1] = t_[1]; dst[m * 8 + k * 4 + 2] = t_[2]; dst[m * 8 + k * 4 + 3] = t_[3]; } } while (0)
#define PG8_LDB(dst, b, h) do { _Pragma("unroll") for (int n = 0; n < 2; ++n) _Pragma("unroll") for (int k = 0; k < 2; ++k) { const i32x4 t_ = *(const PG8_LAS i32x4*)(lds + PG8_SB(b, h) + boffk[k] + n * 2048); \
        dst[n * 8 + k * 4 + 0] = t_[0]; dst[n * 8 + k * 4 + 1] = t_[1]; dst[n * 8 + k * 4 + 2] = t_[2]; dst[n * 8 + k * 4 + 3] = t_[3]; } } while (0)
#define PG8_MMA(ai, bj, At, Bt) do { __builtin_amdgcn_s_setprio(1); \
        { f32x4 c_ = __builtin_shufflevector(accv[ai][bj], accv[ai][bj], 0, 1, 2, 3); c_ = __builtin_amdgcn_mfma_scale_f32_16x16x128_f8f6f4(__builtin_shufflevector(Bt, Bt, 0, 1, 2, 3, 4, 5, 6, 7), __builtin_shufflevector(At, At, 0, 1, 2, 3, 4, 5, 6, 7), c_, 0, 0, 0, 0, 0, 0); accv[ai][bj] = __builtin_shufflevector(accv[ai][bj], __builtin_shufflevector(c_, c_, 0, 1, 2, 3, -1, -1, -1, -1, -1, -1, -1, -1, -1, -1, -1, -1, -1, -1, -1, -1, -1, -1, -1, -1, -1, -1, -1, -1, -1, -1, -1, -1), 32, 33, 34, 35, 4, 5, 6, 7, 8, 9, 10, 11, 12, 13, 14, 15, 16, 17, 18, 19, 20, 21, 22, 23, 24, 25, 26, 27, 28, 29, 30, 31); } \
        { f32x4 c_ = __builtin_shufflevector(accv[ai][bj], accv[ai][bj], 4, 5, 6, 7); c_ = __builtin_amdgcn_mfma_scale_f32_16x16x128_f8f6f4(__builtin_shufflevector(Bt, Bt, 8, 9, 10, 11, 12, 13, 14, 15), __builtin_shufflevector(At, At, 0, 1, 2, 3, 4, 5, 6, 7), c_, 0, 0, 0, 0, 0, 0); accv[ai][bj] = __builtin_shufflevector(accv[ai][bj], __builtin_shufflevector(c_, c_, 0, 1, 2, 3, -1, -1, -1, -1, -1, -1, -1, -1, -1, -1, -1, -1, -1, -1, -1, -1, -1, -1, -1, -1, -1, -1, -1, -1, -1, -1, -1, -1), 0, 1, 2, 3, 32, 33, 34, 35, 8, 9, 10, 11, 12, 13, 14, 15, 16, 17, 18, 19, 20, 21, 22, 23, 24, 25, 26, 27, 28, 29, 30, 31); } \
        { f32x4 c_ = __builtin_shufflevector(accv[ai][bj], accv[ai][bj], 8, 9, 10, 11); c_ = __builtin_amdgcn_mfma_scale_f32_16x16x128_f8f6f4(__builtin_shufflevector(Bt, Bt, 0, 1, 2, 3, 4, 5, 6, 7), __builtin_shufflevector(At, At, 8, 9, 10, 11, 12, 13, 14, 15), c_, 0, 0, 0, 0, 0, 0); accv[ai][bj] = __builtin_shufflevector(accv[ai][bj], __builtin_shufflevector(c_, c_, 0, 1, 2, 3, -1, -1, -1, -1, -1, -1, -1, -1, -1, -1, -1, -1, -1, -1, -1, -1, -1, -1, -1, -1, -1, -1, -1, -1, -1, -1, -1, -1), 0, 1, 2, 3, 4, 5, 6, 7, 32, 33, 34, 35, 12, 13, 14, 15, 16, 17, 18, 19, 20, 21, 22, 23, 24, 25, 26, 27, 28, 29, 30, 31); } \
        { f32x4 c_ = __builtin_shufflevector(accv[ai][bj], accv[ai][bj], 12, 13, 14, 15); c_ = __builtin_amdgcn_mfma_scale_f32_16x16x128_f8f6f4(__builtin_shufflevector(Bt, Bt, 8, 9, 10, 11, 12, 13, 14, 15), __builtin_shufflevector(At, At, 8, 9, 10, 11, 12, 13, 14, 15), c_, 0, 0, 0, 0, 0, 0); accv[ai][bj] = __builtin_shufflevector(accv[ai][bj], __builtin_shufflevector(c_, c_, 0, 1, 2, 3, -1, -1, -1, -1, -1, -1, -1, -1, -1, -1, -1, -1, -1, -1, -1, -1, -1, -1, -1, -1, -1, -1, -1, -1, -1, -1, -1, -1), 0, 1, 2, 3, 4, 5, 6, 7, 8, 9, 10, 11, 32, 33, 34, 35, 16, 17, 18, 19, 20, 21, 22, 23, 24, 25, 26, 27, 28, 29, 30, 31); } \
        { f32x4 c_ = __builtin_shufflevector(accv[ai][bj], accv[ai][bj], 16, 17, 18, 19); c_ = __builtin_amdgcn_mfma_scale_f32_16x16x128_f8f6f4(__builtin_shufflevector(Bt, Bt, 0, 1, 2, 3, 4, 5, 6, 7), __builtin_shufflevector(At, At, 16, 17, 18, 19, 20, 21, 22, 23), c_, 0, 0, 0, 0, 0, 0); accv[ai][bj] = __builtin_shufflevector(accv[ai][bj], __builtin_shufflevector(c_, c_, 0, 1, 2, 3, -1, -1, -1, -1, -1, -1, -1, -1, -1, -1, -1, -1, -1, -1, -1, -1, -1, -1, -1, -1, -1, -1, -1, -1, -1, -1, -1, -1), 0, 1, 2, 3, 4, 5, 6, 7, 8, 9, 10, 11, 12, 13, 14, 15, 32, 33, 34, 35, 20, 21, 22, 23, 24, 25, 26, 27, 28, 29, 30, 31); } \
        { f32x4 c_ = __builtin_shufflevector(accv[ai][bj], accv[ai][bj], 20, 21, 22, 23); c_ = __builtin_amdgcn_mfma_scale_f32_16x16x128_f8f6f4(__builtin_shufflevector(Bt, Bt, 8, 9, 10, 11, 12, 13, 14, 15), __builtin_shufflevector(At, At, 16, 17, 18, 19, 20, 21, 22, 23), c_, 0, 0, 0, 0, 0, 0); accv[ai][bj] = __builtin_shufflevector(accv[ai][bj], __builtin_shufflevector(c_, c_, 0, 1, 2, 3, -1, -1, -1, -1, -1, -1, -1, -1, -1, -1, -1, -1, -1, -1, -1, -1, -1, -1, -1, -1, -1, -1, -1, -1, -1, -1, -1, -1), 0, 1, 2, 3, 4, 5, 6, 7, 8, 9, 10, 11, 12, 13, 14, 15, 16, 17, 18, 19, 32, 33, 34, 35, 24, 25, 26, 27, 28, 29, 30, 31); } \
        { f32x4 c_ = __builtin_shufflevector(accv[ai][bj], accv[ai][bj], 24, 25, 26, 27); c_ = __builtin_amdgcn_mfma_scale_f32_16x16x128_f8f6f4(__builtin_shufflevector(Bt, Bt, 0, 1, 2, 3, 4, 5, 6, 7), __builtin_shufflevector(At, At, 24, 25, 26, 27, 28, 29, 30, 31), c_, 0, 0, 0, 0, 0, 0); accv[ai][bj] = __builtin_shufflevector(accv[ai][bj], __builtin_shufflevector(c_, c_, 0, 1, 2, 3, -1, -1, -1, -1, -1, -1, -1, -1, -1, -1, -1, -1, -1, -1, -1, -1, -1, -1, -1, -1, -1, -1, -1, -1, -1, -1, -1, -1), 0, 1, 2, 3, 4, 5, 6, 7, 8, 9, 10, 11, 12, 13, 14, 15, 16, 17, 18, 19, 20, 21, 22, 23, 32, 33, 34, 35, 28, 29, 30, 31); } \
        { f32x4 c_ = __builtin_shufflevector(accv[ai][bj], accv[ai][bj], 28, 29, 30, 31); c_ = __builtin_amdgcn_mfma_scale_f32_16x16x128_f8f6f4(__builtin_shufflevector(Bt, Bt, 8, 9, 10, 11, 12, 13, 14, 15), __builtin_shufflevector(At, At, 24, 25, 26, 27, 28, 29, 30, 31), c_, 0, 0, 0, 0, 0, 0); accv[ai][bj] = __builtin_shufflevector(accv[ai][bj], __builtin_shufflevector(c_, c_, 0, 1, 2, 3, -1, -1, -1, -1, -1, -1, -1, -1, -1, -1, -1, -1, -1, -1, -1, -1, -1, -1, -1, -1, -1, -1, -1, -1, -1, -1, -1, -1), 0, 1, 2, 3, 4, 5, 6, 7, 8, 9, 10, 11, 12, 13, 14, 15, 16, 17, 18, 19, 20, 21, 22, 23, 24, 25, 26, 27, 32, 33, 34, 35); } \
        __builtin_amdgcn_s_setprio(0); } while (0)
#define PG8_WAIT_V(n) asm volatile("s_waitcnt vmcnt(" #n ")" ::: "memory")
#define PG8_WAIT_L(n) asm volatile("s_waitcnt lgkmcnt(" #n ")" ::: "memory")
#define PG8_BAR __builtin_amdgcn_s_barrier()
#define PG8_SCHED __builtin_amdgcn_sched_barrier(0)
    Unit cur, nxt; int ui = 0;
    if (!S.next(0, cur)) return;
    f32x32 accv[2][2];
#pragma unroll
    for (int a = 0; a < 2; ++a)
#pragma unroll
        for (int b = 0; b < 2; ++b) accv[a][b] = f32x32{};
    i32x32 At; i32x16 B0, B1;
    const char* cA = (const char*)g.A + (size_t)cur.pm * tstep; const char* cB = (const char*)g.Bt + (size_t)cur.pn * tstep;
    S.a_ready(cur);
    PG8_STAGE(PG8_SB(0, 0), cB, voffB); PG8_STAGE(PG8_SA(0, 0), cA, voffA); PG8_STAGE(PG8_SB(0, 1), cB + hstep, voffB); PG8_STAGE(PG8_SA(0, 1), cA + hstep, voffA);
    if (wr == 1) PG8_BAR;
    PG8_WAIT_V(4); PG8_BAR;
    PG8_STAGE(PG8_SB(1, 0), cB + kstep, voffB); PG8_STAGE(PG8_SA(1, 0), cA + kstep, voffA); PG8_STAGE(PG8_SB(1, 1), cB + hstep + kstep, voffB);
    PG8_WAIT_V(6); PG8_BAR;
    PG8_STAMP();
    for (;;) {
        const bool has_next = S.next(ui + 1, nxt);
        const char* nA = has_next ? (const char*)g.A + (size_t)nxt.pm * tstep : cA; const char* nB = has_next ? (const char*)g.Bt + (size_t)nxt.pn * tstep : cB;
        for (int t = 0; t < nt; t += 2) {
            const bool last = (t == nt - 2);
            const char* a1 = cA + (size_t)(t + 1) * kstep;
            const char* a2 = last ? nA : cA + (size_t)(t + 2) * kstep; const char* b2 = last ? nB : cB + (size_t)(t + 2) * kstep;
            const char* a3 = a2 + kstep; const char* b3 = b2 + kstep;
            if (last && has_next) S.a_ready(nxt);
            PG8_LDB(B0, 0, 0); PG8_SCHED; PG8_LDA(At, 0, 0); PG8_STAGE(PG8_SA(1, 1), a1 + hstep, voffA);
            PG8_WAIT_L(8); PG8_BAR; PG8_WAIT_L(0); PG8_MMA(0, 0, At, B0); PG8_BAR; PG8_SCHED;
            PG8_LDB(B1, 0, 1); PG8_STAGE(PG8_SB(0, 0), b2, voffB);
            PG8_BAR; PG8_WAIT_L(0); PG8_MMA(0, 1, At, B1); PG8_BAR;
            PG8_LDA(At, 0, 1); PG8_STAGE(PG8_SA(0, 0), a2, voffA);
            PG8_BAR; PG8_WAIT_L(0); PG8_MMA(1, 0, At, B0); PG8_BAR; PG8_SCHED;
            PG8_STAGE(PG8_SB(0, 1), b2 + hstep, voffB);
            PG8_WAIT_V(6); PG8_BAR; PG8_MMA(1, 1, At, B1); PG8_BAR;
            PG8_LDB(B0, 1, 0); PG8_SCHED; PG8_LDA(At, 1, 0); PG8_STAGE(PG8_SA(0, 1), a2 + hstep, voffA);
            PG8_WAIT_L(8); PG8_BAR; PG8_WAIT_L(0); PG8_MMA(0, 0, At, B0); PG8_BAR; PG8_SCHED;
            PG8_LDB(B1, 1, 1); PG8_STAGE(PG8_SB(1, 0), b3, voffB);
            PG8_BAR; PG8_WAIT_L(0); PG8_MMA(0, 1, At, B1); PG8_BAR;
            PG8_LDA(At, 1, 1); PG8_STAGE(PG8_SA(1, 0), a3, voffA);
            PG8_BAR; PG8_WAIT_L(0); PG8_MMA(1, 0, At, B0); PG8_BAR; PG8_SCHED;
            PG8_STAGE(PG8_SB(1, 1), b3 + hstep, voffB);
            PG8_WAIT_V(6); PG8_BAR; PG8_MMA(1, 1, At, B1); PG8_BAR;
        }
        PG8_STAMP();
        if constexpr (!Epi::AFTER_DRAIN) { f32x4 acc[2][2][4][2];
#pragma unroll
            for (int a = 0; a < 2; ++a)
#pragma unroll
                for (int b = 0; b < 2; ++b)
#pragma unroll
                    for (int m = 0; m < 4; ++m)
#pragma unroll
                        for (int n = 0; n < 2; ++n) { const int q_ = 4 * (m * 2 + n); acc[a][b][m][n] = (f32x4){accv[a][b][q_], accv[a][b][q_ + 1], accv[a][b][q_ + 2], accv[a][b][q_ + 3]}; }
            E(acc, cur, wr, wc, fr, fq); S.done(cur); }
        PG8_STAMP();
        if (!has_next) break;
#pragma unroll
        for (int a = 0; a < 2; ++a)
#pragma unroll
            for (int b = 0; b < 2; ++b) accv[a][b] = f32x32{};
        cur = nxt; cA = nA; cB = nB; ++ui;
    }
    PG8_WAIT_V(0);
    if (wr == 0) PG8_BAR;
    PG8_BAR;
    static_assert(!Epi::AFTER_DRAIN, "no fused epilogues in the fp8 body");
    PG8_STAMP();
    if (STAMP && wid == 0) { stamps[lane] = lane < nts ? (((unsigned long long)(unsigned)ts_hi << 32) | (unsigned)ts_lo) : 0ull;
        if (lane == 62) stamps[62] = rt_entry; if (lane == 63) stamps[63] = (unsigned long long)wall_clock64(); }
#undef PG8_STAMP
#undef PG8_SA
#undef PG8_SB
#undef PG8_STAGE
#undef PG8_LDA
#undef PG8_LDB
#undef PG8_MMA
#undef PG8_WAIT_V
#undef PG8_WAIT_L
#undef PG8_BAR
#undef PG8_SCHED
}

}

#define XB_TMO      128
#define XB_XCNT(j)  (256  + 64 * (j))
#define XB_XSUB(j)  (1280 + 64 * (j))
#define XB_XGEN(j)  (2304 + 64 * (j))
#define XB_TOP      3328
#define XB_TOPGEN   3392
#define XCD_BAR_WORDS 3456
#define XB_SPIN_CAP (1u << 18)
#define LAS __attribute__((address_space(3)))

__device__ __forceinline__ unsigned xb_ld(unsigned* p)              { return __hip_atomic_load(p, __ATOMIC_RELAXED, __HIP_MEMORY_SCOPE_AGENT); }
__device__ __forceinline__ unsigned xb_add(unsigned* p, unsigned v) { return __hip_atomic_fetch_add(p, v, __ATOMIC_RELAXED, __HIP_MEMORY_SCOPE_AGENT); }
__device__ __forceinline__ unsigned xb_xcc_id() { return (unsigned)__builtin_amdgcn_s_getreg((3 << 11) | 20) & 0xFu; }
#define XB_SPIN(cond, bar) do { unsigned _sp = 0; while (cond) { __builtin_amdgcn_s_sleep(1); \
    if ((++_sp & 255u) == 0u) { if (xb_ld(&(bar)[XB_TMO])) break; if (_sp > XB_SPIN_CAP) { atomicAdd(&(bar)[XB_TMO], 1u); break; } } } } while (0)

struct XcdBarrier {
    unsigned* bar; unsigned x; unsigned G;
    volatile LAS unsigned* st;
};

__device__ __forceinline__ XcdBarrier xcd_barrier_post(unsigned* bar, volatile LAS unsigned* st, bool t0  ) {
    XcdBarrier b; b.bar = bar; b.x = xb_xcc_id(); b.st = st; b.G = 0u;
    if (t0) (void)xb_add(&bar[XB_XCNT(b.x)], 1u);
    return b;
}
__device__ __forceinline__ void xcd_barrier_complete(unsigned* bar, unsigned x, unsigned G, unsigned& nloc, unsigned& nx) {
    unsigned sum, cnt, mine, sp = 0u;
    for (;;) {
        sum = 0u; cnt = 0u; mine = 0u;
#pragma unroll
        for (unsigned j = 0; j < 16; ++j) { const unsigned c = xb_ld(&bar[XB_XCNT(j)]); sum += c; cnt += (c > 0u) ? 1u : 0u; mine = (j == x) ? c : mine; }
        if (sum == G) break;
        __builtin_amdgcn_s_sleep(1);
        if ((++sp & 255u) == 0u) { if (xb_ld(&bar[XB_TMO])) break; if (sp > XB_SPIN_CAP) { atomicAdd(&bar[XB_TMO], 1u); break; } }
    }
    nloc = mine > 0u ? mine : 1u; nx = cnt > 0u ? cnt : 1u;
}

__device__ __forceinline__ void xcd_barrier(const XcdBarrier& b, bool t0  ) {
    asm volatile("s_waitcnt vmcnt(0)" ::: "memory");
    __syncthreads();
    if (t0) {
        unsigned* bar = b.bar;
        __builtin_amdgcn_s_waitcnt(0);
        unsigned nloc = b.st[0], nx = b.st[1];
        if (nloc == 0u) { xcd_barrier_complete(bar, b.x, b.G, nloc, nx); b.st[0] = nloc; b.st[1] = nx; }
        const unsigned old = xb_add(&bar[XB_XSUB(b.x)], 1u);
        const unsigned gen = old / nloc;
        if (old + 1u == (gen + 1u) * nloc) {
            __builtin_amdgcn_fence(__ATOMIC_RELEASE, "agent");
            asm volatile("s_waitcnt vmcnt(0)" ::: "memory");
            const unsigned og = xb_add(&bar[XB_TOP], 1u);
            const unsigned tg = og / nx;
            if (og + 1u == (tg + 1u) * nx) xb_add(&bar[XB_TOPGEN], 1u);
            else XB_SPIN(xb_ld(&bar[XB_TOPGEN]) == tg, bar);
            __builtin_amdgcn_fence(__ATOMIC_ACQUIRE, "agent");
            xb_add(&bar[XB_XGEN(b.x)], 1u);
            asm volatile("s_waitcnt vmcnt(0)" ::: "memory");
        } else {
            XB_SPIN(xb_ld(&bar[XB_XGEN(b.x)]) == gen, bar);
            __builtin_amdgcn_fence(__ATOMIC_ACQUIRE, "agent");
            asm volatile("s_waitcnt vmcnt(0)" ::: "memory");
        }
    }
    __syncthreads();
}


namespace mk {
typedef unsigned short bf16_t;
typedef short bf16x8 __attribute__((ext_vector_type(8)));
typedef short s16x4 __attribute__((ext_vector_type(4)));
typedef float f32x16 __attribute__((ext_vector_type(16)));
typedef float f32x4 __attribute__((ext_vector_type(4)));
typedef unsigned u32x4 __attribute__((ext_vector_type(4)));
typedef unsigned u32x2 __attribute__((ext_vector_type(2)));
typedef __bf16 bf2 __attribute__((ext_vector_type(2)));
typedef float f32x16v __attribute__((ext_vector_type(16)));
typedef float f32x32v __attribute__((ext_vector_type(32)));
typedef unsigned u32x6 __attribute__((ext_vector_type(6)));
typedef _Float16 h16x32 __attribute__((ext_vector_type(32)));
typedef _Float16 h16x2 __attribute__((ext_vector_type(2)));

constexpr int TT = 16384, T = 8192, S = 2048, NB = 4, DM = 4096, NIN = 10560, NINP = 10752, NH = 8, NEXP = 16384;
constexpr float EPS = 1e-6f;
constexpr float O8_SCALE = 32.0f, WOUT8_SCALE = 2048.0f;
constexpr float HN8_SCALE = 16.0f, WIN8_SCALE = 2048.0f;
constexpr float U_SCALE = 128.0f, V_SCALE = 5.656854249f;
constexpr int NWAVES = 8, NTHR = 512;
constexpr int LDS_BYTES = 143360;
constexpr int LDS_XB = 131072;
constexpr int LDS_G1X = 131072 + 1024;

constexpr size_t SZ_WIN = (size_t)NINP * DM * 2, SZ_WOUT = (size_t)DM * DM * 2, SZ_W2 = (size_t)2048 * DM * 2, SZ_WUQ = (size_t)1536 * 768 * 2, SZ_WUKV = (size_t)2048 * 512 * 2,
                 SZ_TAB = (size_t)NEXP * 3072;
constexpr size_t LW_WIN = 0, LW_WOUT = LW_WIN + SZ_WIN, LW_W2 = LW_WOUT + SZ_WOUT, LW_WUQ = LW_W2 + SZ_W2, LW_WUKV = LW_WUQ + SZ_WUQ, LW_U = LW_WUKV + SZ_WUKV, LW_V = LW_U + SZ_TAB,
                 LW_END = LW_V + SZ_TAB;
constexpr size_t WS_CTL = 0, WS_SSQ = 65536, WS_W = 65536 + 2 * 65536;
constexpr size_t WS_HN = WS_W + 2 * LW_END, SZ_HN = (size_t)T * DM * 2, WS_P = WS_HN + SZ_HN, SZ_P = (size_t)T * NINP * 2;
constexpr size_t SZ_H1 = (size_t)T * 1024 * 2;
constexpr size_t WS_QKV = WS_P + SZ_P;
constexpr size_t QO_QA = 0, QO_KA = SZ_H1, QO_VA = 2 * SZ_H1, QO_QB = 3 * SZ_H1, QO_KB = 4 * SZ_H1, QO_VB = 5 * SZ_H1, QO_QC = 6 * SZ_H1, QO_KC = 7 * SZ_H1, QO_VC = 8 * SZ_H1,
                 QO_QD = 9 * SZ_H1, SZ_QD = (size_t)T * 1536 * 2, QO_KD = QO_QD + SZ_QD, QO_VD = QO_KD + SZ_QD, SZ_QKV = QO_VD + SZ_H1;
constexpr size_t WS_O = WS_QKV + SZ_QKV, SZ_O = (size_t)T * DM * 2, WS_T2 = WS_O + SZ_O, SZ_T2 = (size_t)2 * T * 1024 * 4, WS_END = WS_T2 + SZ_T2;
constexpr size_t SZ_F1 = (size_t)T * 1024 * 4;
constexpr size_t PO_OA = 0, PO_OB = 2 * SZ_H1, PO_LSE = 5 * SZ_H1, SZ_LSE = (size_t)3 * T * 8 * 4;
static_assert(PO_LSE + SZ_LSE <= SZ_P, "P alias");
constexpr size_t PO_SC = 0, SZ_SC = (size_t)T * 2048 * 4, PO_EXP = SZ_SC, SZ_EG = (size_t)T * 128 * 4, PO_GATE = PO_EXP + SZ_EG;
static_assert(PO_GATE + SZ_EG <= SZ_P, "P alias 2");
constexpr size_t OO_QRAW = 0, OO_KVRAW = (size_t)T * 1536 * 2;
static_assert(OO_KVRAW + (size_t)T * 2048 * 2 <= SZ_O, "O alias");
constexpr size_t TO_HN8 = 0;
constexpr size_t TO_CQ = 0, TO_CKV = (size_t)T * 768 * 2;
constexpr size_t ACT_SZ = WS_END - WS_HN, WS_TOTAL = WS_HN + 2 * ACT_SZ;
constexpr size_t TO_OC = 0, TO_OD = SZ_F1;

struct Args { const float* in[20]; float* out; unsigned char* ws; };
enum { I_X = 0, I_GMIX, I_WIN, I_WOUT, I_DLAM, I_DGQK, I_DGOUT, I_DILG, I_NAG, I_RPB, I_GCQ, I_GCKV, I_WUQ, I_WUKV, I_MLAG, I_GFFN, I_PWQ, I_PSK, I_PU, I_PV };

struct Frame {
    const Args* a; float* out; unsigned char* ws; LAS unsigned char* lds;
    int tid, lane, wid;
    int rank, nwg;
};

#ifdef MK_XCDSPLIT
__device__ __forceinline__ int sid() { return ((int)blockIdx.x >> 2) & 1; }
__device__ __forceinline__ int wg_rank() { return (((int)blockIdx.x >> 3) << 2) | ((int)blockIdx.x & 3); }
#else
__device__ __forceinline__ int sid() { return ((int)blockIdx.x >> 3) & 1; }
__device__ __forceinline__ int wg_rank() { return (((int)blockIdx.x >> 4) << 3) | ((int)blockIdx.x & 7); }
#endif
__device__ __forceinline__ int wg_count() { return (int)gridDim.x >> 1; }

#define MK_DPP_ADD(v, ctrl) v += __int_as_float(__builtin_amdgcn_update_dpp(0, __float_as_int(v), ctrl, 0xF, 0xF, true))
__device__ __forceinline__ float wave_total(float v) {
    MK_DPP_ADD(v, 0xB1); MK_DPP_ADD(v, 0x4E); MK_DPP_ADD(v, 0x141); MK_DPP_ADD(v, 0x140);
    const int vi = __float_as_int(v);
    return (__int_as_float(__builtin_amdgcn_readlane(vi, 0)) + __int_as_float(__builtin_amdgcn_readlane(vi, 16))) + (__int_as_float(__builtin_amdgcn_readlane(vi, 32)) + __int_as_float(__builtin_amdgcn_readlane(vi, 48)));
}
__device__ __forceinline__ float wsum(float v) { return wave_total(v); }
__device__ __forceinline__ float sum4(float v) { MK_DPP_ADD(v, 0xB1); MK_DPP_ADD(v, 0x4E); return v; }
__device__ __forceinline__ float sum8(float v) { MK_DPP_ADD(v, 0xB1); MK_DPP_ADD(v, 0x4E); MK_DPP_ADD(v, 0x141); return v; }
__device__ __forceinline__ unsigned pk_bf16(float lo, float hi) { unsigned r; asm volatile("v_cvt_pk_bf16_f32 %0, %1, %2" : "=v"(r) : "v"(lo), "v"(hi)); return r; }
__device__ __forceinline__ unsigned pk_fp8x4(float a, float b, float c, float d) {
    a = fminf(fmaxf(a, -448.f), 448.f); b = fminf(fmaxf(b, -448.f), 448.f); c = fminf(fmaxf(c, -448.f), 448.f); d = fminf(fmaxf(d, -448.f), 448.f);
    int p = 0; p = __builtin_amdgcn_cvt_pk_fp8_f32(a, b, p, false); p = __builtin_amdgcn_cvt_pk_fp8_f32(c, d, p, true); return (unsigned)p; }
__device__ __forceinline__ float bf_lo(unsigned w) { return __uint_as_float(w << 16); }
__device__ __forceinline__ float bf_hi(unsigned w) { return __uint_as_float(w & 0xffff0000u); }

template <bool F8> __device__ __forceinline__ void transpose_tile4(const Frame& F, const float* __restrict__ src, int N, int K, bf16_t* __restrict__ dst, const float* __restrict__ gain, int k0, int n0) {
    LAS float* tile = (LAS float*)F.lds;
    const int r = F.tid >> 4, c4 = F.tid & 15;
    f32x4 v[8]; float g[8];
#pragma unroll
    for (int i = 0; i < 8; ++i) { const int k = r + 32 * i; v[i] = *(const f32x4*)(src + (size_t)(k0 + k) * N + n0 + c4 * 4); g[i] = gain ? gain[k0 + k] : 1.0f; }
#pragma unroll
    for (int i = 0; i < 8; ++i) { const int k = r + 32 * i;
        tile[k * 65 + c4 * 4 + 0] = v[i][0] * g[i]; tile[k * 65 + c4 * 4 + 1] = v[i][1] * g[i]; tile[k * 65 + c4 * 4 + 2] = v[i][2] * g[i]; tile[k * 65 + c4 * 4 + 3] = v[i][3] * g[i]; }
    __syncthreads();
    const int n = F.tid >> 3, k8 = F.tid & 7;
#pragma unroll
    for (int q = 0; q < 4; ++q) { float e[8];
#pragma unroll
        for (int j = 0; j < 8; ++j) e[j] = tile[(q * 64 + k8 * 8 + j) * 65 + n];
        if (F8) { u32x2 w; w.x = pk_fp8x4(e[0] * 2048.0f, e[1] * 2048.0f, e[2] * 2048.0f, e[3] * 2048.0f); w.y = pk_fp8x4(e[4] * 2048.0f, e[5] * 2048.0f, e[6] * 2048.0f, e[7] * 2048.0f);
            *(u32x2*)((unsigned char*)dst + (size_t)(n0 + n) * K + k0 + q * 64 + k8 * 8) = w; }
        else { u32x4 w; w.x = pk_bf16(e[0], e[1]); w.y = pk_bf16(e[2], e[3]); w.z = pk_bf16(e[4], e[5]); w.w = pk_bf16(e[6], e[7]);
            *(u32x4*)(dst + (size_t)(n0 + n) * K + k0 + q * 64 + k8 * 8) = w; } }
    __syncthreads();
}

struct TDesc { const float* src; const float* gain; unsigned char* dst; int N, K, k0, n0, f8; };
__device__ __forceinline__ TDesc t_decode(const Frame& F, int u) {
    constexpr int N_WIN = 16 * 165, N_WOUT = 16 * 64, N_UQ = 3 * 24, N_UKV = 2 * 32, N_L = N_WIN + N_WOUT + N_UQ + N_UKV;
    const int l = u / N_L; int r = u % N_L; unsigned char* lw = F.a->ws + WS_W + (size_t)l * LW_END; TDesc d;
    if (r < N_WIN) { d.src = F.a->in[I_WIN] + (size_t)l * DM * NIN; d.gain = F.a->in[I_GMIX] + l * DM; d.dst = lw + LW_WIN; d.N = NIN; d.K = DM; d.k0 = (r & 15) * 256; d.n0 = (r >> 4) * 64; d.f8 = 1; return d; }
    r -= N_WIN;
    if (r < N_WOUT) { d.src = F.a->in[I_WOUT] + (size_t)l * DM * DM; d.gain = nullptr; d.dst = lw + LW_WOUT; d.N = DM; d.K = DM; d.k0 = (r & 15) * 256; d.n0 = (r >> 4) * 64; d.f8 = 1; return d; }
    r -= N_WOUT;
    if (r < N_UQ) { d.src = F.a->in[I_WUQ] + (size_t)l * 768 * 1536; d.gain = F.a->in[I_GCQ] + l * 768; d.dst = lw + LW_WUQ; d.N = 1536; d.K = 768; d.k0 = (r % 3) * 256; d.n0 = (r / 3) * 64; d.f8 = 0; return d; }
    r -= N_UQ;
    d.src = F.a->in[I_WUKV] + (size_t)l * 512 * 2048; d.gain = F.a->in[I_GCKV] + l * 512; d.dst = lw + LW_WUKV; d.N = 2048; d.K = 512; d.k0 = (r & 1) * 256; d.n0 = (r >> 1) * 64; d.f8 = 0; return d;
}
#define MK_TLOAD(d, v, g) do { const int r_ = F.tid >> 4, c4_ = F.tid & 15; _Pragma("unroll") for (int i = 0; i < 8; ++i) { const int k_ = r_ + 32 * i; \
        v[i] = *(const f32x4*)(d.src + (size_t)(d.k0 + k_) * d.N + d.n0 + c4_ * 4); g[i] = d.gain ? d.gain[d.k0 + k_] : 1.0f; } } while (0)
#define MK_TFIN(d, v, g) do { LAS float* tile = (LAS float*)F.lds; const int r_ = F.tid >> 4, c4_ = F.tid & 15; \
        _Pragma("unroll") for (int i = 0; i < 8; ++i) { const int k_ = r_ + 32 * i; \
            tile[k_ * 65 + c4_ * 4 + 0] = v[i][0] * g[i]; tile[k_ * 65 + c4_ * 4 + 1] = v[i][1] * g[i]; tile[k_ * 65 + c4_ * 4 + 2] = v[i][2] * g[i]; tile[k_ * 65 + c4_ * 4 + 3] = v[i][3] * g[i]; } \
        __syncthreads(); \
        const int n_ = F.tid >> 3, k8_ = F.tid & 7; \
        _Pragma("unroll") for (int q = 0; q < 4; ++q) { float e[8]; \
            _Pragma("unroll") for (int j = 0; j < 8; ++j) e[j] = tile[(q * 64 + k8_ * 8 + j) * 65 + n_]; \
            if (d.f8) { u32x2 w; w.x = pk_fp8x4(e[0] * 2048.0f, e[1] * 2048.0f, e[2] * 2048.0f, e[3] * 2048.0f); w.y = pk_fp8x4(e[4] * 2048.0f, e[5] * 2048.0f, e[6] * 2048.0f, e[7] * 2048.0f);     \
                *(u32x2*)(d.dst + (size_t)(d.n0 + n_) * d.K + d.k0 + q * 64 + k8_ * 8) = w; } \
            else { u32x4 w; w.x = pk_bf16(e[0], e[1]); w.y = pk_bf16(e[2], e[3]); w.z = pk_bf16(e[4], e[5]); w.w = pk_bf16(e[6], e[7]); \
                *(u32x4*)((bf16_t*)d.dst + (size_t)(d.n0 + n_) * d.K + d.k0 + q * 64 + k8_ * 8) = w; } } \
        __syncthreads(); } while (0)
__device__ __forceinline__ void p0_transpose_range(const Frame& F, int u0, int u1, int rank, int nwg) {
    int u = u0 + rank; if (u >= u1) return;
    TDesc a = t_decode(F, u), b = a; f32x4 va[8], vb[8]; float ga[8], gb[8];
    MK_TLOAD(a, va, ga);
    for (; u < u1; u += 2 * nwg) {
        const bool hb = u + nwg < u1; if (hb) { b = t_decode(F, u + nwg); MK_TLOAD(b, vb, gb); }
        MK_TFIN(a, va, ga);
        const bool ha = u + 2 * nwg < u1; if (ha) { a = t_decode(F, u + 2 * nwg); MK_TLOAD(a, va, ga); }
        if (hb) MK_TFIN(b, vb, gb);
    }
}
#undef MK_TLOAD
#undef MK_TFIN

__device__ __forceinline__ void p0_w2t(const Frame& F, int rank, int nwg) {
    {
        LAS float* SK = (LAS float*)F.lds;
        LAS float* WQ = (LAS float*)(F.lds + 65536);
        for (int u = rank; u < 2 * 16 * 64; u += nwg) {
            const int l = u >> 10, hc = (u >> 6) & 15, k0 = (u & 63) * 64;
            const float* sk = F.a->in[I_PSK] + (size_t)(l * 16 + hc) * 128 * 128;
            const float* wq = F.a->in[I_PWQ] + (size_t)l * DM * 2048 + (size_t)k0 * 2048 + hc * 128;
#pragma unroll
            for (int i = 0; i < 8; ++i) { const int idx = F.tid + NTHR * i, row = idx >> 5, c4 = idx & 31; *(LAS f32x4*)(SK + row * 128 + c4 * 4) = *(const f32x4*)(sk + row * 128 + c4 * 4); }
#pragma unroll
            for (int i = 0; i < 4; ++i) { const int idx = F.tid + NTHR * i, row = idx >> 5, c4 = idx & 31; *(LAS f32x4*)(WQ + row * 132 + c4 * 4) = *(const f32x4*)(wq + (size_t)row * 2048 + c4 * 4); }
            __syncthreads();
            const int k = F.lane, ng = F.wid;
            float acc[16];
#pragma unroll
            for (int j = 0; j < 16; ++j) acc[j] = 0.f;
            for (int d4 = 0; d4 < 32; ++d4) { const f32x4 w = *(const LAS f32x4*)(WQ + k * 132 + d4 * 4);
#pragma unroll
                for (int j = 0; j < 16; ++j) { const f32x4 s = *(const LAS f32x4*)(SK + (ng * 16 + j) * 128 + d4 * 4); acc[j] += w[0] * s[0] + w[1] * s[1] + w[2] * s[2] + w[3] * s[3]; } }
            const float g = F.a->in[I_GFFN][l * DM + k0 + k];
            bf16_t* w2 = (bf16_t*)(F.a->ws + WS_W + (size_t)l * LW_END + LW_W2);
#pragma unroll
            for (int j = 0; j < 16; ++j) w2[(size_t)(hc * 128 + ng * 16 + j) * DM + k0 + k] = (bf16_t)(pk_bf16(acc[j] * g, 0.f) & 0xffffu);
            __syncthreads();
        }
    }
}

__device__ __forceinline__ void p0_a(const Frame& F) {
    constexpr int N_WIN = 16 * 165;
    p0_transpose_range(F, 0, N_WIN, (int)blockIdx.x, (int)gridDim.x);
    for (int i = (int)blockIdx.x * NTHR + F.tid; i < 2 * 192 * DM / 16; i += (int)gridDim.x * NTHR) { const int l = i / (192 * DM / 16), o = i % (192 * DM / 16);
        *(u32x4*)(F.a->ws + WS_W + (size_t)l * LW_END + LW_WIN + (size_t)NIN * DM + (size_t)o * 16) = (u32x4){0u, 0u, 0u, 0u}; }
}

__device__ __forceinline__ void p0_b(const Frame& F, int rank, int nwg) {
    constexpr int N_WIN = 16 * 165, N_WOUT = 16 * 64, N_UQ = 3 * 24, N_UKV = 2 * 32, N_L = N_WIN + N_WOUT + N_UQ + N_UKV;
    p0_transpose_range(F, N_WIN, 2 * N_L, rank, nwg);
    {
        constexpr size_t NIT = (size_t)NEXP * 64;
        const size_t stride = (size_t)nwg * NTHR; const int nit = (int)((4 * NIT - (size_t)rank * NTHR + stride - 1) / stride);
        const int slot = (rank * 13) % nit; int it = 0;
        for (size_t base = (size_t)rank * NTHR; base < 4 * NIT; base += stride, ++it) {
            if (it == slot) p0_w2t(F, rank, nwg);
            const size_t i = base + F.tid;
            const int tb = (int)(i / NIT); const size_t o = i % NIT; const int l = tb >> 1, isv = tb & 1; const size_t row = o >> 6; const int ln = (int)(o & 63);
            const float* src = (isv ? F.a->in[I_PV] : F.a->in[I_PU]) + (size_t)l * NEXP * DM + row * DM + 4 * ln; const float* g = F.a->in[I_GFFN] + l * DM + 4 * ln;
            const float sc = isv ? V_SCALE : U_SCALE;
            f32x4 x[16];
#pragma unroll
            for (int c = 0; c < 16; ++c) { x[c] = *(const f32x4*)(src + c * 256); if (!isv) x[c] *= *(const f32x4*)(g + c * 256);
#pragma unroll
                for (int j = 0; j < 4; ++j) x[c][j] = fminf(fmaxf(x[c][j] * sc, -7.5f), 7.5f); }
            u32x4 w[3];
#pragma unroll
            for (int q = 0; q < 2; ++q) { f32x16v s0, s1;
#pragma unroll
                for (int c = 0; c < 8; ++c) { s0[2 * c] = x[8 * q + c][0]; s1[2 * c] = x[8 * q + c][1]; s0[2 * c + 1] = x[8 * q + c][2]; s1[2 * c + 1] = x[8 * q + c][3]; }
                const u32x6 p = __builtin_amdgcn_cvt_scalef32_2xpk16_fp6_f32(s0, s1, 1.0f);
#pragma unroll
                for (int k = 0; k < 6; ++k) w[(6 * q + k) >> 2][(6 * q + k) & 3] = p[k]; }
            unsigned char* dst = F.a->ws + WS_W + (size_t)l * LW_END + (isv ? LW_V : LW_U) + row * 3072 + ln * 48;
#pragma unroll
            for (int k = 0; k < 3; ++k) *(u32x4*)(dst + 16 * k) = w[k];
        }
    }
}

__device__ __forceinline__ void p_norm(const Frame& F, const float* __restrict__ x, bf16_t* __restrict__ hn) {
    for (int t = F.rank * NWAVES + F.wid; t < T; t += F.nwg * NWAVES) {
        const f32x4* xr = (const f32x4*)(x + (size_t)t * DM);
        f32x4 v[16]; float ss = 0.f;
#pragma unroll
        for (int i = 0; i < 16; ++i) { v[i] = xr[i * 64 + F.lane]; ss += v[i][0] * v[i][0] + v[i][1] * v[i][1] + v[i][2] * v[i][2] + v[i][3] * v[i][3]; }
        ss = wsum(ss);
        const float r = rsqrtf(ss * (1.0f / DM) + EPS);
        unsigned* o = (unsigned*)((unsigned char*)hn + (size_t)t * DM); const float r8 = r * HN8_SCALE;
#pragma unroll
        for (int i = 0; i < 16; ++i) o[i * 64 + F.lane] = pk_fp8x4(v[i][0] * r8, v[i][1] * r8, v[i][2] * r8, v[i][3] * r8);
    }
}

__device__ __forceinline__ void unpack16(const u32x4 a, const u32x4 b, float (&x)[16]) {
#pragma unroll
    for (int i = 0; i < 4; ++i) { x[2 * i] = bf_lo(a[i]); x[2 * i + 1] = bf_hi(a[i]); x[8 + 2 * i] = bf_lo(b[i]); x[8 + 2 * i + 1] = bf_hi(b[i]); }
}
__device__ __forceinline__ void p_post1(const Frame& F, int l) {
    const bf16_t* P = (const bf16_t*)(F.ws + WS_P);
    for (int t = F.rank * NWAVES + F.wid; t < T; t += F.nwg * NWAVES) {
        const bf16_t* pr = P + (size_t)t * NINP; const int lane = F.lane;
        u32x2 cq3[3]; u32x4 ckv4;
#pragma unroll
        for (int i = 0; i < 3; ++i) cq3[i] = ((const u32x2*)(pr + 9216 + lane * 12))[i];
        ckv4 = *(const u32x4*)(pr + 9984 + lane * 8);
        {
            u32x2 c[3]; float ss = 0.f;
#pragma unroll
            for (int i = 0; i < 3; ++i) { c[i] = cq3[i]; const float a0 = bf_lo(c[i].x), a1 = bf_hi(c[i].x), a2 = bf_lo(c[i].y), a3 = bf_hi(c[i].y); ss += a0 * a0 + a1 * a1 + a2 * a2 + a3 * a3; }
            ss = wsum(ss); const float r = rsqrtf(ss * (1.0f / 768) + EPS);
            u32x2* d = (u32x2*)((bf16_t*)(F.ws + WS_T2 + TO_CQ) + (size_t)t * 768 + lane * 12);
#pragma unroll
            for (int i = 0; i < 3; ++i) { u32x2 w; w.x = pk_bf16(bf_lo(c[i].x) * r, bf_hi(c[i].x) * r); w.y = pk_bf16(bf_lo(c[i].y) * r, bf_hi(c[i].y) * r); d[i] = w; }
        }
        {
            const u32x4 c = ckv4; float ss = 0.f;
#pragma unroll
            for (int i = 0; i < 4; ++i) { const float a0 = bf_lo(c[i]), a1 = bf_hi(c[i]); ss += a0 * a0 + a1 * a1; }
            ss = wsum(ss); const float r = rsqrtf(ss * (1.0f / 512) + EPS);
            u32x4 w;
#pragma unroll
            for (int i = 0; i < 4; ++i) w[i] = pk_bf16(bf_lo(c[i]) * r, bf_hi(c[i]) * r);
            *(u32x4*)((bf16_t*)(F.ws + WS_T2 + TO_CKV) + (size_t)t * 512 + lane * 8) = w;
        }
    }
}

__device__ __forceinline__ void p_post2(const Frame& F, int l) {
    const bf16_t* QR = (const bf16_t*)(F.ws + WS_O + OO_QRAW); const bf16_t* KVR = (const bf16_t*)(F.ws + WS_O + OO_KVRAW); const bf16_t* P = (const bf16_t*)(F.ws + WS_P);
    bf16_t* QD = (bf16_t*)(F.ws + WS_QKV + QO_QD); bf16_t* KD = (bf16_t*)(F.ws + WS_QKV + QO_KD); bf16_t* VD = (bf16_t*)(F.ws + WS_QKV + QO_VD);
    LAS float* L = (LAS float*)F.lds + F.wid * 3712; LAS float* q = L; LAS float* kv = L + 1536; LAS float* kr = L + 3584; LAS float* cs = L + 3648;
    const float* g0 = F.a->in[I_MLAG] + (size_t)(l * 2 + 0) * 192; const float* g1 = F.a->in[I_MLAG] + (size_t)(l * 2 + 1) * 192;
    const int lane = F.lane;
    for (int t = F.rank * NWAVES + F.wid; t < T; t += F.nwg * NWAVES) {
        const int b = t / S, s = t % S;
        float aq, akv;
        { const bf16_t* pr = P + (size_t)t * NINP; float sq = 0.f, sk = 0.f;
#pragma unroll
          for (int i = 0; i < 3; ++i) { const u32x2 c2 = ((const u32x2*)(pr + 9216 + lane * 12))[i]; const float a0 = bf_lo(c2.x), a1 = bf_hi(c2.x), a2 = bf_lo(c2.y), a3 = bf_hi(c2.y); sq += (a0 * a0 + a1 * a1) + (a2 * a2 + a3 * a3); }
          { const u32x4 c4 = *(const u32x4*)(pr + 9984 + lane * 8);
#pragma unroll
            for (int i = 0; i < 4; ++i) { const float a0 = bf_lo(c4[i]), a1 = bf_hi(c4[i]); sk += a0 * a0 + a1 * a1; } }
          aq = rsqrtf(wave_total(sq) * (1.0f / 768) + EPS); akv = rsqrtf(wave_total(sk) * (1.0f / 512) + EPS); }
#pragma unroll
        for (int i = 0; i < 3; ++i) { const int c = lane + 64 * i; const u32x4 w = *(const u32x4*)(QR + (size_t)t * 1536 + c * 8);
            *(LAS f32x4*)(q + c * 8) = (f32x4){bf_lo(w[0]), bf_hi(w[0]), bf_lo(w[1]), bf_hi(w[1])}; *(LAS f32x4*)(q + c * 8 + 4) = (f32x4){bf_lo(w[2]), bf_hi(w[2]), bf_lo(w[3]), bf_hi(w[3])}; }
#pragma unroll
        for (int i = 0; i < 4; ++i) { const int c = lane + 64 * i; const u32x4 w = *(const u32x4*)(KVR + (size_t)t * 2048 + c * 8);
            *(LAS f32x4*)(kv + c * 8) = (f32x4){bf_lo(w[0]), bf_hi(w[0]), bf_lo(w[1]), bf_hi(w[1])}; *(LAS f32x4*)(kv + c * 8 + 4) = (f32x4){bf_lo(w[2]), bf_hi(w[2]), bf_lo(w[3]), bf_hi(w[3])}; }
        u32x4 vcp[2];
#pragma unroll
        for (int i = 0; i < 2; ++i) { const int c = lane + 64 * i; vcp[i] = *(const u32x4*)(KVR + (size_t)t * 2048 + (c >> 4) * 256 + 128 + (c & 15) * 8); }
        kr[lane] = __uint_as_float(((unsigned)P[(size_t)t * NINP + 10496 + lane]) << 16);
        if (lane < 32) { const float inv = exp2f(-(float)lane * (2.0f / 64.0f) * 13.287712379549449f);
            float rev = (float)s * inv * 0.15915494309189535f; rev -= rintf(rev);
            cs[lane] = __builtin_amdgcn_cosf(rev); cs[32 + lane] = __builtin_amdgcn_sinf(rev); }
        asm volatile("s_waitcnt lgkmcnt(0)" ::: "memory");
        const int h = lane >> 3, part = lane & 7;
        float qss = 0.f, kss = 0.f;
#pragma unroll
        for (int j = 0; j < 24; ++j) { const float a = q[h * 192 + part + 8 * j]; qss += a * a; }
#pragma unroll
        for (int j = 0; j < 16; ++j) { const float a = kv[h * 256 + part + 8 * j]; kss += a * a; }
        kss *= akv * akv;
#pragma unroll
        for (int j = 0; j < 8; ++j) { const float a = kr[part + 8 * j]; kss += a * a; }
        qss = sum8(qss); kss = sum8(kss);
        const float rq = rsqrtf(aq * aq * qss * (1.0f / 192) + EPS) * aq * 0.07216878364870322f;
        const float rk = rsqrtf(kss * (1.0f / 192) + EPS);
#pragma unroll
        for (int i = 0; i < 3; ++i) {
            const int c = lane + 64 * i, hh = c / 24, e0 = (c % 24) * 8;
            const float rqh = __int_as_float(__builtin_amdgcn_ds_bpermute(hh * 32, __float_as_int(rq))), rkh = __int_as_float(__builtin_amdgcn_ds_bpermute(hh * 32, __float_as_int(rk)));
            float vq[8], vk[8];
#pragma unroll
            for (int j = 0; j < 8; ++j) {
                const int e = e0 + j;
                if (e0 < 128) { vq[j] = q[hh * 192 + e] * g0[e] * rqh; vk[j] = kv[hh * 256 + e] * akv * g1[e] * rkh; }
                else { const int i2 = (e - 128) & 31; const float co = cs[i2], si = cs[32 + i2];
                    const float q1 = q[hh * 192 + 128 + i2] * g0[128 + i2], q2 = q[hh * 192 + 160 + i2] * g0[160 + i2];
                    const float k1 = kr[i2] * g1[128 + i2], k2 = kr[32 + i2] * g1[160 + i2];
                    if (e0 < 160) { vq[j] = (q1 * co - q2 * si) * rqh; vk[j] = (k1 * co - k2 * si) * rkh; }
                    else { vq[j] = (q2 * co + q1 * si) * rqh; vk[j] = (k2 * co + k1 * si) * rkh; } }
            }
            u32x4 wq, wk;
#pragma unroll
            for (int j = 0; j < 4; ++j) { wq[j] = pk_bf16(vq[2 * j], vq[2 * j + 1]); wk[j] = pk_bf16(vk[2 * j], vk[2 * j + 1]); }
            const size_t o = ((size_t)(b * 8 + hh) * S + s) * 192 + e0;
            *(u32x4*)(QD + o) = wq; *(u32x4*)(KD + o) = wk;
        }
#pragma unroll
        for (int i = 0; i < 2; ++i) { const int c = lane + 64 * i, hh = c >> 4, e0 = (c & 15) * 8;
            u32x4 wv;
#pragma unroll
            for (int j = 0; j < 4; ++j) wv[j] = pk_bf16(bf_lo(vcp[i][j]) * akv, bf_hi(vcp[i][j]) * akv);
            *(u32x4*)(VD + ((size_t)(b * 8 + hh) * S + s) * 128 + e0) = wv; }
        asm volatile("s_waitcnt lgkmcnt(0)" ::: "memory");
    }
}

constexpr int SHM_V = 64 * 128 * 2, SHM_KMAX = 64 * 192 * 2, ATT_WS = 2 * SHM_V + 2 * SHM_KMAX, ATT_RPB = ATT_WS + NWAVES * 64 * 4, ATT_END = ATT_RPB + 15 * 128 * 4;
constexpr float LOG2E = 1.4426950408889634f, ATT_THR = 8.0f;
struct AP {
    const bf16_t* Q; const bf16_t* K; const bf16_t* V;
    bf16_t* O; int opitch; int o8; float* lse;
    int NT;
    int dil, l0, r0, qmask, qshift;
    int lk0, jmask, jshift;
    float nslope;
    int qinfo;
};
__device__ __forceinline__ int crow(int r, int hi) { return (r & 3) + 8 * (r >> 2) + 4 * hi; }
template <int DQK> __device__ __forceinline__ int kswz(int row) { return (DQK == 128 ? (row & 15) : ((row >> 1) & 7)) << 4; }
__device__ __forceinline__ int v_st(int k, int c) { const int kk = (k & ~0xC) | ((k & 4) << 1) | ((k & 8) >> 1); return ((kk >> 3) * 4 + (c >> 5)) * 512 + ((kk & 7) * 32 + (c & 31)) * 2; }
__device__ __forceinline__ int v_rd_base(int lane) { return ((lane & 3) << 3) | (((lane >> 2) & 3) << 6) | (((lane >> 4) & 1) << 5) | (((lane >> 5) & 1) << 8); }
constexpr int v_rd_off(int d0, int ks, int half) { return d0 * 512 + ks * 4096 + half * 2048; }
template <int OFF> __device__ __forceinline__ s16x4 tr_read(int vb) { s16x4 r; asm volatile("ds_read_b64_tr_b16 %0, %1 offset:%2" : "=&v"(r) : "v"(vb), "i"(OFF) : "memory"); return r; }
template <int D0> __device__ __forceinline__ void pv_one(f32x16& od, int vb, bf16x8 pa0, bf16x8 pa1, bf16x8 pa2, bf16x8 pa3) {
    const s16x4 l0 = tr_read<v_rd_off(D0, 0, 0)>(vb), h0 = tr_read<v_rd_off(D0, 0, 1)>(vb), l1 = tr_read<v_rd_off(D0, 1, 0)>(vb), h1 = tr_read<v_rd_off(D0, 1, 1)>(vb);
    const s16x4 l2 = tr_read<v_rd_off(D0, 2, 0)>(vb), h2 = tr_read<v_rd_off(D0, 2, 1)>(vb), l3 = tr_read<v_rd_off(D0, 3, 0)>(vb), h3 = tr_read<v_rd_off(D0, 3, 1)>(vb);
    asm volatile("s_waitcnt lgkmcnt(0)" ::: "memory"); __builtin_amdgcn_sched_barrier(0);
#define MK_PK(L, H) (bf16x8){L[0], L[1], L[2], L[3], H[0], H[1], H[2], H[3]}
    od = __builtin_amdgcn_mfma_f32_32x32x16_bf16(pa0, MK_PK(l0, h0), od, 0, 0, 0);
    od = __builtin_amdgcn_mfma_f32_32x32x16_bf16(pa1, MK_PK(l1, h1), od, 0, 0, 0);
    od = __builtin_amdgcn_mfma_f32_32x32x16_bf16(pa2, MK_PK(l2, h2), od, 0, 0, 0);
    od = __builtin_amdgcn_mfma_f32_32x32x16_bf16(pa3, MK_PK(l3, h3), od, 0, 0, 0);
#undef MK_PK
}

#define MK_TR8(D0, vb, L0, H0, L1, H1, L2, H2, L3, H3) do { L0 = tr_read<v_rd_off(D0, 0, 0)>(vb); H0 = tr_read<v_rd_off(D0, 0, 1)>(vb); L1 = tr_read<v_rd_off(D0, 1, 0)>(vb); H1 = tr_read<v_rd_off(D0, 1, 1)>(vb); \
        L2 = tr_read<v_rd_off(D0, 2, 0)>(vb); H2 = tr_read<v_rd_off(D0, 2, 1)>(vb); L3 = tr_read<v_rd_off(D0, 3, 0)>(vb); H3 = tr_read<v_rd_off(D0, 3, 1)>(vb); } while (0)
#define MK_PKV(L, H) (bf16x8){L[0], L[1], L[2], L[3], H[0], H[1], H[2], H[3]}
#define MK_MM4(od, L0, H0, L1, H1, L2, H2, L3, H3) do { od = __builtin_amdgcn_mfma_f32_32x32x16_bf16(pa0, MK_PKV(L0, H0), od, 0, 0, 0); od = __builtin_amdgcn_mfma_f32_32x32x16_bf16(pa1, MK_PKV(L1, H1), od, 0, 0, 0); \
        od = __builtin_amdgcn_mfma_f32_32x32x16_bf16(pa2, MK_PKV(L2, H2), od, 0, 0, 0); od = __builtin_amdgcn_mfma_f32_32x32x16_bf16(pa3, MK_PKV(L3, H3), od, 0, 0, 0); } while (0)
__device__ __forceinline__ void pv_all(f32x16 (&o)[4], int vb, bf16x8 pa0, bf16x8 pa1, bf16x8 pa2, bf16x8 pa3) {
    s16x4 a0, a1, a2, a3, a4, a5, a6, a7, b0, b1, b2, b3, b4, b5, b6, b7;
    __builtin_amdgcn_sched_barrier(0);
    MK_TR8(0, vb, a0, a1, a2, a3, a4, a5, a6, a7);
    MK_TR8(1, vb, b0, b1, b2, b3, b4, b5, b6, b7);
    asm volatile("s_waitcnt lgkmcnt(8)" : "+v"(a0), "+v"(a1), "+v"(a2), "+v"(a3), "+v"(a4), "+v"(a5), "+v"(a6), "+v"(a7) :: "memory"); __builtin_amdgcn_sched_barrier(0);
    MK_MM4(o[0], a0, a1, a2, a3, a4, a5, a6, a7);
    __builtin_amdgcn_sched_barrier(0);
    MK_TR8(2, vb, a0, a1, a2, a3, a4, a5, a6, a7);
    asm volatile("s_waitcnt lgkmcnt(8)" : "+v"(b0), "+v"(b1), "+v"(b2), "+v"(b3), "+v"(b4), "+v"(b5), "+v"(b6), "+v"(b7) :: "memory"); __builtin_amdgcn_sched_barrier(0);
    MK_MM4(o[1], b0, b1, b2, b3, b4, b5, b6, b7);
    __builtin_amdgcn_sched_barrier(0);
    MK_TR8(3, vb, b0, b1, b2, b3, b4, b5, b6, b7);
    asm volatile("s_waitcnt lgkmcnt(8)" : "+v"(a0), "+v"(a1), "+v"(a2), "+v"(a3), "+v"(a4), "+v"(a5), "+v"(a6), "+v"(a7) :: "memory"); __builtin_amdgcn_sched_barrier(0);
    MK_MM4(o[2], a0, a1, a2, a3, a4, a5, a6, a7);
    asm volatile("s_waitcnt lgkmcnt(0)" : "+v"(b0), "+v"(b1), "+v"(b2), "+v"(b3), "+v"(b4), "+v"(b5), "+v"(b6), "+v"(b7) :: "memory"); __builtin_amdgcn_sched_barrier(0);
    MK_MM4(o[3], b0, b1, b2, b3, b4, b5, b6, b7);
}
#undef MK_TR8
#undef MK_MM4
#undef MK_PKV


constexpr unsigned QN = 448u, QEND = 0xffffu;
constexpr int LDS_QS = LDS_XB + 64;
__device__ __forceinline__ unsigned q_pop(unsigned* ctr, unsigned q) {
    unsigned v = xb_add(&ctr[64 * q], 1u);
    if (v < QN) return (q << 9) | v;
    for (;;) {
        unsigned best = 0xffffffffu, bq = 0u;
#pragma unroll
        for (unsigned j = 0; j < (unsigned)NB; ++j) { const unsigned c = xb_ld(&ctr[64 * j]); if (c < best) { best = c; bq = j; } }
        if (best >= QN) return QEND;
        v = xb_add(&ctr[64 * bq], 1u);
        if (v < QN) return (bq << 9) | v;
    }
}
#define MK_QHOOK() do { if (tid == 0) { const unsigned nx_ = q_pop((unsigned*)(F.a->ws + WS_CTL) + 12288 + 256 * (p.qinfo >> 8), (unsigned)(p.qinfo >> 1) & 3u); \
        *(volatile LAS unsigned*)(lds + LDS_QS + 4 * (p.qinfo & 1)) = nx_; } } while (0)

template <int MODE, int DQK>
__device__ __forceinline__ void attn_unit(const Frame& F, const AP p) {
    constexpr int KS = DQK / 16, PITCH = DQK * 2, SHMK = 64 * PITCH, KCH = DQK / 64;
    int tid_ = F.tid; asm volatile("" : "+v"(tid_));
    const int tid = tid_, wid = __builtin_amdgcn_readfirstlane(tid >> 6), lane = tid & 63, r32 = lane & 31, hi = lane >> 5;
    LAS char* lds = (LAS char*)F.lds;
    LAS char* V_lds = lds; LAS char* K_lds = lds + 2 * SHM_V;
    LAS float* wsl = (LAS float*)(lds + ATT_WS) + wid * 64; LAS float* li_l = wsl; LAS float* al_l = wsl + 32;
    const LAS float* rpb = (const LAS float*)(lds + ATT_RPB);
    float m_reg = -1e30f, l_reg = 0.f; f32x16 o[4];
#pragma unroll
    for (int d = 0; d < 4; ++d) o[d] = f32x16{};
    const int qi = wid * 32 + r32;
    const int tq = p.dil * (p.l0 + (qi & p.qmask)) + p.r0 + (qi >> p.qshift);
    bf16x8 qr[KS];
    { const bf16_t* Qw = p.Q + (size_t)tq * DQK + hi * 8;
#pragma unroll
      for (int d0 = 0; d0 < KS; ++d0) qr[d0] = *(const bf16x8*)(Qw + d0 * 16); }
    const int sr = tid >> 4, sc = (tid & 15) * 8, vst0 = v_st(sr, sc), vst1 = v_st(32 + sr, sc);
    const int vb0 = (int)(uintptr_t)V_lds + v_rd_base(lane);
    int krow[KCH], kcol[KCH];
#pragma unroll
    for (int i = 0; i < KCH; ++i) { const int c = tid + NTHR * i; krow[i] = c / (DQK / 8); kcol[i] = c % (DQK / 8); }
    u32x4 vs0, vs1, ksr[KCH];
#define ATT_TOK(j, row) (p.dil * (p.lk0 + 64 * ((j) & p.jmask) + (row)) + p.r0 + ((j) >> p.jshift))
#define ATT_CLAMP(t) ((t) < 0 ? 0 : ((t) > S - 1 ? S - 1 : (t)))
#define ATT_SLOAD(j) do { { const int t0 = ATT_CLAMP(ATT_TOK(j, sr)), t1 = ATT_CLAMP(ATT_TOK(j, 32 + sr)); \
        vs0 = *(const u32x4*)(p.V + (size_t)t0 * 128 + sc); vs1 = *(const u32x4*)(p.V + (size_t)t1 * 128 + sc); } \
        _Pragma("unroll") for (int _i = 0; _i < KCH; ++_i) { const int tk_ = ATT_CLAMP(ATT_TOK(j, krow[_i])); ksr[_i] = *(const u32x4*)(p.K + (size_t)tk_ * DQK + kcol[_i] * 8); } } while (0)
#define ATT_SWRITE(b) do { *(LAS u32x4*)(V_lds + (b) * SHM_V + vst0) = vs0; *(LAS u32x4*)(V_lds + (b) * SHM_V + vst1) = vs1; \
        _Pragma("unroll") for (int _i = 0; _i < KCH; ++_i) *(LAS u32x4*)(K_lds + (b) * SHMK + krow[_i] * PITCH + ((kcol[_i] * 16) ^ kswz<DQK>(krow[_i]))) = ksr[_i]; } while (0)
    ATT_SLOAD(0); MK_QHOOK(); ATT_SWRITE(0); __syncthreads();
    int na_rq = 0, na_cq = 0, na_rs = 0, na_cs = 0;
    if (MODE == 3) { na_rq = tq >> 6; na_cq = tq & 63; na_rs = na_rq - 4; na_rs = na_rs < 0 ? 0 : (na_rs > 24 ? 24 : na_rs); na_cs = na_cq - 8; na_cs = na_cs < 0 ? 0 : (na_cs > 48 ? 48 : na_cs); }
    for (int j = 0; j < p.NT; ++j) {
        const int cur = j & 1;
        if (j + 1 < p.NT) ATT_SLOAD(j + 1);
        const int kt0 = ATT_TOK(j, 0);
        bool skip = false;
        if (MODE == 2) { const int tq_lo = __builtin_amdgcn_readfirstlane(tq), tq_hi = tq_lo + 31 * p.dil, lim = 64 * p.dil;
            skip = (kt0 > tq_hi + lim) || (kt0 + 63 * p.dil < tq_lo - lim) || (((kt0 - tq_lo) & (p.dil - 1)) != 0); }
        if (MODE == 3) { const int rs_u = __builtin_amdgcn_readfirstlane(na_rs), rk = kt0 >> 6; skip = (rk < rs_u) || (rk >= rs_u + 8); }
        if (!skip) {
        f32x16 p0 = f32x16{}, p1 = f32x16{};
        { const LAS char* Ks = K_lds + cur * SHMK + r32 * PITCH; const int sw = kswz<DQK>(r32);
          bf16x8 c0 = *(const LAS bf16x8*)(Ks + ((hi * 16) ^ sw)), c1 = *(const LAS bf16x8*)(Ks + 32 * PITCH + ((hi * 16) ^ sw));
#pragma unroll
          for (int d0 = 0; d0 < KS; ++d0) { bf16x8 n0 = c0, n1 = c1;
            if (d0 + 1 < KS) { const int cb = (((d0 + 1) * 16 + hi * 8) * 2) ^ sw; n0 = *(const LAS bf16x8*)(Ks + cb); n1 = *(const LAS bf16x8*)(Ks + 32 * PITCH + cb); }
            __builtin_amdgcn_sched_barrier(0);
            p0 = __builtin_amdgcn_mfma_f32_32x32x16_bf16(c0, qr[d0], p0, 0, 0, 0);
            p1 = __builtin_amdgcn_mfma_f32_32x32x16_bf16(c1, qr[d0], p1, 0, 0, 0);
            __builtin_amdgcn_sched_barrier(0);
            c0 = n0; c1 = n1; } }
        if (MODE == 1) {
            const float base = (float)(kt0 + 4 * hi - tq);
#pragma unroll
            for (int r = 0; r < 16; ++r) { const float c = (float)((r & 3) + 8 * (r >> 2)); p0[r] = fmaf(fabsf(base + c), p.nslope, p0[r]); p1[r] = fmaf(fabsf(base + c + 32.0f), p.nslope, p1[r]); }
        }
        if (MODE == 2) {
            const int lim = 64 * p.dil, dm = p.dil - 1;
#pragma unroll
            for (int r = 0; r < 16; ++r) {
#pragma unroll
                for (int hf = 0; hf < 2; ++hf) { const int ki = crow(r, hi) + 32 * hf, tk = kt0 + ki * p.dil, d = tk - tq, ad = d < 0 ? -d : d;
                    const bool ok = ((unsigned)tk < (unsigned)S) && (ad <= lim) && ((d & dm) == 0);
                    if (hf) p1[r] = ok ? fmaf((float)ad, p.nslope, p1[r]) : -INFINITY; else p0[r] = ok ? fmaf((float)ad, p.nslope, p0[r]) : -INFINITY; } }
        }
        if (MODE == 3) {
            asm volatile("" : "+v"(na_cq), "+v"(na_cs));
            const int rk = kt0 >> 6; const bool rowok = (rk >= na_rs) && (rk < na_rs + 8); int ri = rk - na_rq + 7; ri = ri < 0 ? 0 : (ri > 14 ? 14 : ri);
            const LAS float* rb = rpb + ri * 128 + (63 - na_cq) + 4 * hi;
            const int cw = 4 * hi - na_cs;
#pragma unroll
            for (int r = 0; r < 16; ++r) {
#pragma unroll
                for (int hf = 0; hf < 2; ++hf) { const int c0 = (r & 3) + 8 * (r >> 2) + 32 * hf;
                    const bool ok = rowok && ((unsigned)(cw + c0) < 16u);
                    const float bv = rb[c0];
                    if (hf) p1[r] = ok ? p1[r] + bv : -INFINITY; else p0[r] = ok ? p0[r] + bv : -INFINITY; } }
        }
        float pmax = p0[0];
#pragma unroll
        for (int r = 1; r < 16; ++r) pmax = fmaxf(pmax, p0[r]);
#pragma unroll
        for (int r = 0; r < 16; ++r) pmax = fmaxf(pmax, p1[r]);
        { auto rr = __builtin_amdgcn_permlane32_swap(__float_as_uint(pmax), __float_as_uint(pmax), false, false); pmax = fmaxf(__uint_as_float(rr[0]), __uint_as_float(rr[1])); }
        float mn, alpha;
        if (__all(pmax - m_reg <= ATT_THR)) { mn = m_reg; alpha = 1.f; }
        else { mn = fmaxf(m_reg, pmax); alpha = __builtin_amdgcn_exp2f((m_reg - mn) * LOG2E); m_reg = mn; }
        const float mnC = -mn * LOG2E;
#pragma unroll
        for (int r = 0; r < 16; ++r) { p0[r] = __builtin_amdgcn_exp2f(fmaf(p0[r], LOG2E, mnC)); p1[r] = __builtin_amdgcn_exp2f(fmaf(p1[r], LOG2E, mnC)); }
        float ps = 0.f;
#pragma unroll
        for (int r = 0; r < 16; ++r) ps += p0[r];
#pragma unroll
        for (int r = 0; r < 16; ++r) ps += p1[r];
        { auto rr = __builtin_amdgcn_permlane32_swap(__float_as_uint(ps), __float_as_uint(ps), false, false); ps = __uint_as_float(rr[0]) + __uint_as_float(rr[1]); }
        l_reg = l_reg * alpha + ps;
        bf16x8 pa0, pa1, pa2, pa3;
#define ATT_PK4(P, BASE, OUT) do { unsigned a0 = pk_bf16(P[BASE + 0], P[BASE + 1]), a1 = pk_bf16(P[BASE + 2], P[BASE + 3]); \
        unsigned b0_ = pk_bf16(P[BASE + 4], P[BASE + 5]), b1_ = pk_bf16(P[BASE + 6], P[BASE + 7]); \
        auto r0_ = __builtin_amdgcn_permlane32_swap(a0, b0_, false, false); auto r1_ = __builtin_amdgcn_permlane32_swap(a1, b1_, false, false); \
        u32x4 w_ = {r0_[0], r1_[0], r0_[1], r1_[1]}; OUT = *reinterpret_cast<bf16x8*>(&w_); } while (0)
        ATT_PK4(p0, 0, pa0); ATT_PK4(p0, 8, pa1); ATT_PK4(p1, 0, pa2); ATT_PK4(p1, 8, pa3);
#undef ATT_PK4
        if (__any(alpha < 1.f)) { if (hi == 0) al_l[r32] = alpha; asm volatile("s_waitcnt lgkmcnt(0)" ::: "memory");
#pragma unroll
            for (int d = 0; d < 4; ++d)
#pragma unroll
                for (int r = 0; r < 16; ++r) o[d][r] *= al_l[crow(r, hi)]; }
        { const int vb = vb0 + cur * SHM_V;
          pv_all(o, vb, pa0, pa1, pa2, pa3); }
        }
        if (j + 1 < p.NT) ATT_SWRITE(cur ^ 1);
        __syncthreads();
    }
    if (hi == 0) li_l[r32] = l_reg;
    asm volatile("s_waitcnt lgkmcnt(0)" ::: "memory");
    if (p.lse != nullptr && hi == 0) p.lse[(size_t)tq * 8] = m_reg + __logf(l_reg);
#pragma unroll
    for (int r = 0; r < 16; ++r) { const int orow = crow(r, hi), qo = wid * 32 + orow; const int to = p.dil * (p.l0 + (qo & p.qmask)) + p.r0 + (qo >> p.qshift);
        const float lv = li_l[orow], rl = lv > 0.f ? 1.0f / lv : 0.f;
        bf16_t* orow_p = p.O + (size_t)to * p.opitch + r32;
#pragma unroll
        for (int d0 = 0; d0 < 4; ++d0) { const float ov = o[d0][r] * rl; if (p.o8) ((unsigned char*)p.O)[(size_t)to * p.opitch + r32 + d0 * 32] = (unsigned char)(pk_fp8x4(ov * O8_SCALE, 0.f, 0.f, 0.f) & 0xffu); else orow_p[d0 * 32] = (bf16_t)(pk_bf16(ov, 0.f) & 0xffffu); } }
    asm volatile("s_waitcnt lgkmcnt(0)" ::: "memory");
#undef ATT_TOK
#undef ATT_CLAMP
#undef ATT_SLOAD
#undef ATT_SWRITE
}


template <int MODE, int DQK>
__device__ __forceinline__ void attn_unit_p(const Frame& F, const AP p) {
    constexpr int KS = DQK / 16, PITCH = DQK * 2, SHMK = 64 * PITCH, KCH = DQK / 64;
    int tid_ = F.tid; asm volatile("" : "+v"(tid_));
    const int tid = tid_, wid = __builtin_amdgcn_readfirstlane(tid >> 6), lane = tid & 63, r32 = lane & 31, hi = lane >> 5;
    LAS char* lds = (LAS char*)F.lds;
    LAS char* V_lds = lds; LAS char* K_lds = lds + 2 * SHM_V;
    LAS float* wsl = (LAS float*)(lds + ATT_WS) + wid * 64; LAS float* li_l = wsl; LAS float* al_l = wsl + 32;
    float m_reg = -1e30f, l_reg = 0.f; f32x16 o[4];
#pragma unroll
    for (int d = 0; d < 4; ++d) o[d] = f32x16{};
    const int tq = p.l0 + wid * 32 + r32;
    bf16x8 qr[KS];
    { const bf16_t* Qw = p.Q + (size_t)tq * DQK + hi * 8;
#pragma unroll
      for (int d0 = 0; d0 < KS; ++d0) qr[d0] = *(const bf16x8*)(Qw + d0 * 16); }
    const int sr = tid >> 4, sc = (tid & 15) * 8, vst0 = v_st(sr, sc), vst1 = v_st(32 + sr, sc);
    const int vb0 = (int)(uintptr_t)V_lds + v_rd_base(lane);
    int krow[KCH], kcol[KCH];
#pragma unroll
    for (int i = 0; i < KCH; ++i) { const int c = tid + NTHR * i; krow[i] = c / (DQK / 8); kcol[i] = c % (DQK / 8); }
    u32x4 vsE0, vsE1, ksE[KCH], vsO0, vsO1, ksO[KCH];
#define AP_SLOAD(S, j) do { const int t0_ = p.lk0 + 64 * (j); vs##S##0 = *(const u32x4*)(p.V + (size_t)(t0_ + sr) * 128 + sc); vs##S##1 = *(const u32x4*)(p.V + (size_t)(t0_ + 32 + sr) * 128 + sc); \
        _Pragma("unroll") for (int _i = 0; _i < KCH; ++_i) ks##S[_i] = *(const u32x4*)(p.K + (size_t)(t0_ + krow[_i]) * DQK + kcol[_i] * 8); } while (0)
#define AP_SWRITE(b, S) do { *(LAS u32x4*)(V_lds + (b) * SHM_V + vst0) = vs##S##0; *(LAS u32x4*)(V_lds + (b) * SHM_V + vst1) = vs##S##1; \
        _Pragma("unroll") for (int _i = 0; _i < KCH; ++_i) *(LAS u32x4*)(K_lds + (b) * SHMK + krow[_i] * PITCH + ((kcol[_i] * 16) ^ kswz<DQK>(krow[_i]))) = ks##S[_i]; } while (0)
#define AP_QKT(P0, P1, b) do { P0 = f32x16{}; P1 = f32x16{}; const LAS char* Ks_ = K_lds + (b) * SHMK + r32 * PITCH; const int sw_ = kswz<DQK>(r32); \
        bf16x8 c0_ = *(const LAS bf16x8*)(Ks_ + ((hi * 16) ^ sw_)), c1_ = *(const LAS bf16x8*)(Ks_ + 32 * PITCH + ((hi * 16) ^ sw_)); \
        _Pragma("unroll") for (int d0 = 0; d0 < KS; ++d0) { bf16x8 n0_ = c0_, n1_ = c1_; \
            if (d0 + 1 < KS) { const int cb_ = (((d0 + 1) * 16 + hi * 8) * 2) ^ sw_; n0_ = *(const LAS bf16x8*)(Ks_ + cb_); n1_ = *(const LAS bf16x8*)(Ks_ + 32 * PITCH + cb_); } \
            P0 = __builtin_amdgcn_mfma_f32_32x32x16_bf16(c0_, qr[d0], P0, 0, 0, 0); P1 = __builtin_amdgcn_mfma_f32_32x32x16_bf16(c1_, qr[d0], P1, 0, 0, 0); c0_ = n0_; c1_ = n1_; } } while (0)
#define AP_PARTIAL(P0, P1, j, MN, AL) do { \
        if (MODE == 1) { const float base_ = (float)(p.lk0 + 64 * (j) + 4 * hi - tq); \
            _Pragma("unroll") for (int r = 0; r < 16; ++r) { const float c_ = (float)((r & 3) + 8 * (r >> 2)); P0[r] = fmaf(fabsf(base_ + c_), p.nslope, P0[r]); P1[r] = fmaf(fabsf(base_ + c_ + 32.0f), p.nslope, P1[r]); } } \
        float pmax_ = P0[0]; \
        _Pragma("unroll") for (int r = 1; r < 16; ++r) pmax_ = fmaxf(pmax_, P0[r]); \
        _Pragma("unroll") for (int r = 0; r < 16; ++r) pmax_ = fmaxf(pmax_, P1[r]); \
        { auto rr_ = __builtin_amdgcn_permlane32_swap(__float_as_uint(pmax_), __float_as_uint(pmax_), false, false); pmax_ = fmaxf(__uint_as_float(rr_[0]), __uint_as_float(rr_[1])); } \
        if (__builtin_expect(__all(pmax_ - m_reg <= ATT_THR), 1)) { MN = m_reg; AL = 1.f; } \
        else { MN = fmaxf(m_reg, pmax_); AL = __builtin_amdgcn_exp2f((m_reg - MN) * LOG2E); m_reg = MN; } \
        { const float mnC_ = -MN * LOG2E; \
          _Pragma("unroll") for (int r = 0; r < 16; ++r) { P0[r] = fmaf(P0[r], LOG2E, mnC_); P1[r] = fmaf(P1[r], LOG2E, mnC_); } \
          _Pragma("unroll") for (int r = 0; r < 16; ++r) P0[r] = __builtin_amdgcn_exp2f(P0[r]); } } while (0)
#define AP_PK4(P, BASE, OUT) do { unsigned a0 = pk_bf16(P[BASE + 0], P[BASE + 1]), a1 = pk_bf16(P[BASE + 2], P[BASE + 3]); \
        unsigned b0_ = pk_bf16(P[BASE + 4], P[BASE + 5]), b1_ = pk_bf16(P[BASE + 6], P[BASE + 7]); \
        auto r0_ = __builtin_amdgcn_permlane32_swap(a0, b0_, false, false); auto r1_ = __builtin_amdgcn_permlane32_swap(a1, b1_, false, false); \
        u32x4 w_ = {r0_[0], r1_[0], r0_[1], r1_[1]}; OUT = *reinterpret_cast<bf16x8*>(&w_); } while (0)
#define AP_FINISH(P0, P1, AL) do { \
        _Pragma("unroll") for (int r = 0; r < 16; ++r) P1[r] = __builtin_amdgcn_exp2f(P1[r]); \
        float ps_ = 0.f; \
        _Pragma("unroll") for (int r = 0; r < 16; ++r) ps_ += P0[r]; \
        _Pragma("unroll") for (int r = 0; r < 16; ++r) ps_ += P1[r]; \
        { auto rr_ = __builtin_amdgcn_permlane32_swap(__float_as_uint(ps_), __float_as_uint(ps_), false, false); ps_ = __uint_as_float(rr_[0]) + __uint_as_float(rr_[1]); } \
        l_reg = l_reg * (AL) + ps_; \
        AP_PK4(P0, 0, pa0); AP_PK4(P0, 8, pa1); AP_PK4(P1, 0, pa2); AP_PK4(P1, 8, pa3); } while (0)
#define AP_PV(b) do { const int vb_ = vb0 + (b) * SHM_V; pv_all(o, vb_, pa0, pa1, pa2, pa3); } while (0)
#define AP_RESC(a) do { if (__any((a) < 1.f)) { if (hi == 0) al_l[r32] = (a); asm volatile("s_waitcnt lgkmcnt(0)" ::: "memory"); \
        _Pragma("unroll") for (int d = 0; d < 4; ++d) _Pragma("unroll") for (int r = 0; r < 16; ++r) o[d][r] *= al_l[crow(r, hi)]; } } while (0)
#define AP_SB() __builtin_amdgcn_sched_barrier(0)
    f32x16 pA0, pA1, pB0, pB1; float mnA, mnB, alA, alB; bf16x8 pa0, pa1, pa2, pa3; const int NT = p.NT;
    AP_SLOAD(E, 0); MK_QHOOK(); AP_SWRITE(0, E); __syncthreads();
    AP_QKT(pA0, pA1, 0); AP_PARTIAL(pA0, pA1, 0, mnA, alA);
    AP_SLOAD(O, 1); if (2 < NT) AP_SLOAD(E, 2);
    AP_SWRITE(1, O); __syncthreads();
    for (int j = 1; j + 1 < NT; j += 2) {
        AP_SB(); AP_QKT(pB0, pB1, 1); AP_FINISH(pA0, pA1, alA); AP_SB();
        AP_SLOAD(O, j + 2); AP_SB();
        AP_PV(0); AP_PARTIAL(pB0, pB1, j, mnB, alB);
        __syncthreads(); AP_SWRITE(0, E);
        AP_RESC(alB); __syncthreads();
        AP_SB(); AP_QKT(pA0, pA1, 0); AP_FINISH(pB0, pB1, alB); AP_SB();
        if (j + 3 < NT) AP_SLOAD(E, j + 3); AP_SB();
        AP_PV(1); AP_PARTIAL(pA0, pA1, j + 1, mnA, alA);
        __syncthreads(); AP_SWRITE(1, O);
        AP_RESC(alA); __syncthreads();
    }
    AP_SB(); AP_QKT(pB0, pB1, 1); AP_FINISH(pA0, pA1, alA); AP_SB();
    AP_PV(0); AP_PARTIAL(pB0, pB1, NT - 1, mnB, alB);
    __syncthreads(); AP_RESC(alB);
    AP_FINISH(pB0, pB1, alB); AP_SB();
    AP_PV(1);
    (void)mnA; (void)mnB;
    if (hi == 0) li_l[r32] = l_reg;
    asm volatile("s_waitcnt lgkmcnt(0)" ::: "memory");
#pragma unroll
    for (int r = 0; r < 16; ++r) { const int orow = crow(r, hi), to = p.l0 + wid * 32 + orow;
        const float lv = li_l[orow], rl = lv > 0.f ? 1.0f / lv : 0.f;
        bf16_t* orow_p = p.O + (size_t)to * p.opitch + r32;
#pragma unroll
        for (int d0 = 0; d0 < 4; ++d0) { const float ov = o[d0][r] * rl; if (p.o8) ((unsigned char*)p.O)[(size_t)to * p.opitch + r32 + d0 * 32] = (unsigned char)(pk_fp8x4(ov * O8_SCALE, 0.f, 0.f, 0.f) & 0xffu); else orow_p[d0 * 32] = (bf16_t)(pk_bf16(ov, 0.f) & 0xffffu); } }
    asm volatile("s_waitcnt lgkmcnt(0)" ::: "memory");
    __syncthreads();
#undef AP_SLOAD
#undef AP_SWRITE
#undef AP_QKT
#undef AP_PARTIAL
#undef AP_PK4
#undef AP_FINISH
#undef AP_PV
#undef AP_RESC
#undef AP_SB
}

__device__ __forceinline__ void p_attention(const Frame& F, int l, int gs) {
    unsigned char* qkv = F.ws + WS_QKV;
    constexpr int N_MLA = 512, N_DIFF = 1024, N_NA = 512, N_D1 = 512, N_D4 = 512, N_D16 = 512, N_ALL = N_MLA + N_DIFF + N_NA + N_D1 + N_D4 + N_D16;
    static_assert(N_ALL == 8 * (int)QN, "queue size");
    const int ls = 2 * l + gs;
    unsigned* qctr = (unsigned*)(F.a->ws + WS_CTL) + 12288 + 256 * ls;
    volatile LAS unsigned* qs = (volatile LAS unsigned*)(F.lds + LDS_QS);
    { int t_ = F.tid; asm volatile("" : "+v"(t_)); if (t_ == 0) qs[0] = q_pop(qctr, xb_xcc_id() & 3u); }
    __syncthreads();
    for (int par = 0; ; par ^= 1) {
        const int u = __builtin_amdgcn_readfirstlane((int)qs[par]);
        if (u == (int)QEND) break;
        const int xl = u >> 9, qi_ = u & 511, sub = qi_ & 7; int v = qi_ >> 3, cat = 0;
        if (v >= 8) { v -= 8; cat = 1; if (v >= 16) { v -= 16; cat = 2; if (v >= 8) { v -= 8; cat = 3; if (v >= 8) { v -= 8; cat = 4; if (v >= 8) { v -= 8; cat = 5; } } } } }
        AP p; p.qinfo = (ls << 8) | (xl << 1) | (par ^ 1); p.lse = nullptr; p.opitch = 1024; p.o8 = 0; p.dil = 1; p.r0 = 0; p.qmask = 255; p.qshift = 8; p.jmask = 63; p.jshift = 6; p.nslope = 0.f; p.lk0 = 0; p.NT = 32;
        if (cat == 1) {
            const int b = xl, hp = 15 - v, h = hp >> 1, c = hp & 1;
            p.Q = (const bf16_t*)(qkv + QO_QA) + (size_t)(b * 16 + hp) * S * 64; p.K = (const bf16_t*)(qkv + QO_KA) + (size_t)(b * 16 + hp) * S * 64; p.V = (const bf16_t*)(qkv + QO_VA) + (size_t)(b * 8 + h) * S * 128;
            p.O = (bf16_t*)(F.ws + WS_P + PO_OA + (size_t)c * SZ_H1) + (size_t)b * S * 1024 + h * 128; p.l0 = sub * 256; p.nslope = -exp2f(-(float)(h + 1));
            {
                const int dmax = 1 << (h + 7), q0 = sub * 256; int jlo = (q0 - dmax + 1) >> 6; jlo = jlo < 0 ? 0 : jlo; int jhi = (q0 + 255 + dmax - 1) >> 6; jhi = jhi > 31 ? 31 : jhi;
                if (((jhi - jlo + 1) & 1) != 0) { if (jlo > 0) --jlo; else ++jhi; }
                p.lk0 = 64 * jlo; p.NT = jhi - jlo + 1; }
#if !defined(MK_ATT_ONLY) || MK_ATT_ONLY == 1
            attn_unit_p<1, 64>(F, p);
#endif
        } else {
            const int b = xl, h = v; const size_t ho = (size_t)(b * 8 + h) * S;
            if (cat == 0) {
                p.Q = (const bf16_t*)(qkv + QO_QD) + ho * 192; p.K = (const bf16_t*)(qkv + QO_KD) + ho * 192; p.V = (const bf16_t*)(qkv + QO_VD) + ho * 128;
                p.O = (bf16_t*)(F.ws + WS_O + (size_t)b * S * DM + 3072 + h * 128); p.opitch = DM; p.o8 = 1; p.l0 = sub * 256;
#if !defined(MK_ATT_ONLY) || MK_ATT_ONLY == 0
                attn_unit<0, 192>(F, p);
#endif
            } else if (cat == 2) {
                p.Q = (const bf16_t*)(qkv + QO_QC) + ho * 128; p.K = (const bf16_t*)(qkv + QO_KC) + ho * 128; p.V = (const bf16_t*)(qkv + QO_VC) + ho * 128;
                p.O = (bf16_t*)(F.ws + WS_O + (size_t)b * S * DM + 2048 + h * 128); p.opitch = DM; p.o8 = 1; p.l0 = sub * 256;
                const int R0 = sub * 4; int first = R0 - 4; first = first < 0 ? 0 : (first > 24 ? 24 : first); int lastb = R0 - 1; lastb = lastb < 0 ? 0 : (lastb > 24 ? 24 : lastb);
                p.lk0 = first * 64; p.NT = lastb + 7 - first + 1;
                { LAS float* rp = (LAS float*)(F.lds + ATT_RPB); const float* src = F.a->in[I_RPB] + (size_t)(l * 8 + h) * 465; int ti = F.tid; asm volatile("" : "+v"(ti)); if (ti < 465) rp[(ti / 31) * 128 + 48 + (ti % 31)] = src[ti]; }
#if !defined(MK_ATT_ONLY) || MK_ATT_ONLY == 3
                attn_unit<3, 128>(F, p);
#endif
            } else {
                const int br = cat - 3;
                p.Q = (const bf16_t*)(qkv + QO_QB) + ho * 128; p.K = (const bf16_t*)(qkv + QO_KB) + ho * 128; p.V = (const bf16_t*)(qkv + QO_VB) + ho * 128;
                p.O = (bf16_t*)(F.ws + WS_P + PO_OB + (size_t)br * SZ_H1) + (size_t)b * S * 1024 + h * 128;
                p.lse = (float*)(F.ws + WS_P + PO_LSE) + (size_t)br * T * 8 + (size_t)b * S * 8 + h; p.nslope = -exp2f(-(float)(h + 1));
                if (br == 0) { p.dil = 1; p.l0 = sub * 256; p.lk0 = p.l0 - 64; p.NT = 6; }
                else if (br == 1) { p.dil = 4; p.r0 = sub >> 1; p.l0 = (sub & 1) * 256; p.lk0 = p.l0 - 64; p.NT = 6; }
                else { p.dil = 16; p.r0 = sub * 2; p.l0 = 0; p.qmask = 127; p.qshift = 7; p.lk0 = 0; p.jmask = 1; p.jshift = 1; p.NT = 4; }
#if !defined(MK_ATT_ONLY) || MK_ATT_ONLY == 2
                attn_unit<2, 128>(F, p);
#endif
            }
        }
    }
}

__device__ __forceinline__ void p_post3(const Frame& F, int l) {
    const bf16_t* OA0 = (const bf16_t*)(F.ws + WS_P + PO_OA); const bf16_t* OA1 = OA0 + (size_t)T * 1024; const bf16_t* OB = (const bf16_t*)(F.ws + WS_P + PO_OB);
    const float* LSE = (const float*)(F.ws + WS_P + PO_LSE);
    unsigned char* O = F.ws + WS_O;
    const int lane = F.lane;
    const float* lv = F.a->in[I_DLAM] + l * 4 * 64;
    const float s01 = wsum(lv[lane] * lv[64 + lane]), s23 = wsum(lv[128 + lane] * lv[192 + lane]);
    const float lam_init = 0.8f - 0.6f * expf(-0.3f * (float)l), lam = expf(s01) - expf(s23) + lam_init;
    const float* gout = F.a->in[I_DGOUT] + l * 128 + (lane & 7) * 16;
    for (int t = F.rank * NWAVES + F.wid; t < T; t += F.nwg * NWAVES) {
        const size_t ro = (size_t)t * 1024 + lane * 16; unsigned char* orow = O + (size_t)t * DM + lane * 16;
        const int h = lane >> 3;
        u32x4 ra[2], rb[2], r0[2], r1[2], r2[2];
#pragma unroll
        for (int i = 0; i < 2; ++i) { ra[i] = *(const u32x4*)(OA0 + ro + 8 * i); rb[i] = *(const u32x4*)(OA1 + ro + 8 * i); r0[i] = *(const u32x4*)(OB + ro + 8 * i);
            r1[i] = *(const u32x4*)(OB + (size_t)T * 1024 + ro + 8 * i); r2[i] = *(const u32x4*)(OB + (size_t)2 * T * 1024 + ro + 8 * i); }
        float e0 = LSE[(size_t)t * 8 + h], e1 = LSE[(size_t)T * 8 + (size_t)t * 8 + h], e2 = LSE[(size_t)2 * T * 8 + (size_t)t * 8 + h];
        asm volatile("" : "+v"(e0), "+v"(e1), "+v"(e2) :: "memory");
        {
            float xa[16], xb[16], d[16]; unpack16(ra[0], ra[1], xa); unpack16(rb[0], rb[1], xb); float ss = 0.f;
#pragma unroll
            for (int j = 0; j < 16; ++j) { d[j] = xa[j] - lam * xb[j]; ss += d[j] * d[j]; }
            ss = sum8(ss);
            const float r = rsqrtf(ss * (1.0f / 128) + EPS) * (1.0f - lam_init);
            u32x4 w0; const float r8 = r * O8_SCALE;
#pragma unroll
            for (int i = 0; i < 4; ++i) w0[i] = pk_fp8x4(d[4 * i] * r8 * gout[4 * i], d[4 * i + 1] * r8 * gout[4 * i + 1], d[4 * i + 2] * r8 * gout[4 * i + 2], d[4 * i + 3] * r8 * gout[4 * i + 3]);
            *(u32x4*)orow = w0;
        }
        {
            const float m = fmaxf(e0, fmaxf(e1, e2)); float w0 = __expf(e0 - m), w1 = __expf(e1 - m), w2 = __expf(e2 - m); const float inv = 1.0f / (w0 + w1 + w2); w0 *= inv; w1 *= inv; w2 *= inv;
            float x0[16], x1[16], x2[16], d[16]; unpack16(r0[0], r0[1], x0); unpack16(r1[0], r1[1], x1); unpack16(r2[0], r2[1], x2);
#pragma unroll
            for (int j = 0; j < 16; ++j) d[j] = w0 * x0[j] + w1 * x1[j] + w2 * x2[j];
            u32x4 y0;
#pragma unroll
            for (int i = 0; i < 4; ++i) y0[i] = pk_fp8x4(d[4 * i] * O8_SCALE, d[4 * i + 1] * O8_SCALE, d[4 * i + 2] * O8_SCALE, d[4 * i + 3] * O8_SCALE);
            *(u32x4*)(orow + 1024) = y0;
        }
    }
}

__device__ __forceinline__ int med3i(int a, int b, int c) { return max(min(a, b), min(max(a, b), c)); }
__device__ __forceinline__ int ordkey(float v) { const int x = __float_as_int(v); return x ^ ((x >> 31) & 0x7fffffff); }
#define MK_INSERT(L, key) do { _Pragma("unroll") for (int _k = 15; _k >= 1; --_k) L[_k] = med3i((key), L[_k - 1], L[_k]); L[0] = max((key), L[0]); } while (0)
__device__ __forceinline__ void p_select(const Frame& F, int l) {
    const float* SC = (const float*)(F.ws + WS_P + PO_SC); int* EX = (int*)(F.ws + WS_P + PO_EXP); float* GT = (float*)(F.ws + WS_P + PO_GATE);
    LAS float* L = (LAS float*)F.lds;
    const int tid = F.tid;
    for (int blk = F.rank * NWAVES + F.wid; blk < T * 8 / 64; blk += F.nwg * NWAVES) {
        const int pid = blk * 64 + F.lane, t = pid >> 3, h = pid & 7;
        const float* sc = SC + (size_t)t * 2048 + h * 256;
        float fa[16], fb[16];
#pragma unroll
        for (int c = 0; c < 2; ++c) {
            int Lk[16];
#pragma unroll
            for (int k = 0; k < 16; ++k) Lk[k] = (int)0x80000000;
            for (int n32 = 0; n32 < 4; ++n32) { f32x4 v[8];
#pragma unroll
                for (int q = 0; q < 8; ++q) v[q] = *(const f32x4*)(sc + c * 128 + n32 * 32 + q * 4);
#pragma unroll
                for (int q = 0; q < 8; ++q)
#pragma unroll
                    for (int e = 0; e < 4; ++e) { const int key = (ordkey(v[q][e]) & ~127) | (n32 * 32 + q * 4 + e); MK_INSERT(Lk, key); } }
#pragma unroll
            for (int k = 0; k < 16; ++k) { const int idx = Lk[k] & 127; const float val = sc[c * 128 + idx];
                if (c == 0) fa[k] = val; else fb[k] = val;
                L[(c * 32 + k) * NTHR + tid] = val; L[(c * 32 + 16 + k) * NTHR + tid] = __int_as_float(idx); }
        }
        int Mk[16];
#pragma unroll
        for (int k = 0; k < 16; ++k) Mk[k] = (int)0x80000000;
#pragma unroll
        for (int i = 0; i < 16; ++i)
#pragma unroll
            for (int j = 0; j < 16; ++j) if ((i + 1) * (j + 1) <= 16) { const int key = (ordkey(fa[i] + fb[j]) & ~255) | (i * 16 + j); MK_INSERT(Mk, key); }
        asm volatile("s_waitcnt lgkmcnt(0)" ::: "memory");
        float sk[16]; int ek[16]; float mx = -INFINITY;
#pragma unroll
        for (int k = 0; k < 16; ++k) { const int code = Mk[k] & 255, i = code >> 4, j = code & 15;
            sk[k] = L[i * NTHR + tid] + L[(32 + j) * NTHR + tid];
            ek[k] = __float_as_int(L[(16 + i) * NTHR + tid]) * 128 + __float_as_int(L[(48 + j) * NTHR + tid]); mx = fmaxf(mx, sk[k]); }
        const float inv = 1.0f; (void)mx;
#pragma unroll
        for (int k = 0; k < 4; ++k) { *(int4*)(EX + (size_t)t * 128 + h * 16 + 4 * k) = make_int4(ek[4 * k], ek[4 * k + 1], ek[4 * k + 2], ek[4 * k + 3]);
            *(f32x4*)(GT + (size_t)t * 128 + h * 16 + 4 * k) = (f32x4){sk[4 * k] * inv, sk[4 * k + 1] * inv, sk[4 * k + 2] * inv, sk[4 * k + 3] * inv}; }
        asm volatile("s_waitcnt lgkmcnt(0)" ::: "memory");
    }
}

typedef float f32x2 __attribute__((ext_vector_type(2)));
typedef _Float16 h16x2 __attribute__((ext_vector_type(2)));
__device__ __forceinline__ void p_gather(const Frame& F, int l, int gs) {
    const bf16_t* HN = (const bf16_t*)(F.ws + WS_HN); const int* EX = (const int*)(F.ws + WS_P + PO_EXP); const float* GT = (const float*)(F.ws + WS_P + PO_GATE);
    const unsigned char* U = F.a->ws + WS_W + (size_t)l * LW_END + LW_U; const unsigned char* V = F.a->ws + WS_W + (size_t)l * LW_END + LW_V;
#define MK_LANE() ({ unsigned z_ = 0u; asm volatile("" : "+v"(z_)); (int)__builtin_amdgcn_mbcnt_hi(~0u, __builtin_amdgcn_mbcnt_lo(~0u, z_)); })
    unsigned* tctr = (unsigned*)(F.a->ws + WS_CTL) + 14336 + 64 * (2 * l + gs);
#define MK_TPOP(ln) ({ unsigned v_ = 0u; if ((ln) == 0) v_ = xb_add(tctr, 1u); v_; })
    int tnext = __builtin_amdgcn_readfirstlane((int)MK_TPOP(MK_LANE()));
    for (int t = tnext; t < T; t = tnext) {
        int lane = MK_LANE();
        const unsigned tv = MK_TPOP(lane);
        h16x2 hh[32];
        float ssq = 0.f;
#pragma unroll
        for (int c = 0; c < 16; ++c) { const u32x2 a = *(const u32x2*)(HN + (size_t)t * DM + c * 256 + 4 * lane); const float a0 = bf_lo(a.x), a1 = bf_hi(a.x), a2 = bf_lo(a.y), a3 = bf_hi(a.y);
            ssq += (a0 * a0 + a1 * a1) + (a2 * a2 + a3 * a3); hh[2 * c] = (h16x2){(_Float16)a0, (_Float16)a1}; hh[2 * c + 1] = (h16x2){(_Float16)a2, (_Float16)a3}; }
        const float rstd = rsqrtf(wave_total(ssq) * (1.0f / DM) + EPS);
        tnext = __builtin_amdgcn_readfirstlane((int)tv); asm volatile("" : "+s"(tnext));
        const int e0 = EX[(size_t)t * 128 + lane], e1 = EX[(size_t)t * 128 + 64 + lane]; float g0 = GT[(size_t)t * 128 + lane] * rstd, g1 = GT[(size_t)t * 128 + 64 + lane] * rstd;
        {
            float m0 = g0, m1 = g1;
#define MK_DPP_MAX(v, ctrl) v = fmaxf(v, __int_as_float(__builtin_amdgcn_update_dpp(0, __float_as_int(v), ctrl, 0xF, 0xF, true)))
            MK_DPP_MAX(m0, 0xB1); MK_DPP_MAX(m0, 0x4E); MK_DPP_MAX(m0, 0x141); MK_DPP_MAX(m0, 0x140); MK_DPP_MAX(m1, 0xB1); MK_DPP_MAX(m1, 0x4E); MK_DPP_MAX(m1, 0x141); MK_DPP_MAX(m1, 0x140);
#undef MK_DPP_MAX
            g0 = __expf(g0 - m0); g1 = __expf(g1 - m1); float s0 = g0, s1 = g1;
            MK_DPP_ADD(s0, 0xB1); MK_DPP_ADD(s0, 0x4E); MK_DPP_ADD(s0, 0x141); MK_DPP_ADD(s0, 0x140); MK_DPP_ADD(s1, 0xB1); MK_DPP_ADD(s1, 0x4E); MK_DPP_ADD(s1, 0x141); MK_DPP_ADD(s1, 0x140);
            g0 /= s0; g1 /= s1; }
        const float zs = rstd * (1.0f / U_SCALE);
#define MK_GRP(w, q) (u32x6){w[(6 * (q) + 0) >> 2][(6 * (q) + 0) & 3], w[(6 * (q) + 1) >> 2][(6 * (q) + 1) & 3], w[(6 * (q) + 2) >> 2][(6 * (q) + 2) & 3], w[(6 * (q) + 3) >> 2][(6 * (q) + 3) & 3], w[(6 * (q) + 4) >> 2][(6 * (q) + 4) & 3], w[(6 * (q) + 5) >> 2][(6 * (q) + 5) & 3]}
#define MK_ROWS(buf, TAB, k) do { const int ev_ = (k) < 16 ? e0 : e1; _Pragma("unroll") for (int j_ = 0; j_ < 4; ++j_) { const int e_ = __builtin_amdgcn_readlane(ev_, (4 * (k) + j_) & 63); \
            const unsigned char* r_ = TAB + (size_t)e_ * 3072 + lane * 48; _Pragma("unroll") for (int c_ = 0; c_ < 3; ++c_) buf[j_][c_] = *(const u32x4*)(r_ + c_ * 16); } } while (0)
        int wv0 = 0, wv1 = 0;
#define MK_DPPF(v, ctrl) __int_as_float(__builtin_amdgcn_update_dpp(0, __float_as_int(v), ctrl, 0xF, 0xF, true))
#define MK_UCOMP(buf, k) do { float p_[4]; _Pragma("unroll") for (int j_ = 0; j_ < 4; ++j_) { float za_ = 0.f, zb_ = 0.f; \
            _Pragma("unroll") for (int q_ = 0; q_ < 2; ++q_) { const h16x32 d_ = __builtin_amdgcn_cvt_scalef32_pk32_f16_fp6(MK_GRP(buf[j_], q_), 1.0f); \
                _Pragma("unroll") for (int p2_ = 0; p2_ < 16; p2_ += 2) { za_ = __builtin_amdgcn_fdot2((h16x2){d_[2 * p2_], d_[2 * p2_ + 1]}, hh[q_ * 16 + p2_], za_, false); \
                    zb_ = __builtin_amdgcn_fdot2((h16x2){d_[2 * p2_ + 2], d_[2 * p2_ + 3]}, hh[q_ * 16 + p2_ + 1], zb_, false); } } \
            p_[j_] = za_ + zb_; } \
            const bool o0_ = (lane & 1) != 0, o1_ = (lane & 2) != 0; \
            const float r01_ = (o0_ ? p_[1] : p_[0]) + MK_DPPF((o0_ ? p_[0] : p_[1]), 0xB1), r23_ = (o0_ ? p_[3] : p_[2]) + MK_DPPF((o0_ ? p_[2] : p_[3]), 0xB1); \
            float r_ = (o1_ ? r23_ : r01_) + MK_DPPF((o1_ ? r01_ : r23_), 0x4E); \
            r_ += MK_DPPF(r_, 0x124); r_ += MK_DPPF(r_, 0x128); \
            { auto s_ = __builtin_amdgcn_permlane16_swap(__float_as_uint(r_), __float_as_uint(r_), false, false); r_ = __uint_as_float(s_[0]) + __uint_as_float(s_[1]); } \
            { auto s_ = __builtin_amdgcn_permlane32_swap(__float_as_uint(r_), __float_as_uint(r_), false, false); r_ = __uint_as_float(s_[0]) + __uint_as_float(s_[1]); } \
            const bool me_ = (lane >> 2) == ((k) & 15); \
            if ((k) < 16) wv0 = me_ ? __float_as_int(r_) : wv0; else wv1 = me_ ? __float_as_int(r_) : wv1; } while (0)
        {
            u32x4 b0[4][3], b1[4][3], b2[4][3];
            MK_ROWS(b0, U, 0); MK_ROWS(b1, U, 1);
            for (int k = 0; k < 30; k += 3) { MK_ROWS(b2, U, k + 2); MK_UCOMP(b0, k); MK_ROWS(b0, U, k + 3); MK_UCOMP(b1, k + 1); MK_ROWS(b1, U, k + 4); MK_UCOMP(b2, k + 2); }
            MK_UCOMP(b0, 30); MK_UCOMP(b1, 31);
        }
        {
            const float z0 = __int_as_float(wv0) * zs, z1 = __int_as_float(wv1) * zs;
            wv0 = __float_as_int(g0 * 0.5f * z0 * (1.0f + erff(z0 * 0.7071067811865476f)) * (1.0f / V_SCALE));
            wv1 = __float_as_int(g1 * 0.5f * z1 * (1.0f + erff(z1 * 0.7071067811865476f)) * (1.0f / V_SCALE)); }
        f32x2 acc[32];
#pragma unroll
        for (int i = 0; i < 32; ++i) acc[i] = (f32x2){0.f, 0.f};
#define MK_VCOMP(buf, k) do { const int wv_ = (k) < 16 ? wv0 : wv1; _Pragma("unroll") for (int j_ = 0; j_ < 4; ++j_) { const float w_ = __int_as_float(__builtin_amdgcn_readlane(wv_, (4 * (k) + j_) & 63)); const f32x2 w2_ = (f32x2){w_, w_}; \
            _Pragma("unroll") for (int q_ = 0; q_ < 2; ++q_) { const f32x32v d_ = __builtin_amdgcn_cvt_scalef32_pk32_f32_fp6(MK_GRP(buf[j_], q_), 1.0f); \
                _Pragma("unroll") for (int p_ = 0; p_ < 16; ++p_) acc[q_ * 16 + p_] = __builtin_elementwise_fma((f32x2){d_[2 * p_], d_[2 * p_ + 1]}, w2_, acc[q_ * 16 + p_]); } } } while (0)
        {
            u32x4 b0[4][3], b1[4][3];
            MK_ROWS(b0, V, 0);
            for (int k = 0; k < 32; k += 2) { MK_ROWS(b1, V, k + 1); MK_VCOMP(b0, k); if (k + 2 < 32) MK_ROWS(b0, V, k + 2); MK_VCOMP(b1, k + 1); }
        }
#undef MK_ROWS
#undef MK_UCOMP
#undef MK_DPPF
#undef MK_VCOMP
#undef MK_GRP
        asm volatile("" : "+v"(lane));
        float* xr = F.out + (size_t)t * DM + 4 * lane; f32x4 xo[16]; float ss = 0.f;
#pragma unroll
        for (int c = 0; c < 16; ++c) xo[c] = *(const f32x4*)(xr + c * 256);
#pragma unroll
        for (int c = 0; c < 16; ++c) { f32x4 a = xo[c]; const int q = c >> 3, pb_ = 2 * (c & 7);
            a[0] += acc[q * 16 + pb_].x; a[1] += acc[q * 16 + pb_].y; a[2] += acc[q * 16 + pb_ + 1].x; a[3] += acc[q * 16 + pb_ + 1].y; *(f32x4*)(xr + c * 256) = a; xo[c] = a;
            ss += (a[0] * a[0] + a[1] * a[1]) + (a[2] * a[2] + a[3] * a[3]); }
        if (l == 0) {
            const float r = rsqrtf(wave_total(ss) * (1.0f / DM) + EPS) * HN8_SCALE; unsigned char* hr = F.ws + WS_T2 + TO_HN8 + (size_t)t * DM + 4 * lane;
#pragma unroll
            for (int c = 0; c < 16; ++c) *(unsigned*)(hr + c * 256) = pk_fp8x4(xo[c][0] * r, xo[c][1] * r, xo[c][2] * r, xo[c][3] * r); }
    }
#undef MK_TPOP
#undef MK_LANE
}

__global__ void __launch_bounds__(NTHR, 2) mk_fwd(Args args) {
    extern __shared__ __attribute__((aligned(16))) unsigned char lds_raw[];
    Frame F;
    F.a = &args;
    F.out = args.out; F.ws = args.ws; F.lds = (LAS unsigned char*)lds_raw;
    const int wave_id = __builtin_amdgcn_readfirstlane((int)threadIdx.x >> 6);
#define MK_TID() ({ unsigned z_ = 0u; asm volatile("" : "+v"(z_)); wave_id * 64 + (int)__builtin_amdgcn_mbcnt_hi(~0u, __builtin_amdgcn_mbcnt_lo(~0u, z_)); })
    F.tid = MK_TID(); F.lane = F.tid & 63; F.wid = wave_id; F.rank = (int)blockIdx.x; F.nwg = (int)gridDim.x;
#define MK_BAR_PTR(full) ((unsigned*)(args.ws + WS_CTL) + ((full) ? 0 : 4096 * (1 + sid())))
    if (MK_TID() == 0) *(LAS u32x4*)(F.lds + LDS_XB) = (u32x4){0u, 0u, 0u, 0u};
    __syncthreads();
    (void)xcd_barrier_post(MK_BAR_PTR(1), (volatile LAS unsigned*)(F.lds + LDS_XB), MK_TID() == 0);
    (void)xcd_barrier_post(MK_BAR_PTR(0), (volatile LAS unsigned*)(F.lds + LDS_XB + 8), MK_TID() == 0);
#ifndef MK_ONLY
#define MK_ONLY -1
#endif
#define MK_EN(s) (MK_ONLY < 0 || MK_ONLY == (s))
#define MK_FRESH(gs, all) do { int t_ = MK_TID(); asm volatile("" : "+v"(t_)); F.tid = t_; F.lane = t_ & 63; F.wid = __builtin_amdgcn_readfirstlane(t_ >> 6); \
        F.rank = (all) ? (int)blockIdx.x : wg_rank(); F.nwg = (all) ? (int)gridDim.x : wg_count(); \
        __attribute__((address_space(1))) unsigned char* w_ = (__attribute__((address_space(1))) unsigned char*)(args.ws + (size_t)(gs) * ACT_SZ); \
        __attribute__((address_space(1))) float* o_ = (__attribute__((address_space(1))) float*)(args.out + (size_t)(gs) * T * DM); \
        asm volatile("" : "+s"(w_), "+s"(o_)); F.ws = (unsigned char*)w_; F.out = (float*)o_; } while (0)
#define MK_BAR(full) do { XcdBarrier b_; b_.bar = MK_BAR_PTR(full); b_.x = xb_xcc_id(); b_.G = (full) ? gridDim.x : (gridDim.x >> 1); b_.st = (volatile LAS unsigned*)(F.lds + LDS_XB + ((full) ? 0 : 8)); \
        xcd_barrier(b_, MK_TID() == 0); } while (0)
    if (MK_EN(100)) { MK_FRESH(0, 1); p0_a(F); MK_FRESH(0, 1); p0_b(F, (int)blockIdx.x, (int)gridDim.x);
        for (int gs = 0; gs < 2; ++gs) { MK_FRESH(gs, 1); p_norm(F, F.a->in[I_X] + (size_t)gs * T * DM, (bf16_t*)(F.ws + WS_T2 + TO_HN8)); } }
    MK_BAR(1);
#ifndef MK_NHEAD
#define MK_NHEAD 4
#endif
#ifndef MK_JTAIL
#define MK_JTAIL 15
#endif
    const int nsteps = (sid() == 0) ? (18 + 18 - MK_JTAIL) : (MK_NHEAD + 18);
    for (int i = 0; i < nsteps; ++i) {
        int gs, g, all, nall;
        if (sid() == 0) { if (i < 18) { gs = 0; g = i; all = i < MK_NHEAD; nall = (i + 1 < MK_NHEAD) || (i + 1 >= 18); } else { gs = 1; g = MK_JTAIL + (i - 18); all = 1; nall = 1; } }
        else { if (i < MK_NHEAD) { gs = 0; g = i; all = 1; nall = (i + 1 < MK_NHEAD); } else { gs = 1; g = i - MK_NHEAD; all = g >= MK_JTAIL; nall = (g + 1 >= MK_JTAIL); } }
        const int l = g >= 9 ? 1 : 0, st = g - 9 * l;
#define lw (F.a->ws + WS_W + (size_t)l * LW_END)
#define xin ((l == 0) ? (F.a->in[I_X] + (size_t)gs * T * DM) : (const float*)F.out)
        MK_FRESH(gs, all);
        if (st == 0) {
            if (MK_EN(1)) { pg8::Gemm gm{(const bf16_t*)(F.ws + WS_T2 + TO_HN8), (const bf16_t*)(lw + LW_WIN), T, NINP, DM}; pg8::StaticOrder So; So.init(T, NINP, F.nwg, F.rank);
                pg8::EpiG1N E{(bf16_t*)(F.ws + WS_P), NINP, (bf16_t*)(F.ws + WS_QKV), SZ_H1 / 2, 1.0f / (HN8_SCALE * WIN8_SCALE), F.a->in[I_DGQK] + l * 128, F.a->in[I_DILG] + l * 256, F.a->in[I_NAG] + l * 256, (LAS float*)(F.lds + LDS_G1X)};
                pg8::gemm_phase_f8<pg8::EpiG1N, pg8::StaticOrder>(F.lds, gm, So, E, nullptr, MK_TID()); }
        } else if (st == 1) {
            if (MK_EN(3)) {
                for (int gi = 0; gi < 2; ++gi) {
                    pg8::Gemm gm{(const bf16_t*)(F.ws + WS_P) + (gi ? 9984 : 9216), (const bf16_t*)(lw + (gi ? LW_WUKV : LW_WUQ)), T, gi ? 2048 : 1536, gi ? 512 : 768, NINP}; pg8::StaticOrder So; So.init(T, gm.N, F.nwg, F.rank);
                    pg8::EpiBf16P E{(bf16_t*)(F.ws + WS_O + (gi ? OO_KVRAW : OO_QRAW)), gm.N}; pg8::gemm_phase<pg8::EpiBf16P, pg8::StaticOrder>(F.lds, gm, So, E, nullptr, MK_TID());
                    __syncthreads();
                }
            }
        } else if (st == 2) { if (MK_EN(4)) p_post2(F, l);
        } else if (st == 3) { if (MK_EN(5)) p_attention(F, l, gs);
        } else if (st == 4) { if (MK_EN(6)) p_post3(F, l);
        } else if (st == 5) {
            if (MK_EN(7)) { pg8::Gemm gm{(const bf16_t*)(F.ws + WS_O), (const bf16_t*)(lw + LW_WOUT), T, DM, DM}; pg8::StaticOrder So; So.init(T, DM, F.nwg, F.rank);
                pg8::EpiResF32N E{xin, F.out, DM, (bf16_t*)(F.ws + WS_HN), 1.0f / (O8_SCALE * WOUT8_SCALE)}; pg8::gemm_phase_f8<pg8::EpiResF32N, pg8::StaticOrder>(F.lds, gm, So, E, nullptr, MK_TID()); }
        } else if (st == 6) {
            if (MK_EN(9)) { pg8::Gemm gm{(const bf16_t*)(F.ws + WS_HN), (const bf16_t*)(lw + LW_W2), T, 2048, DM}; pg8::StaticOrder So; So.init(T, 2048, F.nwg, F.rank);
                pg8::EpiF32 E{(float*)(F.ws + WS_P + PO_SC), 2048, nullptr}; pg8::gemm_phase<pg8::EpiF32, pg8::StaticOrder>(F.lds, gm, So, E, nullptr, MK_TID()); }
        } else if (st == 7) { if (MK_EN(10)) p_select(F, l);
        } else { if (MK_EN(11)) p_gather(F, l, gs); }
        if (i + 1 < nsteps) { if (all || nall) MK_BAR(1); else MK_BAR(0); }
#undef lw
#undef xin
    }
}
}

extern "C" void kernel_launch(void* const* d_in, const int* in_sizes, int n_in, void* d_out, int out_size, void* d_ws, size_t ws_size, hipStream_t stream) {
    static int grid = 0;
    if (grid == 0) {
        if (n_in != 20 || out_size != mk::TT * mk::DM || ws_size < mk::WS_TOTAL) { fprintf(stderr, "kernel_launch: unexpected shapes (n_in %d out %d ws %zu, need %zu)\n", n_in, out_size, ws_size, (size_t)mk::WS_TOTAL); grid = -1; return; }
        int dev = 0, cus = 0, per_cu = 0;
        if (hipGetDevice(&dev) != hipSuccess || hipDeviceGetAttribute(&cus, hipDeviceAttributeMultiprocessorCount, dev) != hipSuccess) { grid = -1; return; }
        if (hipFuncSetAttribute((const void*)mk::mk_fwd, hipFuncAttributeMaxDynamicSharedMemorySize, mk::LDS_BYTES) != hipSuccess) { fprintf(stderr, "kernel_launch: hipFuncSetAttribute failed\n"); grid = -1; return; }
        if (hipOccupancyMaxActiveBlocksPerMultiprocessor(&per_cu, (const void*)mk::mk_fwd, mk::NTHR, mk::LDS_BYTES) != hipSuccess || per_cu < 1) { fprintf(stderr, "kernel_launch: occupancy query says %d\n", per_cu); }
        (void)hipGetLastError();
        grid = cus & ~15;
    }
    if (grid < 0) return;
    (void)hipMemsetAsync((char*)d_ws + mk::WS_CTL, 0, 65536, stream);
    mk::Args a{};
    for (int i = 0; i < 20; ++i) a.in[i] = (const float*)d_in[i];
    a.out = (float*)d_out; a.ws = (unsigned char*)d_ws;
    hipLaunchKernelGGL(mk::mk_fwd, dim3(grid), dim3(mk::NTHR), mk::LDS_BYTES, stream, a);
    const hipError_t le = hipPeekAtLastError();
    if (le != hipSuccess) fprintf(stderr, "kernel_launch: launch failed: %s\n", hipGetErrorName(le));
}
```

```cpp
#include <hip/hip_runtime.h>
#include <cstdio>
#include <cstdint>
#include <cstddef>
namespace pg8 {
#define PG8_LAS __attribute__((address_space(3)))
typedef unsigned short bf16_t;
typedef short bf16x8 __attribute__((ext_vector_type(8)));
typedef float f32x4 __attribute__((ext_vector_type(4)));
typedef unsigned u32x4 __attribute__((ext_vector_type(4)));
typedef int i32x8 __attribute__((ext_vector_type(8)));
typedef int i32x4 __attribute__((ext_vector_type(4)));
typedef int i32x16 __attribute__((ext_vector_type(16)));
typedef int i32x32 __attribute__((ext_vector_type(32)));
typedef float f32x32 __attribute__((ext_vector_type(32)));
constexpr int BM = 256, BK = 64, HALF = 128, HTB = HALF * BK * 2  , STAGE_BYTES = 8 * HTB, NXCD = 8, WGM = 4;

__host__ __device__ __forceinline__ int lds_byte(int r, int c) { const int st = (r >> 4) * 2 + (c >> 5), rr = r & 15, cc = c & 31, ob = rr * 64 + cc * 2; return st * 1024 + (ob ^ (((ob >> 9) & 1) << 5)); }
__host__ __device__ __forceinline__ void stage_rc(int b, int& R, int& C) { const int st = b / 1024, sb = b % 1024, swz = sb ^ (((sb >> 9) & 1) << 5); R = (st >> 1) * 16 + swz / 64; C = (st & 1) * 32 + (swz % 64) / 2; }
__host__ __device__ __forceinline__ int perm32(int rho) { const int n = rho >> 4, i = rho & 15; return 8 * (i >> 2) + 4 * n + (i & 3); }

struct Unit { int pm, pn; };
struct Gemm { const bf16_t* A; const bf16_t* Bt; int M, N, K; int lda = 0; };

struct StaticOrder {
    int nM, nN, nwg, G, c;
    __host__ __device__ void init(int M, int N, int G_, int c_) { nM = M / BM; nN = N / BM; nwg = nM * nN; G = G_; c = c_; }
    __host__ __device__ bool next(int i, Unit& u) const {
        const long L = (long)i * G + c; if (L >= nwg) return false;
        int wgid = (int)L; { const int q = nwg / NXCD, r = nwg % NXCD, xcd = wgid % NXCD, off = wgid / NXCD; wgid = (xcd < r ? xcd * (q + 1) : r * (q + 1) + (xcd - r) * q) + off; }
        const int nig = WGM * nN, gid = wgid / nig, fm = gid * WGM, gsz = (nM - fm) < WGM ? (nM - fm) : WGM;
        u.pm = fm + ((wgid % nig) % gsz); u.pn = (wgid % nig) / gsz; return true;
    }
    __device__ __forceinline__ void a_ready(const Unit&) const {}
    __device__ __forceinline__ void done(const Unit&) const {}
};
__device__ __forceinline__ unsigned cvt_pk_bf16(float lo, float hi) { unsigned r; asm volatile("v_cvt_pk_bf16_f32 %0, %1, %2" : "=v"(r) : "v"(lo), "v"(hi)); return r; }
typedef float f32x2 __attribute__((ext_vector_type(2)));
struct EpiF32 {
    static constexpr bool PERM = false, AFTER_DRAIN = false;
    float* C; int ldc; const float* bias;
    __device__ __forceinline__ void operator()(const f32x4 (&acc)[2][2][4][2], const Unit& u, int wr, int wc, int fr, int fq) const {
        const int row0 = u.pm * BM + wr * 64 + fr, col0 = u.pn * BM + wc * 32 + 4 * fq;
        f32x4 bv[2][2];
#pragma unroll
        for (int bj = 0; bj < 2; ++bj)
#pragma unroll
            for (int n = 0; n < 2; ++n) bv[bj][n] = bias ? *(const f32x4*)(bias + col0 + bj * HALF + n * 16) : (f32x4){0.f, 0.f, 0.f, 0.f};
#pragma unroll
        for (int ai = 0; ai < 2; ++ai)
#pragma unroll
            for (int m = 0; m < 4; ++m) { float* rowp = C + (size_t)(row0 + ai * HALF + m * 16) * ldc + col0;
#pragma unroll
                for (int bj = 0; bj < 2; ++bj)
#pragma unroll
                    for (int n = 0; n < 2; ++n) *(f32x4*)(rowp + bj * HALF + n * 16) = acc[ai][bj][m][n] + bv[bj][n]; }
    }
};
struct EpiBf16P {
    static constexpr bool PERM = true, AFTER_DRAIN = false;
    bf16_t* O; int ldc;
    __device__ __forceinline__ void operator()(const f32x4 (&acc)[2][2][4][2], const Unit& u, int wr, int wc, int fr, int fq) const {
        const int row0 = u.pm * BM + wr * 64 + fr, col0 = u.pn * BM + wc * 32 + 8 * fq;
#pragma unroll
        for (int ai = 0; ai < 2; ++ai)
#pragma unroll
            for (int m = 0; m < 4; ++m) { bf16_t* rowp = O + (size_t)(row0 + ai * HALF + m * 16) * ldc + col0;
#pragma unroll
                for (int bj = 0; bj < 2; ++bj) { const f32x4 v0 = acc[ai][bj][m][0], v1 = acc[ai][bj][m][1];
                    u32x4 w; w.x = cvt_pk_bf16(v0[0], v0[1]); w.y = cvt_pk_bf16(v0[2], v0[3]); w.z = cvt_pk_bf16(v1[0], v1[1]); w.w = cvt_pk_bf16(v1[2], v1[3]);
                    *(u32x4*)(rowp + bj * HALF) = w; } }
    }
};
struct EpiResF32 {
    static constexpr bool PERM = false, AFTER_DRAIN = false;
    const float* res; float* out; int ldc;
    __device__ __forceinline__ void operator()(const f32x4 (&acc)[2][2][4][2], const Unit& u, int wr, int wc, int fr, int fq) const {
        const int row0 = u.pm * BM + wr * 64 + fr, col0 = u.pn * BM + wc * 32 + 4 * fq;
#pragma unroll
        for (int ai = 0; ai < 2; ++ai)
#pragma unroll
            for (int m = 0; m < 4; ++m) { const size_t off = (size_t)(row0 + ai * HALF + m * 16) * ldc + col0;
#pragma unroll
                for (int bj = 0; bj < 2; ++bj)
#pragma unroll
                    for (int n = 0; n < 2; ++n) { const size_t o = off + bj * HALF + n * 16; const f32x4 r = *(const f32x4*)(res + o); *(f32x4*)(out + o) = r + acc[ai][bj][m][n]; } }
    }
};

struct EpiG1 {
    static constexpr bool PERM = true, AFTER_DRAIN = false;
    bf16_t* O; int ldc; bf16_t* vseg;
    size_t vstride; float oscale;
    __device__ __forceinline__ void operator()(const f32x4 (&acc)[2][2][4][2], const Unit& u, int wr, int wc, int fr, int fq) const {
        const int row0 = u.pm * BM + wr * 64 + fr, colt = u.pn * BM, seg = colt >> 10;
        const bool isv = (seg == 2) || (seg == 5) || (seg == 8);
#pragma unroll
        for (int ai = 0; ai < 2; ++ai)
#pragma unroll
            for (int m = 0; m < 4; ++m) { const int row = row0 + ai * HALF + m * 16;
#pragma unroll
                for (int bj = 0; bj < 2; ++bj) { const f32x4 v0 = acc[ai][bj][m][0] * oscale, v1 = acc[ai][bj][m][1] * oscale;
                    u32x4 w; w.x = cvt_pk_bf16(v0[0], v0[1]); w.y = cvt_pk_bf16(v0[2], v0[3]); w.z = cvt_pk_bf16(v1[0], v1[1]); w.w = cvt_pk_bf16(v1[2], v1[3]);
                    bf16_t* dst;
                    if (isv) { const int h = ((colt & 1023) >> 7) + bj; dst = vseg + (size_t)seg * vstride + ((size_t)((row >> 11) * 8 + h) * 2048 + (row & 2047)) * 128 + wc * 32 + 8 * fq; }
                    else dst = O + (size_t)row * ldc + colt + bj * HALF + wc * 32 + 8 * fq;
                    *(u32x4*)dst = w; } }
    }
};
struct EpiResF32N {
    static constexpr bool PERM = false, AFTER_DRAIN = false;
    const float* res; float* out; int ldc; bf16_t* xb; float oscale;
    __device__ __forceinline__ void operator()(const f32x4 (&acc)[2][2][4][2], const Unit& u, int wr, int wc, int fr, int fq) const {
        asm volatile("" : "+v"(fr), "+v"(fq));
        const int row0 = u.pm * BM + wr * 64 + fr, col0 = u.pn * BM + wc * 32 + 4 * fq;
        typedef unsigned u32x2e __attribute__((ext_vector_type(2)));
#pragma unroll
        for (int ai = 0; ai < 2; ++ai) { f32x4 r[4][2][2];
#pragma unroll
            for (int m = 0; m < 4; ++m)
#pragma unroll
                for (int bj = 0; bj < 2; ++bj)
#pragma unroll
                    for (int n = 0; n < 2; ++n) r[m][bj][n] = *(const f32x4*)(res + (size_t)(row0 + ai * HALF + m * 16) * ldc + col0 + bj * HALF + n * 16);
            asm volatile("" ::: "memory");
#pragma unroll
            for (int m = 0; m < 4; ++m)
#pragma unroll
                for (int bj = 0; bj < 2; ++bj)
#pragma unroll
                    for (int n = 0; n < 2; ++n) { const size_t o = (size_t)(row0 + ai * HALF + m * 16) * ldc + col0 + bj * HALF + n * 16;
                        const f32x4 v = r[m][bj][n] + acc[ai][bj][m][n] * oscale; *(f32x4*)(out + o) = v;
                        u32x2e w; w.x = cvt_pk_bf16(v[0], v[1]); w.y = cvt_pk_bf16(v[2], v[3]); *(u32x2e*)(xb + o) = w; }
            asm volatile("" ::: "memory"); }
    }
};

struct EpiG1N {
    static constexpr bool PERM = true, AFTER_DRAIN = false;
    bf16_t* O; int ldc; bf16_t* qkv;
    size_t vstride; float oscale; const float* gA; const float* gB; const float* gC;
    PG8_LAS float* X;
    __device__ __forceinline__ void operator()(const f32x4 (&acc)[2][2][4][2], const Unit& u, int wr, int wc, int fr, int fq) const {
        asm volatile("" : "+v"(fr), "+v"(fq));
        const int row0 = u.pm * BM + wr * 64 + fr, colt = u.pn * BM, seg = colt >> 10, which = seg % 3, mixer = seg / 3;
        if (seg >= 9 || which == 2) {
#pragma unroll
            for (int ai = 0; ai < 2; ++ai)
#pragma unroll
                for (int m = 0; m < 4; ++m) { const int row = row0 + ai * HALF + m * 16;
#pragma unroll
                    for (int bj = 0; bj < 2; ++bj) { const f32x4 v0 = acc[ai][bj][m][0] * oscale, v1 = acc[ai][bj][m][1] * oscale;
                        u32x4 w; w.x = cvt_pk_bf16(v0[0], v0[1]); w.y = cvt_pk_bf16(v0[2], v0[3]); w.z = cvt_pk_bf16(v1[0], v1[1]); w.w = cvt_pk_bf16(v1[2], v1[3]);
                        bf16_t* dst;
                        if (seg < 9) { const int h = ((colt & 1023) >> 7) + bj; dst = qkv + (size_t)seg * vstride + ((size_t)((row >> 11) * 8 + h) * 2048 + (row & 2047)) * 128 + wc * 32 + 8 * fq; }
                        else dst = O + (size_t)row * ldc + colt + bj * HALF + wc * 32 + 8 * fq;
                        *(u32x4*)dst = w; } }
            return;
        }
        const int lane = fr + 16 * fq;
        float ss[2][4][2];
#pragma unroll
        for (int ai = 0; ai < 2; ++ai)
#pragma unroll
            for (int m = 0; m < 4; ++m)
#pragma unroll
                for (int bj = 0; bj < 2; ++bj) { const f32x4 v0 = acc[ai][bj][m][0] * oscale, v1 = acc[ai][bj][m][1] * oscale;
                    float s = (v0[0] * v0[0] + v0[1] * v0[1]) + (v0[2] * v0[2] + v0[3] * v0[3]) + (v1[0] * v1[0] + v1[1] * v1[1]) + (v1[2] * v1[2] + v1[3] * v1[3]);
                    s += __int_as_float(__builtin_amdgcn_ds_bpermute((lane ^ 16) << 2, __float_as_int(s)));
                    s += __int_as_float(__builtin_amdgcn_ds_bpermute((lane ^ 32) << 2, __float_as_int(s)));
                    ss[ai][m][bj] = s; }
        if (fq == 0) {
#pragma unroll
            for (int ai = 0; ai < 2; ++ai)
#pragma unroll
                for (int m = 0; m < 4; ++m)
#pragma unroll
                    for (int bj = 0; bj < 2; ++bj) X[(((wr * 128) + ai * 64 + m * 16 + fr) * 2 + bj) * 4 + wc] = ss[ai][m][bj]; }
        asm volatile("s_waitcnt lgkmcnt(0)" ::: "memory"); __builtin_amdgcn_s_barrier(); asm volatile("" ::: "memory");
        const float* g = (mixer == 0 ? gA + which * 64 + (wc & 1) * 32 : (mixer == 1 ? gB : gC) + which * 128 + wc * 32) + 8 * fq;
        const f32x4 g0 = *(const f32x4*)g, g1 = *(const f32x4*)(g + 4);
        const float qs = which == 0 ? (mixer == 0 ? 0.125f : 0.08838834764831845f) : 1.0f;
#pragma unroll
        for (int ai = 0; ai < 2; ++ai)
#pragma unroll
            for (int m = 0; m < 4; ++m) { const int row = row0 + ai * HALF + m * 16;
#pragma unroll
                for (int bj = 0; bj < 2; ++bj) { const f32x4 pw = *(const PG8_LAS f32x4*)(X + (((wr * 128) + ai * 64 + m * 16 + fr) * 2 + bj) * 4);
                    float tot, inv; if (mixer == 0) { tot = (wc & 2) ? (pw[2] + pw[3]) : (pw[0] + pw[1]); inv = 1.0f / 64; } else { tot = (pw[0] + pw[1]) + (pw[2] + pw[3]); inv = 1.0f / 128; }
                    const float r = rsqrtf(tot * inv + 1e-6f) * qs * oscale;
                    const f32x4 v0 = acc[ai][bj][m][0] * r * g0, v1 = acc[ai][bj][m][1] * r * g1;
                    u32x4 w; w.x = cvt_pk_bf16(v0[0], v0[1]); w.y = cvt_pk_bf16(v0[2], v0[3]); w.z = cvt_pk_bf16(v1[0], v1[1]); w.w = cvt_pk_bf16(v1[2], v1[3]);
                    const int h = ((colt & 1023) >> 7) + bj; bf16_t* dst;
                    if (mixer == 0) dst = qkv + (size_t)seg * vstride + ((size_t)((row >> 11) * 16 + 2 * h + (wc >> 1)) * 2048 + (row & 2047)) * 64 + (wc & 1) * 32 + 8 * fq;
                    else dst = qkv + (size_t)seg * vstride + ((size_t)((row >> 11) * 8 + h) * 2048 + (row & 2047)) * 128 + wc * 32 + 8 * fq;
                    *(u32x4*)dst = w; } }
    }
};

template <class Epi, class Sched, bool STAMP = false>
__device__ __forceinline__ void gemm_phase(PG8_LAS unsigned char* lds, const Gemm g, const Sched& S, const Epi& E, unsigned long long* stamps, int tid_in) {
    int tid_ = tid_in; asm volatile("" : "+v"(tid_));
    const int tid = tid_, wid = __builtin_amdgcn_readfirstlane(tid >> 6), lane = tid & 63, wr = wid >> 2, wc = wid & 3, fr = lane & 15, fq = lane >> 4;
    const int K = g.K, nt = K / BK, LDA = g.lda ? g.lda : g.K;
    int ts_lo = 0, ts_hi = 0, nts = 0; const unsigned long long rt_entry = STAMP ? (unsigned long long)wall_clock64() : 0ull;
#define PG8_STAMP() do { if (STAMP && wid == 0 && nts < 64) { const unsigned long long _c = (unsigned long long)clock64(); \
        ts_lo = (lane == nts) ? (int)(unsigned)_c : ts_lo; ts_hi = (lane == nts) ? (int)(unsigned)(_c >> 32) : ts_hi; ++nts; } } while (0)
    PG8_STAMP();
    unsigned voffA[2], voffB[2];
#pragma unroll
    for (int i = 0; i < 2; ++i) { int R, C; stage_rc(tid * 16 + i * 8192, R, C); const int Rb = Epi::PERM ? ((R & ~31) + perm32(R & 31)) : R;
        voffA[i] = (unsigned)(R * LDA + C) * 2u; voffB[i] = (unsigned)(Rb * K + C) * 2u; }
    const size_t kstep = (size_t)(BK * 2);
    const size_t hstep = (size_t)HALF * K * 2;
    const size_t tstep = 2 * hstep;
    const size_t hstepA = (size_t)HALF * LDA * 2, tstepA = 2 * hstepA;
    const unsigned ldsw = (unsigned)wid * 1024u;
    const int aoff = lds_byte(wr * 64 + fr, fq * 8), boff = lds_byte(wc * 32 + fr, fq * 8);
#define PG8_SA(b, h) (((b) * 2 + (h)) * HTB)
#define PG8_SB(b, h) ((4 + (b) * 2 + (h)) * HTB)
#define PG8_STAGE(bufoff, gbase, voff) do { _Pragma("unroll") for (int _i = 0; _i < 2; ++_i) \
        __builtin_amdgcn_global_load_lds((const unsigned*)((const char*)(gbase) + (voff)[_i]), (PG8_LAS unsigned*)(lds + (bufoff) + ldsw + _i * 8192), 16, 0, 0); } while (0)
#define PG8_LDA(dst, b, h) do { _Pragma("unroll") for (int m = 0; m < 4; ++m) _Pragma("unroll") for (int k = 0; k < 2; ++k) dst[m][k] = *(const PG8_LAS bf16x8*)(lds + PG8_SA(b, h) + aoff + m * 2048 + k * 1024); } while (0)
#define PG8_LDB(dst, b, h) do { _Pragma("unroll") for (int n = 0; n < 2; ++n) _Pragma("unroll") for (int k = 0; k < 2; ++k) dst[n][k] = *(const PG8_LAS bf16x8*)(lds + PG8_SB(b, h) + boff + n * 2048 + k * 1024); } while (0)
#define PG8_MMA(ai, bj, At, Bt) do { __builtin_amdgcn_s_setprio(1); _Pragma("unroll") for (int m = 0; m < 4; ++m) _Pragma("unroll") for (int n = 0; n < 2; ++n) _Pragma("unroll") for (int k = 0; k < 2; ++k) \
        acc[ai][bj][m][n] = __builtin_amdgcn_mfma_f32_16x16x32_bf16(Bt[n][k], At[m][k], acc[ai][bj][m][n], 0, 0, 0); __builtin_amdgcn_s_setprio(0); } while (0)
#define PG8_WAIT_V(n) asm volatile("s_waitcnt vmcnt(" #n ")" ::: "memory")
#define PG8_WAIT_L(n) asm volatile("s_waitcnt lgkmcnt(" #n ")" ::: "memory")
#define PG8_BAR __builtin_amdgcn_s_barrier()
#define PG8_SCHED __builtin_amdgcn_sched_barrier(0)
    Unit cur, nxt; int ui = 0;
    if (!S.next(0, cur)) return;
    f32x4 acc[2][2][4][2];
#pragma unroll
    for (int a = 0; a < 2; ++a)
#pragma unroll
        for (int b = 0; b < 2; ++b)
#pragma unroll
            for (int m = 0; m < 4; ++m)
#pragma unroll
                for (int n = 0; n < 2; ++n) acc[a][b][m][n] = (f32x4){0.f, 0.f, 0.f, 0.f};
    bf16x8 At[4][2], B0[2][2], B1[2][2];
    const char* cA = (const char*)g.A + (size_t)cur.pm * tstepA; const char* cB = (const char*)g.Bt + (size_t)cur.pn * tstep;
    S.a_ready(cur);
    PG8_STAGE(PG8_SB(0, 0), cB, voffB); PG8_STAGE(PG8_SA(0, 0), cA, voffA); PG8_STAGE(PG8_SB(0, 1), cB + hstep, voffB); PG8_STAGE(PG8_SA(0, 1), cA + hstepA, voffA);
    if (wr == 1) PG8_BAR;
    PG8_WAIT_V(4); PG8_BAR;
    PG8_STAGE(PG8_SB(1, 0), cB + kstep, voffB); PG8_STAGE(PG8_SA(1, 0), cA + kstep, voffA); PG8_STAGE(PG8_SB(1, 1), cB + hstep + kstep, voffB);
    PG8_WAIT_V(6); PG8_BAR;
    PG8_STAMP();
    for (;;) {
        const bool has_next = S.next(ui + 1, nxt);
        const char* nA = has_next ? (const char*)g.A + (size_t)nxt.pm * tstepA : cA; const char* nB = has_next ? (const char*)g.Bt + (size_t)nxt.pn * tstep : cB;
        for (int t = 0; t < nt; t += 2) {
            const bool last = (t == nt - 2);
            const char* a1 = cA + (size_t)(t + 1) * kstep;
            const char* a2 = last ? nA : cA + (size_t)(t + 2) * kstep; const char* b2 = last ? nB : cB + (size_t)(t + 2) * kstep;
            const char* a3 = a2 + kstep; const char* b3 = b2 + kstep;
            if (last && has_next) S.a_ready(nxt);
            PG8_LDB(B0, 0, 0); PG8_SCHED; PG8_LDA(At, 0, 0); PG8_STAGE(PG8_SA(1, 1), a1 + hstepA, voffA);
            PG8_WAIT_L(8); PG8_BAR; PG8_WAIT_L(0); PG8_MMA(0, 0, At, B0); PG8_BAR; PG8_SCHED;
            PG8_LDB(B1, 0, 1); PG8_STAGE(PG8_SB(0, 0), b2, voffB);
            PG8_BAR; PG8_WAIT_L(0); PG8_MMA(0, 1, At, B1); PG8_BAR;
            PG8_LDA(At, 0, 1); PG8_STAGE(PG8_SA(0, 0), a2, voffA);
            PG8_BAR; PG8_WAIT_L(0); PG8_MMA(1, 0, At, B0); PG8_BAR; PG8_SCHED;
            PG8_STAGE(PG8_SB(0, 1), b2 + hstep, voffB);
            PG8_WAIT_V(6); PG8_BAR; PG8_MMA(1, 1, At, B1); PG8_BAR;
            PG8_LDB(B0, 1, 0); PG8_SCHED; PG8_LDA(At, 1, 0); PG8_STAGE(PG8_SA(0, 1), a2 + hstepA, voffA);
            PG8_WAIT_L(8); PG8_BAR; PG8_WAIT_L(0); PG8_MMA(0, 0, At, B0); PG8_BAR; PG8_SCHED;
            PG8_LDB(B1, 1, 1); PG8_STAGE(PG8_SB(1, 0), b3, voffB);
            PG8_BAR; PG8_WAIT_L(0); PG8_MMA(0, 1, At, B1); PG8_BAR;
            PG8_LDA(At, 1, 1); PG8_STAGE(PG8_SA(1, 0), a3, voffA);
            PG8_BAR; PG8_WAIT_L(0); PG8_MMA(1, 0, At, B0); PG8_BAR; PG8_SCHED;
            PG8_STAGE(PG8_SB(1, 1), b3 + hstep, voffB);
            PG8_WAIT_V(6); PG8_BAR; PG8_MMA(1, 1, At, B1); PG8_BAR;
        }
        PG8_STAMP();
        if constexpr (!Epi::AFTER_DRAIN) { E(acc, cur, wr, wc, fr, fq); S.done(cur); }
        PG8_STAMP();
        if (!has_next) break;
#pragma unroll
        for (int a = 0; a < 2; ++a)
#pragma unroll
            for (int b = 0; b < 2; ++b)
#pragma unroll
                for (int m = 0; m < 4; ++m)
#pragma unroll
                    for (int n = 0; n < 2; ++n) acc[a][b][m][n] = (f32x4){0.f, 0.f, 0.f, 0.f};
        cur = nxt; cA = nA; cB = nB; ++ui;
    }
    PG8_WAIT_V(0);
    if (wr == 0) PG8_BAR;
    PG8_BAR;
    if constexpr (Epi::AFTER_DRAIN) { E.fused(acc, cur, wr, wc, fr, fq, lds, wid, lane); S.done(cur); }
    PG8_STAMP();
    if (STAMP && wid == 0) { stamps[lane] = lane < nts ? (((unsigned long long)(unsigned)ts_hi << 32) | (unsigned)ts_lo) : 0ull;
        if (lane == 62) stamps[62] = rt_entry; if (lane == 63) stamps[63] = (unsigned long long)wall_clock64(); }
#undef PG8_STAMP
#undef PG8_SA
#undef PG8_SB
#undef PG8_STAGE
#undef PG8_LDA
#undef PG8_LDB
#undef PG8_MMA
#undef PG8_WAIT_V
#undef PG8_WAIT_L
#undef PG8_BAR
#undef PG8_SCHED
}

template <class Epi, class Sched, bool STAMP = false>
__device__ __forceinline__ void gemm_phase_f8(PG8_LAS unsigned char* lds, const Gemm g, const Sched& S, const Epi& E, unsigned long long* stamps, int tid_in) {
    int tid_ = tid_in; asm volatile("" : "+v"(tid_));
    const int tid = tid_, wid = __builtin_amdgcn_readfirstlane(tid >> 6), lane = tid & 63, wr = wid >> 2, wc = wid & 3, fr = lane & 15, fq = lane >> 4;
    const int K = g.K, nt = K / 128;
    int ts_lo = 0, ts_hi = 0, nts = 0; const unsigned long long rt_entry = STAMP ? (unsigned long long)wall_clock64() : 0ull;
#define PG8_STAMP() do { if (STAMP && wid == 0 && nts < 64) { const unsigned long long _c = (unsigned long long)clock64(); \
        ts_lo = (lane == nts) ? (int)(unsigned)_c : ts_lo; ts_hi = (lane == nts) ? (int)(unsigned)(_c >> 32) : ts_hi; ++nts; } } while (0)
    PG8_STAMP();
    unsigned voffA[2], voffB[2];
#pragma unroll
    for (int i = 0; i < 2; ++i) { int R, C; stage_rc(tid * 16 + i * 8192, R, C); const int Rb = Epi::PERM ? ((R & ~31) + perm32(R & 31)) : R;
        voffA[i] = (unsigned)(R * K + C * 2); voffB[i] = (unsigned)(Rb * K + C * 2); }
    const size_t kstep = (size_t)(BK * 2);
    const size_t hstep = (size_t)HALF * K;
    const size_t tstep = 2 * hstep;
    const unsigned ldsw = (unsigned)wid * 1024u;
    const int aoff = lds_byte(wr * 64 + fr, fq * 16), boff = lds_byte(wc * 32 + fr, fq * 16);
    const int aoffk[2] = {aoff + 16 * (fq & 1), aoff + 16 * ((fq & 1) ^ 1)}, boffk[2] = {boff + 16 * (fq & 1), boff + 16 * ((fq & 1) ^ 1)};
#define PG8_SA(b, h) (((b) * 2 + (h)) * HTB)
#define PG8_SB(b, h) ((4 + (b) * 2 + (h)) * HTB)
#define PG8_STAGE(bufoff, gbase, voff) do { _Pragma("unroll") for (int _i = 0; _i < 2; ++_i) \
        __builtin_amdgcn_global_load_lds((const unsigned*)((const char*)(gbase) + (voff)[_i]), (PG8_LAS unsigned*)(lds + (bufoff) + ldsw + _i * 8192), 16, 0, 0); } while (0)
#define PG8_LDA(dst, b, h) do { _Pragma("unroll") for (int m = 0; m < 4; ++m) _Pragma("unroll") for (int k = 0; k < 2; ++k) { const i32x4 t_ = *(const PG8_LAS i32x4*)(lds + PG8_SA(b, h) + aoffk[k] + m * 2048); \
        dst[m * 8 + k * 4 + 0] = t_[0]; dst[m * 8 + k * 4 + 1] = t_[1]; dst[m * 8 + k * 4 + 2] = t_[2]; dst[m * 8 + k * 4 + 3] = t_[3]; } } while (0)
#define PG8_LDB(dst, b, h) do { _Pragma("unroll") for (int n = 0; n < 2; ++n) _Pragma("unroll") for (int k = 0; k < 2; ++k) { const i32x4 t_ = *(const PG8_LAS i32x4*)(lds + PG8_SB(b, h) + boffk[k] + n * 2048); \
        dst[n * 8 + k * 4 + 0] = t_[0]; dst[n * 8 + k * 4 + 1] = t_[1]; dst[n * 8 + k * 4 + 2] = t_[2]; dst[n * 8 + k * 4 + 3] = t_[3]; } } while (0)
#define PG8_MMA(ai, bj, At, Bt) do { __builtin_amdgcn_s_setprio(1); \
        { f32x4 c_ = __builtin_shufflevector(accv[ai][bj], accv[ai][bj], 0, 1, 2, 3); c_ = __builtin_amdgcn_mfma_scale_f32_16x16x128_f8f6f4(__builtin_shufflevector(Bt, Bt, 0, 1, 2, 3, 4, 5, 6, 7), __builtin_shufflevector(At, At, 0, 1, 2, 3, 4, 5, 6, 7), c_, 0, 0, 0, 0, 0, 0); accv[ai][bj] = __builtin_shufflevector(accv[ai][bj], __builtin_shufflevector(c_, c_, 0, 1, 2, 3, -1, -1, -1, -1, -1, -1, -1, -1, -1, -1, -1, -1, -1, -1, -1, -1, -1, -1, -1, -1, -1, -1, -1, -1, -1, -1, -1, -1), 32, 33, 34, 35, 4, 5, 6, 7, 8, 9, 10, 11, 12, 13, 14, 15, 16, 17, 18, 19, 20, 21, 22, 23, 24, 25, 26, 27, 28, 29, 30, 31); } \
        { f32x4 c_ = __builtin_shufflevector(accv[ai][bj], accv[ai][bj], 4, 5, 6, 7); c_ = __builtin_amdgcn_mfma_scale_f32_16x16x128_f8f6f4(__builtin_shufflevector(Bt, Bt, 8, 9, 10, 11, 12, 13, 14, 15), __builtin_shufflevector(At, At, 0, 1, 2, 3, 4, 5, 6, 7), c_, 0, 0, 0, 0, 0, 0); accv[ai][bj] = __builtin_shufflevector(accv[ai][bj], __builtin_shufflevector(c_, c_, 0, 1, 2, 3, -1, -1, -1, -1, -1, -1, -1, -1, -1, -1, -1, -1, -1, -1, -1, -1, -1, -1, -1, -1, -1, -1, -1, -1, -1, -1, -1, -1), 0, 1, 2, 3, 32, 33, 34, 35, 8, 9, 10, 11, 12, 13, 14, 15, 16, 17, 18, 19, 20, 21, 22, 23, 24, 25, 26, 27, 28, 29, 30, 31); } \
        { f32x4 c_ = __builtin_shufflevector(accv[ai][bj], accv[ai][bj], 8, 9, 10, 11); c_ = __builtin_amdgcn_mfma_scale_f32_16x16x128_f8f6f4(__builtin_shufflevector(Bt, Bt, 0, 1, 2, 3, 4, 5, 6, 7), __builtin_shufflevector(At, At, 8, 9, 10, 11, 12, 13, 14, 15), c_, 0, 0, 0, 0, 0, 0); accv[ai][bj] = __builtin_shufflevector(accv[ai][bj], __builtin_shufflevector(c_, c_, 0, 1, 2, 3, -1, -1, -1, -1, -1, -1, -1, -1, -1, -1, -1, -1, -1, -1, -1, -1, -1, -1, -1, -1, -1, -1, -1, -1, -1, -1, -1, -1), 0, 1, 2, 3, 4, 5, 6, 7, 32, 33, 34, 35, 12, 13, 14, 15, 16, 17, 18, 19, 20, 21, 22, 23, 24, 25, 26, 27, 28, 29, 30, 31); } \
        { f32x4 c_ = __builtin_shufflevector(accv[ai][bj], accv[ai][bj], 12, 13, 14, 15); c_ = __builtin_amdgcn_mfma_scale_f32_16x16x128_f8f6f4(__builtin_shufflevector(Bt, Bt, 8, 9, 10, 11, 12, 13, 14, 15), __builtin_shufflevector(At, At, 8, 9, 10, 11, 12, 13, 14, 15), c_, 0, 0, 0, 0, 0, 0); accv[ai][bj] = __builtin_shufflevector(accv[ai][bj], __builtin_shufflevector(c_, c_, 0, 1, 2, 3, -1, -1, -1, -1, -1, -1, -1, -1, -1, -1, -1, -1, -1, -1, -1, -1, -1, -1, -1, -1, -1, -1, -1, -1, -1, -1, -1, -1), 0, 1, 2, 3, 4, 5, 6, 7, 8, 9, 10, 11, 32, 33, 34, 35, 16, 17, 18, 19, 20, 21, 22, 23, 24, 25, 26, 27, 28, 29, 30, 31); } \
        { f32x4 c_ = __builtin_shufflevector(accv[ai][bj], accv[ai][bj], 16, 17, 18, 19); c_ = __builtin_amdgcn_mfma_scale_f32_16x16x128_f8f6f4(__builtin_shufflevector(Bt, Bt, 0, 1, 2, 3, 4, 5, 6, 7), __builtin_shufflevector(At, At, 16, 17, 18, 19, 20, 21, 22, 23), c_, 0, 0, 0, 0, 0, 0); accv[ai][bj] = __builtin_shufflevector(accv[ai][bj], __builtin_shufflevector(c_, c_, 0, 1, 2, 3, -1, -1, -1, -1, -1, -1, -1, -1, -1, -1, -1, -1, -1, -1, -1, -1, -1, -1, -1, -1, -1, -1, -1, -1, -1, -1, -1, -1), 0, 1, 2, 3, 4, 5, 6, 7, 8, 9, 10, 11, 12, 13, 14, 15, 32, 33, 34, 35, 20, 21, 22, 23, 24, 25, 26, 27, 28, 29, 30, 31); } \
        { f32x4 c_ = __builtin_shufflevector(accv[ai][bj], accv[ai][bj], 20, 21, 22, 23); c_ = __builtin_amdgcn_mfma_scale_f32_16x16x128_f8f6f4(__builtin_shufflevector(Bt, Bt, 8, 9, 10, 11, 12, 13, 14, 15), __builtin_shufflevector(At, At, 16, 17, 18, 19, 20, 21, 22, 23), c_, 0, 0, 0, 0, 0, 0); accv[ai][bj] = __builtin_shufflevector(accv[ai][bj], __builtin_shufflevector(c_, c_, 0, 1, 2, 3, -1, -1, -1, -1, -1, -1, -1, -1, -1, -1, -1, -1, -1, -1, -1, -1, -1, -1, -1, -1, -1, -1, -1, -1, -1, -1, -1, -1), 0, 1, 2, 3, 4, 5, 6, 7, 8, 9, 10, 11, 12, 13, 14, 15, 16, 17, 18, 19, 32, 33, 34, 35, 24, 25, 26, 27, 28, 29, 30, 31); } \
        { f32x4 c_ = __builtin_shufflevector(accv[ai][bj], accv[ai][bj], 24, 25, 26, 27); c_ = __builtin_amdgcn_mfma_scale_f32_16x16x128_f8f6f4(__builtin_shufflevector(Bt, Bt, 0, 1, 2, 3, 4, 5, 6, 7), __builtin_shufflevector(At, At, 24, 25, 26, 27, 28, 29, 30, 31), c_, 0, 0, 0, 0, 0, 0); accv[ai][bj] = __builtin_shufflevector(accv[ai][bj], __builtin_shufflevector(c_, c_, 0, 1, 2, 3, -1, -1, -1, -1, -1, -1, -1, -1, -1, -1, -1, -1, -1, -1, -1, -1, -1, -1, -1, -1, -1, -1, -1, -1, -1, -1, -1, -1), 0, 1, 2, 3, 4, 5, 6, 7, 8, 9, 10, 11, 12, 13, 14, 15, 16, 17, 18, 19, 20, 21, 22, 23, 32, 33, 34, 35, 28, 29, 30, 31); } \
        { f32x4 c_ = __builtin_shufflevector(accv[ai][bj], accv[ai][bj], 28, 29, 30, 31); c_ = __builtin_amdgcn_mfma_scale_f32_16x16x128_f8f6f4(__builtin_shufflevector(Bt, Bt, 8, 9, 10, 11, 12, 13, 14, 15), __builtin_shufflevector(At, At, 24, 25, 26, 27, 28, 29, 30, 31), c_, 0, 0, 0, 0, 0, 0); accv[ai][bj] = __builtin_shufflevector(accv[ai][bj], __builtin_shufflevector(c_, c_, 0, 1, 2, 3, -1, -1, -1, -1, -1, -1, -1, -1, -1, -1, -1, -1, -1, -1, -1, -1, -1, -1, -1, -1, -1, -1, -1, -1, -1, -1, -1, -1), 0, 1, 2, 3, 4, 5, 6, 7, 8, 9, 10, 11, 12, 13, 14, 15, 16, 17, 18, 19, 20, 21, 22, 23, 24, 25, 26, 27, 32, 33, 34, 35); } \
        __builtin_amdgcn_s_setprio(0); } while (0)
#define PG8_WAIT_V(n) asm volatile("s_waitcnt vmcnt(" #n ")" ::: "memory")
#define PG8_WAIT_L(n) asm volatile("s_waitcnt lgkmcnt(" #n ")" ::: "memory")
#define PG8_BAR __builtin_amdgcn_s_barrier()
#define PG8_SCHED __builtin_amdgcn_sched_barrier(0)
    Unit cur, nxt; int ui = 0;
    if (!S.next(0, cur)) return;
    f32x32 accv[2][2];
#pragma unroll
    for (int a = 0; a < 2; ++a)
#pragma unroll
        for (int b = 0; b < 2; ++b) accv[a][b] = f32x32{};
    i32x32 At; i32x16 B0, B1;
    const char* cA = (const char*)g.A + (size_t)cur.pm * tstep; const char* cB = (const char*)g.Bt + (size_t)cur.pn * tstep;
    S.a_ready(cur);
    PG8_STAGE(PG8_SB(0, 0), cB, voffB); PG8_STAGE(PG8_SA(0, 0), cA, voffA); PG8_STAGE(PG8_SB(0, 1), cB + hstep, voffB); PG8_STAGE(PG8_SA(0, 1), cA + hstep, voffA);
    if (wr == 1) PG8_BAR;
    PG8_WAIT_V(4); PG8_BAR;
    PG8_STAGE(PG8_SB(1, 0), cB + kstep, voffB); PG8_STAGE(PG8_SA(1, 0), cA + kstep, voffA); PG8_STAGE(PG8_SB(1, 1), cB + hstep + kstep, voffB);
    PG8_WAIT_V(6); PG8_BAR;
    PG8_STAMP();
    for (;;) {
        const bool has_next = S.next(ui + 1, nxt);
        const char* nA = has_next ? (const char*)g.A + (size_t)nxt.pm * tstep : cA; const char* nB = has_next ? (const char*)g.Bt + (size_t)nxt.pn * tstep : cB;
        for (int t = 0; t < nt; t += 2) {
            const bool last = (t == nt - 2);
            const char* a1 = cA + (size_t)(t + 1) * kstep;
            const char* a2 = last ? nA : cA + (size_t)(t + 2) * kstep; const char* b2 = last ? nB : cB + (size_t)(t + 2) * kstep;
            const char* a3 = a2 + kstep; const char* b3 = b2 + kstep;
            if (last && has_next) S.a_ready(nxt);
            PG8_LDB(B0, 0, 0); PG8_SCHED; PG8_LDA(At, 0, 0); PG8_STAGE(PG8_SA(1, 1), a1 + hstep, voffA);
            PG8_WAIT_L(8); PG8_BAR; PG8_WAIT_L(0); PG8_MMA(0, 0, At, B0); PG8_BAR; PG8_SCHED;
            PG8_LDB(B1, 0, 1); PG8_STAGE(PG8_SB(0, 0), b2, voffB);
            PG8_BAR; PG8_WAIT_L(0); PG8_MMA(0, 1, At, B1); PG8_BAR;
            PG8_LDA(At, 0, 1); PG8_STAGE(PG8_SA(0, 0), a2, voffA);
            PG8_BAR; PG8_WAIT_L(0); PG8_MMA(1, 0, At, B0); PG8_BAR; PG8_SCHED;
            PG8_STAGE(PG8_SB(0, 1), b2 + hstep, voffB);
            PG8_WAIT_V(6); PG8_BAR; PG8_MMA(1, 1, At, B1); PG8_BAR;
            PG8_LDB(B0, 1, 0); PG8_SCHED; PG8_LDA(At, 1, 0); PG8_STAGE(PG8_SA(0, 1), a2 + hstep, voffA);
            PG8_WAIT_L(8); PG8_BAR; PG8_WAIT_L(0); PG8_MMA(0, 0, At, B0); PG8_BAR; PG8_SCHED;
            PG8_LDB(B1, 1, 1); PG8_STAGE(PG8_SB(1, 0), b3, voffB);
            PG8_BAR; PG8_WAIT_L(0); PG8_MMA(0, 1, At, B1); PG8_BAR;
            PG8_LDA(At, 1, 1); PG8_STAGE(PG8_SA(1, 0), a3, voffA);
            PG8_BAR; PG8_WAIT_L(0); PG8_MMA(1, 0, At, B0); PG8_BAR; PG8_SCHED;
            PG8_STAGE(PG8_SB(1, 1), b3 + hstep, voffB);
            PG8_WAIT_V(6); PG8_BAR; PG8_MMA(1, 1, At, B1); PG8_BAR;
        }
        PG8_STAMP();
        if constexpr (!Epi::AFTER_DRAIN) { f32x4 acc[2][2][4][2];
#pragma unroll
            for (int a = 0; a < 2; ++a)
#pragma unroll
                for (int b = 0; b < 2; ++b)
#pragma unroll
                    for (int m = 0; m < 4; ++m)
#pragma unroll
                        for (int n = 0; n < 2; ++n) { const int q_ = 4 * (m * 2 + n); acc[a][b][m][n] = (f32x4){accv[a][b][q_], accv[a][b][q_ + 1], accv[a][b][q_ + 2], accv[a][b][q_ + 3]}; }
            E(acc, cur, wr, wc, fr, fq); S.done(cur); }
        PG8_STAMP();
        if (!has_next) break;
#pragma unroll
        for (int a = 0; a < 2; ++a)
#pragma unroll
            for (int b = 0; b < 2; ++b) accv[a][b] = f32x32{};
        cur = nxt; cA = nA; cB = nB; ++ui;
    }
    PG8_WAIT_V(0);
    if (wr == 0) PG8_BAR;
    PG8_BAR;
    static_assert(!Epi::AFTER_DRAIN, "no fused epilogues in the fp8 body");
    PG8_STAMP();
    if (STAMP && wid == 0) { stamps[lane] = lane < nts ? (((unsigned long long)(unsigned)ts_hi << 32) | (unsigned)ts_lo) : 0ull;
        if (lane == 62) stamps[62] = rt_entry; if (lane == 63) stamps[63] = (unsigned long long)wall_clock64(); }
#undef PG8_STAMP
#undef PG8_SA
#undef PG8_SB
#undef PG8_STAGE
#undef PG8_LDA
#undef PG8_LDB
#undef PG8_MMA
#undef PG8_WAIT_V
#undef PG8_WAIT_L
#undef PG8_BAR
#undef PG8_SCHED
}

}

#define XB_TMO      128
#define XB_XCNT(j)  (256  + 64 * (j))
#define XB_XSUB(j)  (1280 + 64 * (j))
#define XB_XGEN(j)  (2304 + 64 * (j))
#define XB_TOP      3328
#define XB_TOPGEN   3392
#define XCD_BAR_WORDS 3456
#define XB_SPIN_CAP (1u << 18)
#define LAS __attribute__((address_space(3)))

__device__ __forceinline__ unsigned xb_ld(unsigned* p)              { return __hip_atomic_load(p, __ATOMIC_RELAXED, __HIP_MEMORY_SCOPE_AGENT); }
__device__ __forceinline__ unsigned xb_add(unsigned* p, unsigned v) { return __hip_atomic_fetch_add(p, v, __ATOMIC_RELAXED, __HIP_MEMORY_SCOPE_AGENT); }
__device__ __forceinline__ unsigned xb_xcc_id() { return (unsigned)__builtin_amdgcn_s_getreg((3 << 11) | 20) & 0xFu; }
#define XB_SPIN(cond, bar) do { unsigned _sp = 0; while (cond) { __builtin_amdgcn_s_sleep(1); \
    if ((++_sp & 255u) == 0u) { if (xb_ld(&(bar)[XB_TMO])) break; if (_sp > XB_SPIN_CAP) { atomicAdd(&(bar)[XB_TMO], 1u); break; } } } } while (0)

struct XcdBarrier {
    unsigned* bar; unsigned x; unsigned G;
    volatile LAS unsigned* st;
};

__device__ __forceinline__ XcdBarrier xcd_barrier_post(unsigned* bar, volatile LAS unsigned* st, bool t0  ) {
    XcdBarrier b; b.bar = bar; b.x = xb_xcc_id(); b.st = st; b.G = 0u;
    if (t0) (void)xb_add(&bar[XB_XCNT(b.x)], 1u);
    return b;
}
__device__ __forceinline__ void xcd_barrier_complete(unsigned* bar, unsigned x, unsigned G, unsigned& nloc, unsigned& nx) {
    unsigned sum, cnt, mine, sp = 0u;
    for (;;) {
        sum = 0u; cnt = 0u; mine = 0u;
#pragma unroll
        for (unsigned j = 0; j < 16; ++j) { const unsigned c = xb_ld(&bar[XB_XCNT(j)]); sum += c; cnt += (c > 0u) ? 1u : 0u; mine = (j == x) ? c : mine; }
        if (sum == G) break;
        __builtin_amdgcn_s_sleep(1);
        if ((++sp & 255u) == 0u) { if (xb_ld(&bar[XB_TMO])) break; if (sp > XB_SPIN_CAP) { atomicAdd(&bar[XB_TMO], 1u); break; } }
    }
    nloc = mine > 0u ? mine : 1u; nx = cnt > 0u ? cnt : 1u;
}

__device__ __forceinline__ void xcd_barrier(const XcdBarrier& b, bool t0  ) {
    asm volatile("s_waitcnt vmcnt(0)" ::: "memory");
    __syncthreads();
    if (t0) {
        unsigned* bar = b.bar;
        __builtin_amdgcn_s_waitcnt(0);
        unsigned nloc = b.st[0], nx = b.st[1];
        if (nloc == 0u) { xcd_barrier_complete(bar, b.x, b.G, nloc, nx); b.st[0] = nloc; b.st[1] = nx; }
        const unsigned old = xb_add(&bar[XB_XSUB(b.x)], 1u);
        const unsigned gen = old / nloc;
        if (old + 1u == (gen + 1u) * nloc) {
            __builtin_amdgcn_fence(__ATOMIC_RELEASE, "agent");
            asm volatile("s_waitcnt vmcnt(0)" ::: "memory");
            const unsigned og = xb_add(&bar[XB_TOP], 1u);
            const unsigned tg = og / nx;
            if (og + 1u == (tg + 1u) * nx) xb_add(&bar[XB_TOPGEN], 1u);
            else XB_SPIN(xb_ld(&bar[XB_TOPGEN]) == tg, bar);
            __builtin_amdgcn_fence(__ATOMIC_ACQUIRE, "agent");
            xb_add(&bar[XB_XGEN(b.x)], 1u);
            asm volatile("s_waitcnt vmcnt(0)" ::: "memory");
        } else {
            XB_SPIN(xb_ld(&bar[XB_XGEN(b.x)]) == gen, bar);
            __builtin_amdgcn_fence(__ATOMIC_ACQUIRE, "agent");
            asm volatile("s_waitcnt vmcnt(0)" ::: "memory");
        }
    }
    __syncthreads();
}


namespace mk {
typedef unsigned short bf16_t;
typedef short bf16x8 __attribute__((ext_vector_type(8)));
typedef short s16x4 __attribute__((ext_vector_type(4)));
typedef float f32x16 __attribute__((ext_vector_type(16)));
typedef float f32x4 __attribute__((ext_vector_type(4)));
typedef unsigned u32x4 __attribute__((ext_vector_type(4)));
typedef unsigned u32x2 __attribute__((ext_vector_type(2)));
typedef __bf16 bf2 __attribute__((ext_vector_type(2)));
typedef float f32x16v __attribute__((ext_vector_type(16)));
typedef float f32x32v __attribute__((ext_vector_type(32)));
typedef unsigned u32x6 __attribute__((ext_vector_type(6)));
typedef _Float16 h16x32 __attribute__((ext_vector_type(32)));
typedef _Float16 h16x2 __attribute__((ext_vector_type(2)));

constexpr int TT = 16384, T = 8192, S = 2048, NB = 4, DM = 4096, NIN = 10560, NINP = 10752, NH = 8, NEXP = 16384;
constexpr float EPS = 1e-6f;
constexpr float O8_SCALE = 32.0f, WOUT8_SCALE = 2048.0f;
constexpr float HN8_SCALE = 16.0f, WIN8_SCALE = 2048.0f;
constexpr float U_SCALE = 128.0f, V_SCALE = 5.656854249f;
constexpr int NWAVES = 8, NTHR = 512;
constexpr int LDS_BYTES = 143360;
constexpr int LDS_XB = 131072;
constexpr int LDS_G1X = 131072 + 1024;

constexpr size_t SZ_WIN = (size_t)NINP * DM * 2, SZ_WOUT = (size_t)DM * DM * 2, SZ_W2 = (size_t)2048 * DM * 2, SZ_WUQ = (size_t)1536 * 768 * 2, SZ_WUKV = (size_t)2048 * 512 * 2,
                 SZ_TAB = (size_t)NEXP * 3072;
constexpr size_t LW_WIN = 0, LW_WOUT = LW_WIN + SZ_WIN, LW_W2 = LW_WOUT + SZ_WOUT, LW_WUQ = LW_W2 + SZ_W2, LW_WUKV = LW_WUQ + SZ_WUQ, LW_U = LW_WUKV + SZ_WUKV, LW_V = LW_U + SZ_TAB,
                 LW_END = LW_V + SZ_TAB;
constexpr size_t WS_CTL = 0, WS_SSQ = 65536, WS_W = 65536 + 2 * 65536;
constexpr size_t WS_HN = WS_W + 2 * LW_END, SZ_HN = (size_t)T * DM * 2, WS_P = WS_HN + SZ_HN, SZ_P = (size_t)T * NINP * 2;
constexpr size_t SZ_H1 = (size_t)T * 1024 * 2;
constexpr size_t WS_QKV = WS_P + SZ_P;
constexpr size_t QO_QA = 0, QO_KA = SZ_H1, QO_VA = 2 * SZ_H1, QO_QB = 3 * SZ_H1, QO_KB = 4 * SZ_H1, QO_VB = 5 * SZ_H1, QO_QC = 6 * SZ_H1, QO_KC = 7 * SZ_H1, QO_VC = 8 * SZ_H1,
                 QO_QD = 9 * SZ_H1, SZ_QD = (size_t)T * 1536 * 2, QO_KD = QO_QD + SZ_QD, QO_VD = QO_KD + SZ_QD, SZ_QKV = QO_VD + SZ_H1;
constexpr size_t WS_O = WS_QKV + SZ_QKV, SZ_O = (size_t)T * DM * 2, WS_T2 = WS_O + SZ_O, SZ_T2 = (size_t)2 * T * 1024 * 4, WS_END = WS_T2 + SZ_T2;
constexpr size_t SZ_F1 = (size_t)T * 1024 * 4;
constexpr size_t PO_OA = 0, PO_OB = 2 * SZ_H1, PO_LSE = 5 * SZ_H1, SZ_LSE = (size_t)3 * T * 8 * 4;
static_assert(PO_LSE + SZ_LSE <= SZ_P, "P alias");
constexpr size_t PO_SC = 0, SZ_SC = (size_t)T * 2048 * 4, PO_EXP = SZ_SC, SZ_EG = (size_t)T * 128 * 4, PO_GATE = PO_EXP + SZ_EG;
static_assert(PO_GATE + SZ_EG <= SZ_P, "P alias 2");
constexpr size_t OO_QRAW = 0, OO_KVRAW = (size_t)T * 1536 * 2;
static_assert(OO_KVRAW + (size_t)T * 2048 * 2 <= SZ_O, "O alias");
constexpr size_t TO_HN8 = 0;
constexpr size_t TO_CQ = 0, TO_CKV = (size_t)T * 768 * 2;
constexpr size_t ACT_SZ = WS_END - WS_HN, WS_TOTAL = WS_HN + 2 * ACT_SZ;
constexpr size_t TO_OC = 0, TO_OD = SZ_F1;

struct Args { const float* in[20]; float* out; unsigned char* ws; };
enum { I_X = 0, I_GMIX, I_WIN, I_WOUT, I_DLAM, I_DGQK, I_DGOUT, I_DILG, I_NAG, I_RPB, I_GCQ, I_GCKV, I_WUQ, I_WUKV, I_MLAG, I_GFFN, I_PWQ, I_PSK, I_PU, I_PV };

struct Frame {
    const Args* a; float* out; unsigned char* ws; LAS unsigned char* lds;
    int tid, lane, wid;
    int rank, nwg;
};

#ifdef MK_XCDSPLIT
__device__ __forceinline__ int sid() { return ((int)blockIdx.x >> 2) & 1; }
__device__ __forceinline__ int wg_rank() { return (((int)blockIdx.x >> 3) << 2) | ((int)blockIdx.x & 3); }
#else
__device__ __forceinline__ int sid() { return ((int)blockIdx.x >> 3) & 1; }
__device__ __forceinline__ int wg_rank() { return (((int)blockIdx.x >> 4) << 3) | ((int)blockIdx.x & 7); }
#endif
__device__ __forceinline__ int wg_count() { return (int)gridDim.x >> 1; }

#define MK_DPP_ADD(v, ctrl) v += __int_as_float(__builtin_amdgcn_update_dpp(0, __float_as_int(v), ctrl, 0xF, 0xF, true))
__device__ __forceinline__ float wave_total(float v) {
    MK_DPP_ADD(v, 0xB1); MK_DPP_ADD(v, 0x4E); MK_DPP_ADD(v, 0x141); MK_DPP_ADD(v, 0x140);
    const int vi = __float_as_int(v);
    return (__int_as_float(__builtin_amdgcn_readlane(vi, 0)) + __int_as_float(__builtin_amdgcn_readlane(vi, 16))) + (__int_as_float(__builtin_amdgcn_readlane(vi, 32)) + __int_as_float(__builtin_amdgcn_readlane(vi, 48)));
}
__device__ __forceinline__ float wsum(float v) { return wave_total(v); }
__device__ __forceinline__ float sum4(float v) { MK_DPP_ADD(v, 0xB1); MK_DPP_ADD(v, 0x4E); return v; }
__device__ __forceinline__ float sum8(float v) { MK_DPP_ADD(v, 0xB1); MK_DPP_ADD(v, 0x4E); MK_DPP_ADD(v, 0x141); return v; }
__device__ __forceinline__ unsigned pk_bf16(float lo, float hi) { unsigned r; asm volatile("v_cvt_pk_bf16_f32 %0, %1, %2" : "=v"(r) : "v"(lo), "v"(hi)); return r; }
__device__ __forceinline__ unsigned pk_fp8x4(float a, float b, float c, float d) {
    a = fminf(fmaxf(a, -448.f), 448.f); b = fminf(fmaxf(b, -448.f), 448.f); c = fminf(fmaxf(c, -448.f), 448.f); d = fminf(fmaxf(d, -448.f), 448.f);
    int p = 0; p = __builtin_amdgcn_cvt_pk_fp8_f32(a, b, p, false); p = __builtin_amdgcn_cvt_pk_fp8_f32(c, d, p, true); return (unsigned)p; }
__device__ __forceinline__ float bf_lo(unsigned w) { return __uint_as_float(w << 16); }
__device__ __forceinline__ float bf_hi(unsigned w) { return __uint_as_float(w & 0xffff0000u); }

template <bool F8> __device__ __forceinline__ void transpose_tile4(const Frame& F, const float* __restrict__ src, int N, int K, bf16_t* __restrict__ dst, const float* __restrict__ gain, int k0, int n0) {
    LAS float* tile = (LAS float*)F.lds;
    const int r = F.tid >> 4, c4 = F.tid & 15;
    f32x4 v[8]; float g[8];
#pragma unroll
    for (int i = 0; i < 8; ++i) { const int k = r + 32 * i; v[i] = *(const f32x4*)(src + (size_t)(k0 + k) * N + n0 + c4 * 4); g[i] = gain ? gain[k0 + k] : 1.0f; }
#pragma unroll
    for (int i = 0; i < 8; ++i) { const int k = r + 32 * i;
        tile[k * 65 + c4 * 4 + 0] = v[i][0] * g[i]; tile[k * 65 + c4 * 4 + 1] = v[i][1] * g[i]; tile[k * 65 + c4 * 4 + 2] = v[i][2] * g[i]; tile[k * 65 + c4 * 4 + 3] = v[i][3] * g[i]; }
    __syncthreads();
    const int n = F.tid >> 3, k8 = F.tid & 7;
#pragma unroll
    for (int q = 0; q < 4; ++q) { float e[8];
#pragma unroll
        for (int j = 0; j < 8; ++j) e[j] = tile[(q * 64 + k8 * 8 + j) * 65 + n];
        if (F8) { u32x2 w; w.x = pk_fp8x4(e[0] * 2048.0f, e[1] * 2048.0f, e[2] * 2048.0f, e[3] * 2048.0f); w.y = pk_fp8x4(e[4] * 2048.0f, e[5] * 2048.0f, e[6] * 2048.0f, e[7] * 2048.0f);
            *(u32x2*)((unsigned char*)dst + (size_t)(n0 + n) * K + k0 + q * 64 + k8 * 8) = w; }
        else { u32x4 w; w.x = pk_bf16(e[0], e[1]); w.y = pk_bf16(e[2], e[3]); w.z = pk_bf16(e[4], e[5]); w.w = pk_bf16(e[6], e[7]);
            *(u32x4*)(dst + (size_t)(n0 + n) * K + k0 + q * 64 + k8 * 8) = w; } }
    __syncthreads();
}

struct TDesc { const float* src; const float* gain; unsigned char* dst; int N, K, k0, n0, f8; };
__device__ __forceinline__ TDesc t_decode(const Frame& F, int u) {
    constexpr int N_WIN = 16 * 165, N_WOUT = 16 * 64, N_UQ = 3 * 24, N_UKV = 2 * 32, N_L = N_WIN + N_WOUT + N_UQ + N_UKV;
    const int l = u / N_L; int r = u % N_L; unsigned char* lw = F.a->ws + WS_W + (size_t)l * LW_END; TDesc d;
    if (r < N_WIN) { d.src = F.a->in[I_WIN] + (size_t)l * DM * NIN; d.gain = F.a->in[I_GMIX] + l * DM; d.dst = lw + LW_WIN; d.N = NIN; d.K = DM; d.k0 = (r & 15) * 256; d.n0 = (r >> 4) * 64; d.f8 = 1; return d; }
    r -= N_WIN;
    if (r < N_WOUT) { d.src = F.a->in[I_WOUT] + (size_t)l * DM * DM; d.gain = nullptr; d.dst = lw + LW_WOUT; d.N = DM; d.K = DM; d.k0 = (r & 15) * 256; d.n0 = (r >> 4) * 64; d.f8 = 1; return d; }
    r -= N_WOUT;
    if (r < N_UQ) { d.src = F.a->in[I_WUQ] + (size_t)l * 768 * 1536; d.gain = F.a->in[I_GCQ] + l * 768; d.dst = lw + LW_WUQ; d.N = 1536; d.K = 768; d.k0 = (r % 3) * 256; d.n0 = (r / 3) * 64; d.f8 = 0; return d; }
    r -= N_UQ;
    d.src = F.a->in[I_WUKV] + (size_t)l * 512 * 2048; d.gain = F.a->in[I_GCKV] + l * 512; d.dst = lw + LW_WUKV; d.N = 2048; d.K = 512; d.k0 = (r & 1) * 256; d.n0 = (r >> 1) * 64; d.f8 = 0; return d;
}
#define MK_TLOAD(d, v, g) do { const int r_ = F.tid >> 4, c4_ = F.tid & 15; _Pragma("unroll") for (int i = 0; i < 8; ++i) { const int k_ = r_ + 32 * i; \
        v[i] = *(const f32x4*)(d.src + (size_t)(d.k0 + k_) * d.N + d.n0 + c4_ * 4); g[i] = d.gain ? d.gain[d.k0 + k_] : 1.0f; } } while (0)
#define MK_TFIN(d, v, g) do { LAS float* tile = (LAS float*)F.lds; const int r_ = F.tid >> 4, c4_ = F.tid & 15; \
        _Pragma("unroll") for (int i = 0; i < 8; ++i) { const int k_ = r_ + 32 * i; \
            tile[k_ * 65 + c4_ * 4 + 0] = v[i][0] * g[i]; tile[k_ * 65 + c4_ * 4 + 1] = v[i][1] * g[i]; tile[k_ * 65 + c4_ * 4 + 2] = v[i][2] * g[i]; tile[k_ * 65 + c4_ * 4 + 3] = v[i][3] * g[i]; } \
        __syncthreads(); \
        const int n_ = F.tid >> 3, k8_ = F.tid & 7; \
        _Pragma("unroll") for (int q = 0; q < 4; ++q) { float e[8]; \
            _Pragma("unroll") for (int j = 0; j < 8; ++j) e[j] = tile[(q * 64 + k8_ * 8 + j) * 65 + n_]; \
            if (d.f8) { u32x2 w; w.x = pk_fp8x4(e[0] * 2048.0f, e[1] * 2048.0f, e[2] * 2048.0f, e[3] * 2048.0f); w.y = pk_fp8x4(e[4] * 2048.0f, e[5] * 2048.0f, e[6] * 2048.0f, e[7] * 2048.0f);     \
                *(u32x2*)(d.dst + (size_t)(d.n0 + n_) * d.K + d.k0 + q * 64 + k8_ * 8) = w; } \
            else { u32x4 w; w.x = pk_bf16(e[0], e[1]); w.y = pk_bf16(e[2], e[3]); w.z = pk_bf16(e[4], e[5]); w.w = pk_bf16(e[6], e[7]); \
                *(u32x4*)((bf16_t*)d.dst + (size_t)(d.n0 + n_) * d.K + d.k0 + q * 64 + k8_ * 8) = w; } } \
        __syncthreads(); } while (0)
__device__ __forceinline__ void p0_transpose_range(const Frame& F, int u0, int u1, int rank, int nwg) {
    int u = u0 + rank; if (u >= u1) return;
    TDesc a = t_decode(F, u), b = a; f32x4 va[8], vb[8]; float ga[8], gb[8];
    MK_TLOAD(a, va, ga);
    for (; u < u1; u += 2 * nwg) {
        const bool hb = u + nwg < u1; if (hb) { b = t_decode(F, u + nwg); MK_TLOAD(b, vb, gb); }
        MK_TFIN(a, va, ga);
        const bool ha = u + 2 * nwg < u1; if (ha) { a = t_decode(F, u + 2 * nwg); MK_TLOAD(a, va, ga); }
        if (hb) MK_TFIN(b, vb, gb);
    }
}
#undef MK_TLOAD
#undef MK_TFIN

__device__ __forceinline__ void p0_w2t(const Frame& F, int rank, int nwg) {
    {
        LAS float* SK = (LAS float*)F.lds;
        LAS float* WQ = (LAS float*)(F.lds + 65536);
        for (int u = rank; u < 2 * 16 * 64; u += nwg) {
            const int l = u >> 10, hc = (u >> 6) & 15, k0 = (u & 63) * 64;
            const float* sk = F.a->in[I_PSK] + (size_t)(l * 16 + hc) * 128 * 128;
            const float* wq = F.a->in[I_PWQ] + (size_t)l * DM * 2048 + (size_t)k0 * 2048 + hc * 128;
#pragma unroll
            for (int i = 0; i < 8; ++i) { const int idx = F.tid + NTHR * i, row = idx >> 5, c4 = idx & 31; *(LAS f32x4*)(SK + row * 128 + c4 * 4) = *(const f32x4*)(sk + row * 128 + c4 * 4); }
#pragma unroll
            for (int i = 0; i < 4; ++i) { const int idx = F.tid + NTHR * i, row = idx >> 5, c4 = idx & 31; *(LAS f32x4*)(WQ + row * 132 + c4 * 4) = *(const f32x4*)(wq + (size_t)row * 2048 + c4 * 4); }
            __syncthreads();
            const int k = F.lane, ng = F.wid;
            float acc[16];
#pragma unroll
            for (int j = 0; j < 16; ++j) acc[j] = 0.f;
            for (int d4 = 0; d4 < 32; ++d4) { const f32x4 w = *(const LAS f32x4*)(WQ + k * 132 + d4 * 4);
#pragma unroll
                for (int j = 0; j < 16; ++j) { const f32x4 s = *(const LAS f32x4*)(SK + (ng * 16 + j) * 128 + d4 * 4); acc[j] += w[0] * s[0] + w[1] * s[1] + w[2] * s[2] + w[3] * s[3]; } }
            const float g = F.a->in[I_GFFN][l * DM + k0 + k];
            bf16_t* w2 = (bf16_t*)(F.a->ws + WS_W + (size_t)l * LW_END + LW_W2);
#pragma unroll
            for (int j = 0; j < 16; ++j) w2[(size_t)(hc * 128 + ng * 16 + j) * DM + k0 + k] = (bf16_t)(pk_bf16(acc[j] * g, 0.f) & 0xffffu);
            __syncthreads();
        }
    }
}

__device__ __forceinline__ void p0_a(const Frame& F) {
    constexpr int N_WIN = 16 * 165;
    p0_transpose_range(F, 0, N_WIN, (int)blockIdx.x, (int)gridDim.x);
    for (int i = (int)blockIdx.x * NTHR + F.tid; i < 2 * 192 * DM / 16; i += (int)gridDim.x * NTHR) { const int l = i / (192 * DM / 16), o = i % (192 * DM / 16);
        *(u32x4*)(F.a->ws + WS_W + (size_t)l * LW_END + LW_WIN + (size_t)NIN * DM + (size_t)o * 16) = (u32x4){0u, 0u, 0u, 0u}; }
}

__device__ __forceinline__ void p0_b(const Frame& F, int rank, int nwg) {
    constexpr int N_WIN = 16 * 165, N_WOUT = 16 * 64, N_UQ = 3 * 24, N_UKV = 2 * 32, N_L = N_WIN + N_WOUT + N_UQ + N_UKV;
    p0_transpose_range(F, N_WIN, 2 * N_L, rank, nwg);
    {
        constexpr size_t NIT = (size_t)NEXP * 64;
        const size_t stride = (size_t)nwg * NTHR; const int nit = (int)((4 * NIT - (size_t)rank * NTHR + stride - 1) / stride);
        const int slot = (rank * 13) % nit; int it = 0;
        for (size_t base = (size_t)rank * NTHR; base < 4 * NIT; base += stride, ++it) {
            if (it == slot) p0_w2t(F, rank, nwg);
            const size_t i = base + F.tid;
            const int tb = (int)(i / NIT); const size_t o = i % NIT; const int l = tb >> 1, isv = tb & 1; const size_t row = o >> 6; const int ln = (int)(o & 63);
            const float* src = (isv ? F.a->in[I_PV] : F.a->in[I_PU]) + (size_t)l * NEXP * DM + row * DM + 4 * ln; const float* g = F.a->in[I_GFFN] + l * DM + 4 * ln;
            const float sc = isv ? V_SCALE : U_SCALE;
            f32x4 x[16];
#pragma unroll
            for (int c = 0; c < 16; ++c) { x[c] = *(const f32x4*)(src + c * 256); if (!isv) x[c] *= *(const f32x4*)(g + c * 256);
#pragma unroll
                for (int j = 0; j < 4; ++j) x[c][j] = fminf(fmaxf(x[c][j] * sc, -7.5f), 7.5f); }
            u32x4 w[3];
#pragma unroll
            for (int q = 0; q < 2; ++q) { f32x16v s0, s1;
#pragma unroll
                for (int c = 0; c < 8; ++c) { s0[2 * c] = x[8 * q + c][0]; s1[2 * c] = x[8 * q + c][1]; s0[2 * c + 1] = x[8 * q + c][2]; s1[2 * c + 1] = x[8 * q + c][3]; }
                const u32x6 p = __builtin_amdgcn_cvt_scalef32_2xpk16_fp6_f32(s0, s1, 1.0f);
#pragma unroll
                for (int k = 0; k < 6; ++k) w[(6 * q + k) >> 2][(6 * q + k) & 3] = p[k]; }
            unsigned char* dst = F.a->ws + WS_W + (size_t)l * LW_END + (isv ? LW_V : LW_U) + row * 3072 + ln * 48;
#pragma unroll
            for (int k = 0; k < 3; ++k) *(u32x4*)(dst + 16 * k) = w[k];
        }
    }
}

__device__ __forceinline__ void p_norm(const Frame& F, const float* __restrict__ x, bf16_t* __restrict__ hn) {
    for (int t = F.rank * NWAVES + F.wid; t < T; t += F.nwg * NWAVES) {
        const f32x4* xr = (const f32x4*)(x + (size_t)t * DM);
        f32x4 v[16]; float ss = 0.f;
#pragma unroll
        for (int i = 0; i < 16; ++i) { v[i] = xr[i * 64 + F.lane]; ss += v[i][0] * v[i][0] + v[i][1] * v[i][1] + v[i][2] * v[i][2] + v[i][3] * v[i][3]; }
        ss = wsum(ss);
        const float r = rsqrtf(ss * (1.0f / DM) + EPS);
        unsigned* o = (unsigned*)((unsigned char*)hn + (size_t)t * DM); const float r8 = r * HN8_SCALE;
#pragma unroll
        for (int i = 0; i < 16; ++i) o[i * 64 + F.lane] = pk_fp8x4(v[i][0] * r8, v[i][1] * r8, v[i][2] * r8, v[i][3] * r8);
    }
}

__device__ __forceinline__ void unpack16(const u32x4 a, const u32x4 b, float (&x)[16]) {
#pragma unroll
    for (int i = 0; i < 4; ++i) { x[2 * i] = bf_lo(a[i]); x[2 * i + 1] = bf_hi(a[i]); x[8 + 2 * i] = bf_lo(b[i]); x[8 + 2 * i + 1] = bf_hi(b[i]); }
}
__device__ __forceinline__ void p_post1(const Frame& F, int l) {
    const bf16_t* P = (const bf16_t*)(F.ws + WS_P);
    for (int t = F.rank * NWAVES + F.wid; t < T; t += F.nwg * NWAVES) {
        const bf16_t* pr = P + (size_t)t * NINP; const int lane = F.lane;
        u32x2 cq3[3]; u32x4 ckv4;
#pragma unroll
        for (int i = 0; i < 3; ++i) cq3[i] = ((const u32x2*)(pr + 9216 + lane * 12))[i];
        ckv4 = *(const u32x4*)(pr + 9984 + lane * 8);
        {
            u32x2 c[3]; float ss = 0.f;
#pragma unroll
            for (int i = 0; i < 3; ++i) { c[i] = cq3[i]; const float a0 = bf_lo(c[i].x), a1 = bf_hi(c[i].x), a2 = bf_lo(c[i].y), a3 = bf_hi(c[i].y); ss += a0 * a0 + a1 * a1 + a2 * a2 + a3 * a3; }
            ss = wsum(ss); const float r = rsqrtf(ss * (1.0f / 768) + EPS);
            u32x2* d = (u32x2*)((bf16_t*)(F.ws + WS_T2 + TO_CQ) + (size_t)t * 768 + lane * 12);
#pragma unroll
            for (int i = 0; i < 3; ++i) { u32x2 w; w.x = pk_bf16(bf_lo(c[i].x) * r, bf_hi(c[i].x) * r); w.y = pk_bf16(bf_lo(c[i].y) * r, bf_hi(c[i].y) * r); d[i] = w; }
        }
        {
            const u32x4 c = ckv4; float ss = 0.f;
#pragma unroll
            for (int i = 0; i < 4; ++i) { const float a0 = bf_lo(c[i]), a1 = bf_hi(c[i]); ss += a0 * a0 + a1 * a1; }
            ss = wsum(ss); const float r = rsqrtf(ss * (1.0f / 512) + EPS);
            u32x4 w;
#pragma unroll
            for (int i = 0; i < 4; ++i) w[i] = pk_bf16(bf_lo(c[i]) * r, bf_hi(c[i]) * r);
            *(u32x4*)((bf16_t*)(F.ws + WS_T2 + TO_CKV) + (size_t)t * 512 + lane * 8) = w;
        }
    }
}

__device__ __forceinline__ void p_post2(const Frame& F, int l) {
    const bf16_t* QR = (const bf16_t*)(F.ws + WS_O + OO_QRAW); const bf16_t* KVR = (const bf16_t*)(F.ws + WS_O + OO_KVRAW); const bf16_t* P = (const bf16_t*)(F.ws + WS_P);
    bf16_t* QD = (bf16_t*)(F.ws + WS_QKV + QO_QD); bf16_t* KD = (bf16_t*)(F.ws + WS_QKV + QO_KD); bf16_t* VD = (bf16_t*)(F.ws + WS_QKV + QO_VD);
    LAS float* L = (LAS float*)F.lds + F.wid * 3712; LAS float* q = L; LAS float* kv = L + 1536; LAS float* kr = L + 3584; LAS float* cs = L + 3648;
    const float* g0 = F.a->in[I_MLAG] + (size_t)(l * 2 + 0) * 192; const float* g1 = F.a->in[I_MLAG] + (size_t)(l * 2 + 1) * 192;
    const int lane = F.lane;
    for (int t = F.rank * NWAVES + F.wid; t < T; t += F.nwg * NWAVES) {
        const int b = t / S, s = t % S;
        float aq, akv;
        { const bf16_t* pr = P + (size_t)t * NINP; float sq = 0.f, sk = 0.f;
#pragma unroll
          for (int i = 0; i < 3; ++i) { const u32x2 c2 = ((const u32x2*)(pr + 9216 + lane * 12))[i]; const float a0 = bf_lo(c2.x), a1 = bf_hi(c2.x), a2 = bf_lo(c2.y), a3 = bf_hi(c2.y); sq += (a0 * a0 + a1 * a1) + (a2 * a2 + a3 * a3); }
          { const u32x4 c4 = *(const u32x4*)(pr + 9984 + lane * 8);
#pragma unroll
            for (int i = 0; i < 4; ++i) { const float a0 = bf_lo(c4[i]), a1 = bf_hi(c4[i]); sk += a0 * a0 + a1 * a1; } }
          aq = rsqrtf(wave_total(sq) * (1.0f / 768) + EPS); akv = rsqrtf(wave_total(sk) * (1.0f / 512) + EPS); }
#pragma unroll
        for (int i = 0; i < 3; ++i) { const int c = lane + 64 * i; const u32x4 w = *(const u32x4*)(QR + (size_t)t * 1536 + c * 8);
            *(LAS f32x4*)(q + c * 8) = (f32x4){bf_lo(w[0]), bf_hi(w[0]), bf_lo(w[1]), bf_hi(w[1])}; *(LAS f32x4*)(q + c * 8 + 4) = (f32x4){bf_lo(w[2]), bf_hi(w[2]), bf_lo(w[3]), bf_hi(w[3])}; }
#pragma unroll
        for (int i = 0; i < 4; ++i) { const int c = lane + 64 * i; const u32x4 w = *(const u32x4*)(KVR + (size_t)t * 2048 + c * 8);
            *(LAS f32x4*)(kv + c * 8) = (f32x4){bf_lo(w[0]), bf_hi(w[0]), bf_lo(w[1]), bf_hi(w[1])}; *(LAS f32x4*)(kv + c * 8 + 4) = (f32x4){bf_lo(w[2]), bf_hi(w[2]), bf_lo(w[3]), bf_hi(w[3])}; }
        u32x4 vcp[2];
#pragma unroll
        for (int i = 0; i < 2; ++i) { const int c = lane + 64 * i; vcp[i] = *(const u32x4*)(KVR + (size_t)t * 2048 + (c >> 4) * 256 + 128 + (c & 15) * 8); }
        kr[lane] = __uint_as_float(((unsigned)P[(size_t)t * NINP + 10496 + lane]) << 16);
        if (lane < 32) { const float inv = exp2f(-(float)lane * (2.0f / 64.0f) * 13.287712379549449f);
            float rev = (float)s * inv * 0.15915494309189535f; rev -= rintf(rev);
            cs[lane] = __builtin_amdgcn_cosf(rev); cs[32 + lane] = __builtin_amdgcn_sinf(rev); }
        asm volatile("s_waitcnt lgkmcnt(0)" ::: "memory");
        const int h = lane >> 3, part = lane & 7;
        float qss = 0.f, kss = 0.f;
#pragma unroll
        for (int j = 0; j < 24; ++j) { const float a = q[h * 192 + part + 8 * j]; qss += a * a; }
#pragma unroll
        for (int j = 0; j < 16; ++j) { const float a = kv[h * 256 + part + 8 * j]; kss += a * a; }
        kss *= akv * akv;
#pragma unroll
        for (int j = 0; j < 8; ++j) { const float a = kr[part + 8 * j]; kss += a * a; }
        qss = sum8(qss); kss = sum8(kss);
        const float rq = rsqrtf(aq * aq * qss * (1.0f / 192) + EPS) * aq * 0.07216878364870322f;
        const float rk = rsqrtf(kss * (1.0f / 192) + EPS);
#pragma unroll
        for (int i = 0; i < 3; ++i) {
            const int c = lane + 64 * i, hh = c / 24, e0 = (c % 24) * 8;
            const float rqh = __int_as_float(__builtin_amdgcn_ds_bpermute(hh * 32, __float_as_int(rq))), rkh = __int_as_float(__builtin_amdgcn_ds_bpermute(hh * 32, __float_as_int(rk)));
            float vq[8], vk[8];
#pragma unroll
            for (int j = 0; j < 8; ++j) {
                const int e = e0 + j;
                if (e0 < 128) { vq[j] = q[hh * 192 + e] * g0[e] * rqh; vk[j] = kv[hh * 256 + e] * akv * g1[e] * rkh; }
                else { const int i2 = (e - 128) & 31; const float co = cs[i2], si = cs[32 + i2];
                    const float q1 = q[hh * 192 + 128 + i2] * g0[128 + i2], q2 = q[hh * 192 + 160 + i2] * g0[160 + i2];
                    const float k1 = kr[i2] * g1[128 + i2], k2 = kr[32 + i2] * g1[160 + i2];
                    if (e0 < 160) { vq[j] = (q1 * co - q2 * si) * rqh; vk[j] = (k1 * co - k2 * si) * rkh; }
                    else { vq[j] = (q2 * co + q1 * si) * rqh; vk[j] = (k2 * co + k1 * si) * rkh; } }
            }
            u32x4 wq, wk;
#pragma unroll
            for (int j = 0; j < 4; ++j) { wq[j] = pk_bf16(vq[2 * j], vq[2 * j + 1]); wk[j] = pk_bf16(vk[2 * j], vk[2 * j + 1]); }
            const size_t o = ((size_t)(b * 8 + hh) * S + s) * 192 + e0;
            *(u32x4*)(QD + o) = wq; *(u32x4*)(KD + o) = wk;
        }
#pragma unroll
        for (int i = 0; i < 2; ++i) { const int c = lane + 64 * i, hh = c >> 4, e0 = (c & 15) * 8;
            u32x4 wv;
#pragma unroll
            for (int j = 0; j < 4; ++j) wv[j] = pk_bf16(bf_lo(vcp[i][j]) * akv, bf_hi(vcp[i][j]) * akv);
            *(u32x4*)(VD + ((size_t)(b * 8 + hh) * S + s) * 128 + e0) = wv; }
        asm volatile("s_waitcnt lgkmcnt(0)" ::: "memory");
    }
}

constexpr int SHM_V = 64 * 128 * 2, SHM_KMAX = 64 * 192 * 2, ATT_WS = 2 * SHM_V + 2 * SHM_KMAX, ATT_RPB = ATT_WS + NWAVES * 64 * 4, ATT_END = ATT_RPB + 15 * 128 * 4;
constexpr float LOG2E = 1.4426950408889634f, ATT_THR = 8.0f;
struct AP {
    const bf16_t* Q; const bf16_t* K; const bf16_t* V;
    bf16_t* O; int opitch; int o8; float* lse;
    int NT;
    int dil, l0, r0, qmask, qshift;
    int lk0, jmask, jshift;
    float nslope;
    int qinfo;
};
__device__ __forceinline__ int crow(int r, int hi) { return (r & 3) + 8 * (r >> 2) + 4 * hi; }
template <int DQK> __device__ __forceinline__ int kswz(int row) { return (DQK == 128 ? (row & 15) : ((row >> 1) & 7)) << 4; }
__device__ __forceinline__ int v_st(int k, int c) { const int kk = (k & ~0xC) | ((k & 4) << 1) | ((k & 8) >> 1); return ((kk >> 3) * 4 + (c >> 5)) * 512 + ((kk & 7) * 32 + (c & 31)) * 2; }
__device__ __forceinline__ int v_rd_base(int lane) { return ((lane & 3) << 3) | (((lane >> 2) & 3) << 6) | (((lane >> 4) & 1) << 5) | (((lane >> 5) & 1) << 8); }
constexpr int v_rd_off(int d0, int ks, int half) { return d0 * 512 + ks * 4096 + half * 2048; }
template <int OFF> __device__ __forceinline__ s16x4 tr_read(int vb) { s16x4 r; asm volatile("ds_read_b64_tr_b16 %0, %1 offset:%2" : "=&v"(r) : "v"(vb), "i"(OFF) : "memory"); return r; }
template <int D0> __device__ __forceinline__ void pv_one(f32x16& od, int vb, bf16x8 pa0, bf16x8 pa1, bf16x8 pa2, bf16x8 pa3) {
    const s16x4 l0 = tr_read<v_rd_off(D0, 0, 0)>(vb), h0 = tr_read<v_rd_off(D0, 0, 1)>(vb), l1 = tr_read<v_rd_off(D0, 1, 0)>(vb), h1 = tr_read<v_rd_off(D0, 1, 1)>(vb);
    const s16x4 l2 = tr_read<v_rd_off(D0, 2, 0)>(vb), h2 = tr_read<v_rd_off(D0, 2, 1)>(vb), l3 = tr_read<v_rd_off(D0, 3, 0)>(vb), h3 = tr_read<v_rd_off(D0, 3, 1)>(vb);
    asm volatile("s_waitcnt lgkmcnt(0)" ::: "memory"); __builtin_amdgcn_sched_barrier(0);
#define MK_PK(L, H) (bf16x8){L[0], L[1], L[2], L[3], H[0], H[1], H[2], H[3]}
    od = __builtin_amdgcn_mfma_f32_32x32x16_bf16(pa0, MK_PK(l0, h0), od, 0, 0, 0);
    od = __builtin_amdgcn_mfma_f32_32x32x16_bf16(pa1, MK_PK(l1, h1), od, 0, 0, 0);
    od = __builtin_amdgcn_mfma_f32_32x32x16_bf16(pa2, MK_PK(l2, h2), od, 0, 0, 0);
    od = __builtin_amdgcn_mfma_f32_32x32x16_bf16(pa3, MK_PK(l3, h3), od, 0, 0, 0);
#undef MK_PK
}

#define MK_TR8(D0, vb, L0, H0, L1, H1, L2, H2, L3, H3) do { L0 = tr_read<v_rd_off(D0, 0, 0)>(vb); H0 = tr_read<v_rd_off(D0, 0, 1)>(vb); L1 = tr_read<v_rd_off(D0, 1, 0)>(vb); H1 = tr_read<v_rd_off(D0, 1, 1)>(vb); \
        L2 = tr_read<v_rd_off(D0, 2, 0)>(vb); H2 = tr_read<v_rd_off(D0, 2, 1)>(vb); L3 = tr_read<v_rd_off(D0, 3, 0)>(vb); H3 = tr_read<v_rd_off(D0, 3, 1)>(vb); } while (0)
#define MK_PKV(L, H) (bf16x8){L[0], L[1], L[2], L[3], H[0], H[1], H[2], H[3]}
#define MK_MM4(od, L0, H0, L1, H1, L2, H2, L3, H3) do { od = __builtin_amdgcn_mfma_f32_32x32x16_bf16(pa0, MK_PKV(L0, H0), od, 0, 0, 0); od = __builtin_amdgcn_mfma_f32_32x32x16_bf16(pa1, MK_PKV(L1, H1), od, 0, 0, 0); \
        od = __builtin_amdgcn_mfma_f32_32x32x16_bf16(pa2, MK_PKV(L2, H2), od, 0, 0, 0); od = __builtin_amdgcn_mfma_f32_32x32x16_bf16(pa3, MK_PKV(L3, H3), od, 0, 0, 0); } while (0)
__device__ __forceinline__ void pv_all(f32x16 (&o)[4], int vb, bf16x8 pa0, bf16x8 pa1, bf16x8 pa2, bf16x8 pa3) {
    s16x4 a0, a1, a2, a3, a4, a5, a6, a7, b0, b1, b2, b3, b4, b5, b6, b7;
    __builtin_amdgcn_sched_barrier(0);
    MK_TR8(0, vb, a0, a1, a2, a3, a4, a5, a6, a7);
    MK_TR8(1, vb, b0, b1, b2, b3, b4, b5, b6, b7);
    asm volatile("s_waitcnt lgkmcnt(8)" : "+v"(a0), "+v"(a1), "+v"(a2), "+v"(a3), "+v"(a4), "+v"(a5), "+v"(a6), "+v"(a7) :: "memory"); __builtin_amdgcn_sched_barrier(0);
    MK_MM4(o[0], a0, a1, a2, a3, a4, a5, a6, a7);
    __builtin_amdgcn_sched_barrier(0);
    MK_TR8(2, vb, a0, a1, a2, a3, a4, a5, a6, a7);
    asm volatile("s_waitcnt lgkmcnt(8)" : "+v"(b0), "+v"(b1), "+v"(b2), "+v"(b3), "+v"(b4), "+v"(b5), "+v"(b6), "+v"(b7) :: "memory"); __builtin_amdgcn_sched_barrier(0);
    MK_MM4(o[1], b0, b1, b2, b3, b4, b5, b6, b7);
    __builtin_amdgcn_sched_barrier(0);
    MK_TR8(3, vb, b0, b1, b2, b3, b4, b5, b6, b7);
    asm volatile("s_waitcnt lgkmcnt(8)" : "+v"(a0), "+v"(a1), "+v"(a2), "+v"(a3), "+v"(a4), "+v"(a5), "+v"(a6), "+v"(a7) :: "memory"); __builtin_amdgcn_sched_barrier(0);
    MK_MM4(o[2], a0, a1, a2, a3, a4, a5, a6, a7);
    asm volatile("s_waitcnt lgkmcnt(0)" : "+v"(b0), "+v"(b1), "+v"(b2), "+v"(b3), "+v"(b4), "+v"(b5), "+v"(b6), "+v"(b7) :: "memory"); __builtin_amdgcn_sched_barrier(0);
    MK_MM4(o[3], b0, b1, b2, b3, b4, b5, b6, b7);
}
#undef MK_TR8
#undef MK_MM4
#undef MK_PKV


constexpr unsigned QN = 448u, QEND = 0xffffu;
constexpr int LDS_QS = LDS_XB + 64;
__device__ __forceinline__ unsigned q_pop(unsigned* ctr, unsigned q) {
    unsigned v = xb_add(&ctr[64 * q], 1u);
    if (v < QN) return (q << 9) | v;
    for (;;) {
        unsigned best = 0xffffffffu, bq = 0u;
#pragma unroll
        for (unsigned j = 0; j < (unsigned)NB; ++j) { const unsigned c = xb_ld(&ctr[64 * j]); if (c < best) { best = c; bq = j; } }
        if (best >= QN) return QEND;
        v = xb_add(&ctr[64 * bq], 1u);
        if (v < QN) return (bq << 9) | v;
    }
}
#define MK_QHOOK() do { if (tid == 0) { const unsigned nx_ = q_pop((unsigned*)(F.a->ws + WS_CTL) + 12288 + 256 * (p.qinfo >> 8), (unsigned)(p.qinfo >> 1) & 3u); \
        *(volatile LAS unsigned*)(lds + LDS_QS + 4 * (p.qinfo & 1)) = nx_; } } while (0)

template <int MODE, int DQK>
__device__ __forceinline__ void attn_unit(const Frame& F, const AP p) {
    constexpr int KS = DQK / 16, PITCH = DQK * 2, SHMK = 64 * PITCH, KCH = DQK / 64;
    int tid_ = F.tid; asm volatile("" : "+v"(tid_));
    const int tid = tid_, wid = __builtin_amdgcn_readfirstlane(tid >> 6), lane = tid & 63, r32 = lane & 31, hi = lane >> 5;
    LAS char* lds = (LAS char*)F.lds;
    LAS char* V_lds = lds; LAS char* K_lds = lds + 2 * SHM_V;
    LAS float* wsl = (LAS float*)(lds + ATT_WS) + wid * 64; LAS float* li_l = wsl; LAS float* al_l = wsl + 32;
    const LAS float* rpb = (const LAS float*)(lds + ATT_RPB);
    float m_reg = -1e30f, l_reg = 0.f; f32x16 o[4];
#pragma unroll
    for (int d = 0; d < 4; ++d) o[d] = f32x16{};
    const int qi = wid * 32 + r32;
    const int tq = p.dil * (p.l0 + (qi & p.qmask)) + p.r0 + (qi >> p.qshift);
    bf16x8 qr[KS];
    { const bf16_t* Qw = p.Q + (size_t)tq * DQK + hi * 8;
#pragma unroll
      for (int d0 = 0; d0 < KS; ++d0) qr[d0] = *(const bf16x8*)(Qw + d0 * 16); }
    const int sr = tid >> 4, sc = (tid & 15) * 8, vst0 = v_st(sr, sc), vst1 = v_st(32 + sr, sc);
    const int vb0 = (int)(uintptr_t)V_lds + v_rd_base(lane);
    int krow[KCH], kcol[KCH];
#pragma unroll
    for (int i = 0; i < KCH; ++i) { const int c = tid + NTHR * i; krow[i] = c / (DQK / 8); kcol[i] = c % (DQK / 8); }
    u32x4 vs0, vs1, ksr[KCH];
#define ATT_TOK(j, row) (p.dil * (p.lk0 + 64 * ((j) & p.jmask) + (row)) + p.r0 + ((j) >> p.jshift))
#define ATT_CLAMP(t) ((t) < 0 ? 0 : ((t) > S - 1 ? S - 1 : (t)))
#define ATT_SLOAD(j) do { { const int t0 = ATT_CLAMP(ATT_TOK(j, sr)), t1 = ATT_CLAMP(ATT_TOK(j, 32 + sr)); \
        vs0 = *(const u32x4*)(p.V + (size_t)t0 * 128 + sc); vs1 = *(const u32x4*)(p.V + (size_t)t1 * 128 + sc); } \
        _Pragma("unroll") for (int _i = 0; _i < KCH; ++_i) { const int tk_ = ATT_CLAMP(ATT_TOK(j, krow[_i])); ksr[_i] = *(const u32x4*)(p.K + (size_t)tk_ * DQK + kcol[_i] * 8); } } while (0)
#define ATT_SWRITE(b) do { *(LAS u32x4*)(V_lds + (b) * SHM_V + vst0) = vs0; *(LAS u32x4*)(V_lds + (b) * SHM_V + vst1) = vs1; \
        _Pragma("unroll") for (int _i = 0; _i < KCH; ++_i) *(LAS u32x4*)(K_lds + (b) * SHMK + krow[_i] * PITCH + ((kcol[_i] * 16) ^ kswz<DQK>(krow[_i]))) = ksr[_i]; } while (0)
    ATT_SLOAD(0); MK_QHOOK(); ATT_SWRITE(0); __syncthreads();
    int na_rq = 0, na_cq = 0, na_rs = 0, na_cs = 0;
    if (MODE == 3) { na_rq = tq >> 6; na_cq = tq & 63; na_rs = na_rq - 4; na_rs = na_rs < 0 ? 0 : (na_rs > 24 ? 24 : na_rs); na_cs = na_cq - 8; na_cs = na_cs < 0 ? 0 : (na_cs > 48 ? 48 : na_cs); }
    for (int j = 0; j < p.NT; ++j) {
        const int cur = j & 1;
        if (j + 1 < p.NT) ATT_SLOAD(j + 1);
        const int kt0 = ATT_TOK(j, 0);
        bool skip = false;
        if (MODE == 2) { const int tq_lo = __builtin_amdgcn_readfirstlane(tq), tq_hi = tq_lo + 31 * p.dil, lim = 64 * p.dil;
            skip = (kt0 > tq_hi + lim) || (kt0 + 63 * p.dil < tq_lo - lim) || (((kt0 - tq_lo) & (p.dil - 1)) != 0); }
        if (MODE == 3) { const int rs_u = __builtin_amdgcn_readfirstlane(na_rs), rk = kt0 >> 6; skip = (rk < rs_u) || (rk >= rs_u + 8); }
        if (!skip) {
        f32x16 p0 = f32x16{}, p1 = f32x16{};
        { const LAS char* Ks = K_lds + cur * SHMK + r32 * PITCH; const int sw = kswz<DQK>(r32);
          bf16x8 c0 = *(const LAS bf16x8*)(Ks + ((hi * 16) ^ sw)), c1 = *(const LAS bf16x8*)(Ks + 32 * PITCH + ((hi * 16) ^ sw));
#pragma unroll
          for (int d0 = 0; d0 < KS; ++d0) { bf16x8 n0 = c0, n1 = c1;
            if (d0 + 1 < KS) { const int cb = (((d0 + 1) * 16 + hi * 8) * 2) ^ sw; n0 = *(const LAS bf16x8*)(Ks + cb); n1 = *(const LAS bf16x8*)(Ks + 32 * PITCH + cb); }
            __builtin_amdgcn_sched_barrier(0);
            p0 = __builtin_amdgcn_mfma_f32_32x32x16_bf16(c0, qr[d0], p0, 0, 0, 0);
            p1 = __builtin_amdgcn_mfma_f32_32x32x16_bf16(c1, qr[d0], p1, 0, 0, 0);
            __builtin_amdgcn_sched_barrier(0);
            c0 = n0; c1 = n1; } }
        if (MODE == 1) {
            const float base = (float)(kt0 + 4 * hi - tq);
#pragma unroll
            for (int r = 0; r < 16; ++r) { const float c = (float)((r & 3) + 8 * (r >> 2)); p0[r] = fmaf(fabsf(base + c), p.nslope, p0[r]); p1[r] = fmaf(fabsf(base + c + 32.0f), p.nslope, p1[r]); }
        }
        if (MODE == 2) {
            const int lim = 64 * p.dil, dm = p.dil - 1;
#pragma unroll
            for (int r = 0; r < 16; ++r) {
#pragma unroll
                for (int hf = 0; hf < 2; ++hf) { const int ki = crow(r, hi) + 32 * hf, tk = kt0 + ki * p.dil, d = tk - tq, ad = d < 0 ? -d : d;
                    const bool ok = ((unsigned)tk < (unsigned)S) && (ad <= lim) && ((d & dm) == 0);
                    if (hf) p1[r] = ok ? fmaf((float)ad, p.nslope, p1[r]) : -INFINITY; else p0[r] = ok ? fmaf((float)ad, p.nslope, p0[r]) : -INFINITY; } }
        }
        if (MODE == 3) {
            asm volatile("" : "+v"(na_cq), "+v"(na_cs));
            const int rk = kt0 >> 6; const bool rowok = (rk >= na_rs) && (rk < na_rs + 8); int ri = rk - na_rq + 7; ri = ri < 0 ? 0 : (ri > 14 ? 14 : ri);
            const LAS float* rb = rpb + ri * 128 + (63 - na_cq) + 4 * hi;
            const int cw = 4 * hi - na_cs;
#pragma unroll
            for (int r = 0; r < 16; ++r) {
#pragma unroll
                for (int hf = 0; hf < 2; ++hf) { const int c0 = (r & 3) + 8 * (r >> 2) + 32 * hf;
                    const bool ok = rowok && ((unsigned)(cw + c0) < 16u);
                    const float bv = rb[c0];
                    if (hf) p1[r] = ok ? p1[r] + bv : -INFINITY; else p0[r] = ok ? p0[r] + bv : -INFINITY; } }
        }
        float pmax = p0[0];
#pragma unroll
        for (int r = 1; r < 16; ++r) pmax = fmaxf(pmax, p0[r]);
#pragma unroll
        for (int r = 0; r < 16; ++r) pmax = fmaxf(pmax, p1[r]);
        { auto rr = __builtin_amdgcn_permlane32_swap(__float_as_uint(pmax), __float_as_uint(pmax), false, false); pmax = fmaxf(__uint_as_float(rr[0]), __uint_as_float(rr[1])); }
        float mn, alpha;
        if (__all(pmax - m_reg <= ATT_THR)) { mn = m_reg; alpha = 1.f; }
        else { mn = fmaxf(m_reg, pmax); alpha = __builtin_amdgcn_exp2f((m_reg - mn) * LOG2E); m_reg = mn; }
        const float mnC = -mn * LOG2E;
#pragma unroll
        for (int r = 0; r < 16; ++r) { p0[r] = __builtin_amdgcn_exp2f(fmaf(p0[r], LOG2E, mnC)); p1[r] = __builtin_amdgcn_exp2f(fmaf(p1[r], LOG2E, mnC)); }
        float ps = 0.f;
#pragma unroll
        for (int r = 0; r < 16; ++r) ps += p0[r];
#pragma unroll
        for (int r = 0; r < 16; ++r) ps += p1[r];
        { auto rr = __builtin_amdgcn_permlane32_swap(__float_as_uint(ps), __float_as_uint(ps), false, false); ps = __uint_as_float(rr[0]) + __uint_as_float(rr[1]); }
        l_reg = l_reg * alpha + ps;
        bf16x8 pa0, pa1, pa2, pa3;
#define ATT_PK4(P, BASE, OUT) do { unsigned a0 = pk_bf16(P[BASE + 0], P[BASE + 1]), a1 = pk_bf16(P[BASE + 2], P[BASE + 3]); \
        unsigned b0_ = pk_bf16(P[BASE + 4], P[BASE + 5]), b1_ = pk_bf16(P[BASE + 6], P[BASE + 7]); \
        auto r0_ = __builtin_amdgcn_permlane32_swap(a0, b0_, false, false); auto r1_ = __builtin_amdgcn_permlane32_swap(a1, b1_, false, false); \
        u32x4 w_ = {r0_[0], r1_[0], r0_[1], r1_[1]}; OUT = *reinterpret_cast<bf16x8*>(&w_); } while (0)
        ATT_PK4(p0, 0, pa0); ATT_PK4(p0, 8, pa1); ATT_PK4(p1, 0, pa2); ATT_PK4(p1, 8, pa3);
#undef ATT_PK4
        if (__any(alpha < 1.f)) { if (hi == 0) al_l[r32] = alpha; asm volatile("s_waitcnt lgkmcnt(0)" ::: "memory");
#pragma unroll
            for (int d = 0; d < 4; ++d)
#pragma unroll
                for (int r = 0; r < 16; ++r) o[d][r] *= al_l[crow(r, hi)]; }
        { const int vb = vb0 + cur * SHM_V;
          pv_all(o, vb, pa0, pa1, pa2, pa3); }
        }
        if (j + 1 < p.NT) ATT_SWRITE(cur ^ 1);
        __syncthreads();
    }
    if (hi == 0) li_l[r32] = l_reg;
    asm volatile("s_waitcnt lgkmcnt(0)" ::: "memory");
    if (p.lse != nullptr && hi == 0) p.lse[(size_t)tq * 8] = m_reg + __logf(l_reg);
#pragma unroll
    for (int r = 0; r < 16; ++r) { const int orow = crow(r, hi), qo = wid * 32 + orow; const int to = p.dil * (p.l0 + (qo & p.qmask)) + p.r0 + (qo >> p.qshift);
        const float lv = li_l[orow], rl = lv > 0.f ? 1.0f / lv : 0.f;
        bf16_t* orow_p = p.O + (size_t)to * p.opitch + r32;
#pragma unroll
        for (int d0 = 0; d0 < 4; ++d0) { const float ov = o[d0][r] * rl; if (p.o8) ((unsigned char*)p.O)[(size_t)to * p.opitch + r32 + d0 * 32] = (unsigned char)(pk_fp8x4(ov * O8_SCALE, 0.f, 0.f, 0.f) & 0xffu); else orow_p[d0 * 32] = (bf16_t)(pk_bf16(ov, 0.f) & 0xffffu); } }
    asm volatile("s_waitcnt lgkmcnt(0)" ::: "memory");
#undef ATT_TOK
#undef ATT_CLAMP
#undef ATT_SLOAD
#undef ATT_SWRITE
}


template <int MODE, int DQK>
__device__ __forceinline__ void attn_unit_p(const Frame& F, const AP p) {
    constexpr int KS = DQK / 16, PITCH = DQK * 2, SHMK = 64 * PITCH, KCH = DQK / 64;
    int tid_ = F.tid; asm volatile("" : "+v"(tid_));
    const int tid = tid_, wid = __builtin_amdgcn_readfirstlane(tid >> 6), lane = tid & 63, r32 = lane & 31, hi = lane >> 5;
    LAS char* lds = (LAS char*)F.lds;
    LAS char* V_lds = lds; LAS char* K_lds = lds + 2 * SHM_V;
    LAS float* wsl = (LAS float*)(lds + ATT_WS) + wid * 64; LAS float* li_l = wsl; LAS float* al_l = wsl + 32;
    float m_reg = -1e30f, l_reg = 0.f; f32x16 o[4];
#pragma unroll
    for (int d = 0; d < 4; ++d) o[d] = f32x16{};
    const int tq = p.l0 + wid * 32 + r32;
    bf16x8 qr[KS];
    { const bf16_t* Qw = p.Q + (size_t)tq * DQK + hi * 8;
#pragma unroll
      for (int d0 = 0; d0 < KS; ++d0) qr[d0] = *(const bf16x8*)(Qw + d0 * 16); }
    const int sr = tid >> 4, sc = (tid & 15) * 8, vst0 = v_st(sr, sc), vst1 = v_st(32 + sr, sc);
    const int vb0 = (int)(uintptr_t)V_lds + v_rd_base(lane);
    int krow[KCH], kcol[KCH];
#pragma unroll
    for (int i = 0; i < KCH; ++i) { const int c = tid + NTHR * i; krow[i] = c / (DQK / 8); kcol[i] = c % (DQK / 8); }
    u32x4 vsE0, vsE1, ksE[KCH], vsO0, vsO1, ksO[KCH];
#define AP_SLOAD(S, j) do { const int t0_ = p.lk0 + 64 * (j); vs##S##0 = *(const u32x4*)(p.V + (size_t)(t0_ + sr) * 128 + sc); vs##S##1 = *(const u32x4*)(p.V + (size_t)(t0_ + 32 + sr) * 128 + sc); \
        _Pragma("unroll") for (int _i = 0; _i < KCH; ++_i) ks##S[_i] = *(const u32x4*)(p.K + (size_t)(t0_ + krow[_i]) * DQK + kcol[_i] * 8); } while (0)
#define AP_SWRITE(b, S) do { *(LAS u32x4*)(V_lds + (b) * SHM_V + vst0) = vs##S##0; *(LAS u32x4*)(V_lds + (b) * SHM_V + vst1) = vs##S##1; \
        _Pragma("unroll") for (int _i = 0; _i < KCH; ++_i) *(LAS u32x4*)(K_lds + (b) * SHMK + krow[_i] * PITCH + ((kcol[_i] * 16) ^ kswz<DQK>(krow[_i]))) = ks##S[_i]; } while (0)
#define AP_QKT(P0, P1, b) do { P0 = f32x16{}; P1 = f32x16{}; const LAS char* Ks_ = K_lds + (b) * SHMK + r32 * PITCH; const int sw_ = kswz<DQK>(r32); \
        bf16x8 c0_ = *(const LAS bf16x8*)(Ks_ + ((hi * 16) ^ sw_)), c1_ = *(const LAS bf16x8*)(Ks_ + 32 * PITCH + ((hi * 16) ^ sw_)); \
        _Pragma("unroll") for (int d0 = 0; d0 < KS; ++d0) { bf16x8 n0_ = c0_, n1_ = c1_; \
            if (d0 + 1 < KS) { const int cb_ = (((d0 + 1) * 16 + hi * 8) * 2) ^ sw_; n0_ = *(const LAS bf16x8*)(Ks_ + cb_); n1_ = *(const LAS bf16x8*)(Ks_ + 32 * PITCH + cb_); } \
            P0 = __builtin_amdgcn_mfma_f32_32x32x16_bf16(c0_, qr[d0], P0, 0, 0, 0); P1 = __builtin_amdgcn_mfma_f32_32x32x16_bf16(c1_, qr[d0], P1, 0, 0, 0); c0_ = n0_; c1_ = n1_; } } while (0)
#define AP_PARTIAL(P0, P1, j, MN, AL) do { \
        if (MODE == 1) { const float base_ = (float)(p.lk0 + 64 * (j) + 4 * hi - tq); \
            _Pragma("unroll") for (int r = 0; r < 16; ++r) { const float c_ = (float)((r & 3) + 8 * (r >> 2)); P0[r] = fmaf(fabsf(base_ + c_), p.nslope, P0[r]); P1[r] = fmaf(fabsf(base_ + c_ + 32.0f), p.nslope, P1[r]); } } \
        float pmax_ = P0[0]; \
        _Pragma("unroll") for (int r = 1; r < 16; ++r) pmax_ = fmaxf(pmax_, P0[r]); \
        _Pragma("unroll") for (int r = 0; r < 16; ++r) pmax_ = fmaxf(pmax_, P1[r]); \
        { auto rr_ = __builtin_amdgcn_permlane32_swap(__float_as_uint(pmax_), __float_as_uint(pmax_), false, false); pmax_ = fmaxf(__uint_as_float(rr_[0]), __uint_as_float(rr_[1])); } \
        if (__builtin_expect(__all(pmax_ - m_reg <= ATT_THR), 1)) { MN = m_reg; AL = 1.f; } \
        else { MN = fmaxf(m_reg, pmax_); AL = __builtin_amdgcn_exp2f((m_reg - MN) * LOG2E); m_reg = MN; } \
        { const float mnC_ = -MN * LOG2E; \
          _Pragma("unroll") for (int r = 0; r < 16; ++r) { P0[r] = fmaf(P0[r], LOG2E, mnC_); P1[r] = fmaf(P1[r], LOG2E, mnC_); } \
          _Pragma("unroll") for (int r = 0; r < 16; ++r) P0[r] = __builtin_amdgcn_exp2f(P0[r]); } } while (0)
#define AP_PK4(P, BASE, OUT) do { unsigned a0 = pk_bf16(P[BASE + 0], P[BASE + 1]), a1 = pk_bf16(P[BASE + 2], P[BASE + 3]); \
        unsigned b0_ = pk_bf16(P[BASE + 4], P[BASE + 5]), b1_ = pk_bf16(P[BASE + 6], P[BASE + 7]); \
        auto r0_ = __builtin_amdgcn_permlane32_swap(a0, b0_, false, false); auto r1_ = __builtin_amdgcn_permlane32_swap(a1, b1_, false, false); \
        u32x4 w_ = {r0_[0], r1_[0], r0_[1], r1_[1]}; OUT = *reinterpret_cast<bf16x8*>(&w_); } while (0)
#define AP_FINISH(P0, P1, AL) do { \
        _Pragma("unroll") for (int r = 0; r < 16; ++r) P1[r] = __builtin_amdgcn_exp2f(P1[r]); \
        float ps_ = 0.f; \
        _Pragma("unroll") for (int r = 0; r < 16; ++r) ps_ += P0[r]; \
        _Pragma("unroll") for (int r = 0; r < 16; ++r) ps_ += P1[r]; \
        { auto rr_ = __builtin_amdgcn_permlane32_swap(__float_as_uint(ps_), __float_as_uint(ps_), false, false); ps_ = __uint_as_float(rr_[0]) + __uint_as_float(rr_[1]); } \
        l_reg = l_reg * (AL) + ps_; \
        AP_PK4(P0, 0, pa0); AP_PK4(P0, 8, pa1); AP_PK4(P1, 0, pa2); AP_PK4(P1, 8, pa3); } while (0)
#define AP_PV(b) do { const int vb_ = vb0 + (b) * SHM_V; pv_all(o, vb_, pa0, pa1, pa2, pa3); } while (0)
#define AP_RESC(a) do { if (__any((a) < 1.f)) { if (hi == 0) al_l[r32] = (a); asm volatile("s_waitcnt lgkmcnt(0)" ::: "memory"); \
        _Pragma("unroll") for (int d = 0; d < 4; ++d) _Pragma("unroll") for (int r = 0; r < 16; ++r) o[d][r] *= al_l[crow(r, hi)]; } } while (0)
#define AP_SB() __builtin_amdgcn_sched_barrier(0)
    f32x16 pA0, pA1, pB0, pB1; float mnA, mnB, alA, alB; bf16x8 pa0, pa1, pa2, pa3; const int NT = p.NT;
    AP_SLOAD(E, 0); MK_QHOOK(); AP_SWRITE(0, E); __syncthreads();
    AP_QKT(pA0, pA1, 0); AP_PARTIAL(pA0, pA1, 0, mnA, alA);
    AP_SLOAD(O, 1); if (2 < NT) AP_SLOAD(E, 2);
    AP_SWRITE(1, O); __syncthreads();
    for (int j = 1; j + 1 < NT; j += 2) {
        AP_SB(); AP_QKT(pB0, pB1, 1); AP_FINISH(pA0, pA1, alA); AP_SB();
        AP_SLOAD(O, j + 2); AP_SB();
        AP_PV(0); AP_PARTIAL(pB0, pB1, j, mnB, alB);
        __syncthreads(); AP_SWRITE(0, E);
        AP_RESC(alB); __syncthreads();
        AP_SB(); AP_QKT(pA0, pA1, 0); AP_FINISH(pB0, pB1, alB); AP_SB();
        if (j + 3 < NT) AP_SLOAD(E, j + 3); AP_SB();
        AP_PV(1); AP_PARTIAL(pA0, pA1, j + 1, mnA, alA);
        __syncthreads(); AP_SWRITE(1, O);
        AP_RESC(alA); __syncthreads();
    }
    AP_SB(); AP_QKT(pB0, pB1, 1); AP_FINISH(pA0, pA1, alA); AP_SB();
    AP_PV(0); AP_PARTIAL(pB0, pB1, NT - 1, mnB, alB);
    __syncthreads(); AP_RESC(alB);
    AP_FINISH(pB0, pB1, alB); AP_SB();
    AP_PV(1);
    (void)mnA; (void)mnB;
    if (hi == 0) li_l[r32] = l_reg;
    asm volatile("s_waitcnt lgkmcnt(0)" ::: "memory");
#pragma unroll
    for (int r = 0; r < 16; ++r) { const int orow = crow(r, hi), to = p.l0 + wid * 32 + orow;
        const float lv = li_l[orow], rl = lv > 0.f ? 1.0f / lv : 0.f;
        bf16_t* orow_p = p.O + (size_t)to * p.opitch + r32;
#pragma unroll
        for (int d0 = 0; d0 < 4; ++d0) { const float ov = o[d0][r] * rl; if (p.o8) ((unsigned char*)p.O)[(size_t)to * p.opitch + r32 + d0 * 32] = (unsigned char)(pk_fp8x4(ov * O8_SCALE, 0.f, 0.f, 0.f) & 0xffu); else orow_p[d0 * 32] = (bf16_t)(pk_bf16(ov, 0.f) & 0xffffu); } }
    asm volatile("s_waitcnt lgkmcnt(0)" ::: "memory");
    __syncthreads();
#undef AP_SLOAD
#undef AP_SWRITE
#undef AP_QKT
#undef AP_PARTIAL
#undef AP_PK4
#undef AP_FINISH
#undef AP_PV
#undef AP_RESC
#undef AP_SB
}

__device__ __forceinline__ void p_attention(const Frame& F, int l, int gs) {
    unsigned char* qkv = F.ws + WS_QKV;
    constexpr int N_MLA = 512, N_DIFF = 1024, N_NA = 512, N_D1 = 512, N_D4 = 512, N_D16 = 512, N_ALL = N_MLA + N_DIFF + N_NA + N_D1 + N_D4 + N_D16;
    static_assert(N_ALL == 8 * (int)QN, "queue size");
    const int ls = 2 * l + gs;
    unsigned* qctr = (unsigned*)(F.a->ws + WS_CTL) + 12288 + 256 * ls;
    volatile LAS unsigned* qs = (volatile LAS unsigned*)(F.lds + LDS_QS);
    { int t_ = F.tid; asm volatile("" : "+v"(t_)); if (t_ == 0) qs[0] = q_pop(qctr, xb_xcc_id() & 3u); }
    __syncthreads();
    for (int par = 0; ; par ^= 1) {
        const int u = __builtin_amdgcn_readfirstlane((int)qs[par]);
        if (u == (int)QEND) break;
        const int xl = u >> 9, qi_ = u & 511, sub = qi_ & 7; int v = qi_ >> 3, cat = 0;
        if (v >= 8) { v -= 8; cat = 1; if (v >= 16) { v -= 16; cat = 2; if (v >= 8) { v -= 8; cat = 3; if (v >= 8) { v -= 8; cat = 4; if (v >= 8) { v -= 8; cat = 5; } } } } }
        AP p; p.qinfo = (ls << 8) | (xl << 1) | (par ^ 1); p.lse = nullptr; p.opitch = 1024; p.o8 = 0; p.dil = 1; p.r0 = 0; p.qmask = 255; p.qshift = 8; p.jmask = 63; p.jshift = 6; p.nslope = 0.f; p.lk0 = 0; p.NT = 32;
        if (cat == 1) {
            const int b = xl, hp = 15 - v, h = hp >> 1, c = hp & 1;
            p.Q = (const bf16_t*)(qkv + QO_QA) + (size_t)(b * 16 + hp) * S * 64; p.K = (const bf16_t*)(qkv + QO_KA) + (size_t)(b * 16 + hp) * S * 64; p.V = (const bf16_t*)(qkv + QO_VA) + (size_t)(b * 8 + h) * S * 128;
            p.O = (bf16_t*)(F.ws + WS_P + PO_OA + (size_t)c * SZ_H1) + (size_t)b * S * 1024 + h * 128; p.l0 = sub * 256; p.nslope = -exp2f(-(float)(h + 1));
            {
                const int dmax = 1 << (h + 7), q0 = sub * 256; int jlo = (q0 - dmax + 1) >> 6; jlo = jlo < 0 ? 0 : jlo; int jhi = (q0 + 255 + dmax - 1) >> 6; jhi = jhi > 31 ? 31 : jhi;
                if (((jhi - jlo + 1) & 1) != 0) { if (jlo > 0) --jlo; else ++jhi; }
                p.lk0 = 64 * jlo; p.NT = jhi - jlo + 1; }
#if !defined(MK_ATT_ONLY) || MK_ATT_ONLY == 1
            attn_unit_p<1, 64>(F, p);
#endif
        } else {
            const int b = xl, h = v; const size_t ho = (size_t)(b * 8 + h) * S;
            if (cat == 0) {
                p.Q = (const bf16_t*)(qkv + QO_QD) + ho * 192; p.K = (const bf16_t*)(qkv + QO_KD) + ho * 192; p.V = (const bf16_t*)(qkv + QO_VD) + ho * 128;
                p.O = (bf16_t*)(F.ws + WS_O + (size_t)b * S * DM + 3072 + h * 128); p.opitch = DM; p.o8 = 1; p.l0 = sub * 256;
#if !defined(MK_ATT_ONLY) || MK_ATT_ONLY == 0
                attn_unit<0, 192>(F, p);
#endif
            } else if (cat == 2) {
                p.Q = (const bf16_t*)(qkv + QO_QC) + ho * 128; p.K = (const bf16_t*)(qkv + QO_KC) + ho * 128; p.V = (const bf16_t*)(qkv + QO_VC) + ho * 128;
                p.O = (bf16_t*)(F.ws + WS_O + (size_t)b * S * DM + 2048 + h * 128); p.opitch = DM; p.o8 = 1; p.l0 = sub * 256;
                const int R0 = sub * 4; int first = R0 - 4; first = first < 0 ? 0 : (first > 24 ? 24 : first); int lastb = R0 - 1; lastb = lastb < 0 ? 0 : (lastb > 24 ? 24 : lastb);
                p.lk0 = first * 64; p.NT = lastb + 7 - first + 1;
                { LAS float* rp = (LAS float*)(F.lds + ATT_RPB); const float* src = F.a->in[I_RPB] + (size_t)(l * 8 + h) * 465; int ti = F.tid; asm volatile("" : "+v"(ti)); if (ti < 465) rp[(ti / 31) * 128 + 48 + (ti % 31)] = src[ti]; }
#if !defined(MK_ATT_ONLY) || MK_ATT_ONLY == 3
                attn_unit<3, 128>(F, p);
#endif
            } else {
                const int br = cat - 3;
                p.Q = (const bf16_t*)(qkv + QO_QB) + ho * 128; p.K = (const bf16_t*)(qkv + QO_KB) + ho * 128; p.V = (const bf16_t*)(qkv + QO_VB) + ho * 128;
                p.O = (bf16_t*)(F.ws + WS_P + PO_OB + (size_t)br * SZ_H1) + (size_t)b * S * 1024 + h * 128;
                p.lse = (float*)(F.ws + WS_P + PO_LSE) + (size_t)br * T * 8 + (size_t)b * S * 8 + h; p.nslope = -exp2f(-(float)(h + 1));
                if (br == 0) { p.dil = 1; p.l0 = sub * 256; p.lk0 = p.l0 - 64; p.NT = 6; }
                else if (br == 1) { p.dil = 4; p.r0 = sub >> 1; p.l0 = (sub & 1) * 256; p.lk0 = p.l0 - 64; p.NT = 6; }
                else { p.dil = 16; p.r0 = sub * 2; p.l0 = 0; p.qmask = 127; p.qshift = 7; p.lk0 = 0; p.jmask = 1; p.jshift = 1; p.NT = 4; }
#if !defined(MK_ATT_ONLY) || MK_ATT_ONLY == 2
                attn_unit<2, 128>(F, p);
#endif
            }
        }
    }
}

__device__ __forceinline__ void p_post3(const Frame& F, int l) {
    const bf16_t* OA0 = (const bf16_t*)(F.ws + WS_P + PO_OA); const bf16_t* OA1 = OA0 + (size_t)T * 1024; const bf16_t* OB = (const bf16_t*)(F.ws + WS_P + PO_OB);
    const float* LSE = (const float*)(F.ws + WS_P + PO_LSE);
    unsigned char* O = F.ws + WS_O;
    const int lane = F.lane;
    const float* lv = F.a->in[I_DLAM] + l * 4 * 64;
    const float s01 = wsum(lv[lane] * lv[64 + lane]), s23 = wsum(lv[128 + lane] * lv[192 + lane]);
    const float lam_init = 0.8f - 0.6f * expf(-0.3f * (float)l), lam = expf(s01) - expf(s23) + lam_init;
    const float* gout = F.a->in[I_DGOUT] + l * 128 + (lane & 7) * 16;
    for (int t = F.rank * NWAVES + F.wid; t < T; t += F.nwg * NWAVES) {
        const size_t ro = (size_t)t * 1024 + lane * 16; unsigned char* orow = O + (size_t)t * DM + lane * 16;
        const int h = lane >> 3;
        u32x4 ra[2], rb[2], r0[2], r1[2], r2[2];
#pragma unroll
        for (int i = 0; i < 2; ++i) { ra[i] = *(const u32x4*)(OA0 + ro + 8 * i); rb[i] = *(const u32x4*)(OA1 + ro + 8 * i); r0[i] = *(const u32x4*)(OB + ro + 8 * i);
            r1[i] = *(const u32x4*)(OB + (size_t)T * 1024 + ro + 8 * i); r2[i] = *(const u32x4*)(OB + (size_t)2 * T * 1024 + ro + 8 * i); }
        float e0 = LSE[(size_t)t * 8 + h], e1 = LSE[(size_t)T * 8 + (size_t)t * 8 + h], e2 = LSE[(size_t)2 * T * 8 + (size_t)t * 8 + h];
        asm volatile("" : "+v"(e0), "+v"(e1), "+v"(e2) :: "memory");
        {
            float xa[16], xb[16], d[16]; unpack16(ra[0], ra[1], xa); unpack16(rb[0], rb[1], xb); float ss = 0.f;
#pragma unroll
            for (int j = 0; j < 16; ++j) { d[j] = xa[j] - lam * xb[j]; ss += d[j] * d[j]; }
            ss = sum8(ss);
            const float r = rsqrtf(ss * (1.0f / 128) + EPS) * (1.0f - lam_init);
            u32x4 w0; const float r8 = r * O8_SCALE;
#pragma unroll
            for (int i = 0; i < 4; ++i) w0[i] = pk_fp8x4(d[4 * i] * r8 * gout[4 * i], d[4 * i + 1] * r8 * gout[4 * i + 1], d[4 * i + 2] * r8 * gout[4 * i + 2], d[4 * i + 3] * r8 * gout[4 * i + 3]);
            *(u32x4*)orow = w0;
        }
        {
            const float m = fmaxf(e0, fmaxf(e1, e2)); float w0 = __expf(e0 - m), w1 = __expf(e1 - m), w2 = __expf(e2 - m); const float inv = 1.0f / (w0 + w1 + w2); w0 *= inv; w1 *= inv; w2 *= inv;
            float x0[16], x1[16], x2[16], d[16]; unpack16(r0[0], r0[1], x0); unpack16(r1[0], r1[1], x1); unpack16(r2[0], r2[1], x2);
#pragma unroll
            for (int j = 0; j < 16; ++j) d[j] = w0 * x0[j] + w1 * x1[j] + w2 * x2[j];
            u32x4 y0;
#pragma unroll
            for (int i = 0; i < 4; ++i) y0[i] = pk_fp8x4(d[4 * i] * O8_SCALE, d[4 * i + 1] * O8_SCALE, d[4 * i + 2] * O8_SCALE, d[4 * i + 3] * O8_SCALE);
            *(u32x4*)(orow + 1024) = y0;
        }
    }
}

__device__ __forceinline__ int med3i(int a, int b, int c) { return max(min(a, b), min(max(a, b), c)); }
__device__ __forceinline__ int ordkey(float v) { const int x = __float_as_int(v); return x ^ ((x >> 31) & 0x7fffffff); }
#define MK_INSERT(L, key) do { _Pragma("unroll") for (int _k = 15; _k >= 1; --_k) L[_k] = med3i((key), L[_k - 1], L[_k]); L[0] = max((key), L[0]); } while (0)
__device__ __forceinline__ void p_select(const Frame& F, int l) {
    const float* SC = (const float*)(F.ws + WS_P + PO_SC); int* EX = (int*)(F.ws + WS_P + PO_EXP); float* GT = (float*)(F.ws + WS_P + PO_GATE);
    LAS float* L = (LAS float*)F.lds;
    const int tid = F.tid;
    for (int blk = F.rank * NWAVES + F.wid; blk < T * 8 / 64; blk += F.nwg * NWAVES) {
        const int pid = blk * 64 + F.lane, t = pid >> 3, h = pid & 7;
        const float* sc = SC + (size_t)t * 2048 + h * 256;
        float fa[16], fb[16];
#pragma unroll
        for (int c = 0; c < 2; ++c) {
            int Lk[16];
#pragma unroll
            for (int k = 0; k < 16; ++k) Lk[k] = (int)0x80000000;
            for (int n32 = 0; n32 < 4; ++n32) { f32x4 v[8];
#pragma unroll
                for (int q = 0; q < 8; ++q) v[q] = *(const f32x4*)(sc + c * 128 + n32 * 32 + q * 4);
#pragma unroll
                for (int q = 0; q < 8; ++q)
#pragma unroll
                    for (int e = 0; e < 4; ++e) { const int key = (ordkey(v[q][e]) & ~127) | (n32 * 32 + q * 4 + e); MK_INSERT(Lk, key); } }
#pragma unroll
            for (int k = 0; k < 16; ++k) { const int idx = Lk[k] & 127; const float val = sc[c * 128 + idx];
                if (c == 0) fa[k] = val; else fb[k] = val;
                L[(c * 32 + k) * NTHR + tid] = val; L[(c * 32 + 16 + k) * NTHR + tid] = __int_as_float(idx); }
        }
        int Mk[16];
#pragma unroll
        for (int k = 0; k < 16; ++k) Mk[k] = (int)0x80000000;
#pragma unroll
        for (int i = 0; i < 16; ++i)
#pragma unroll
            for (int j = 0; j < 16; ++j) if ((i + 1) * (j + 1) <= 16) { const int key = (ordkey(fa[i] + fb[j]) & ~255) | (i * 16 + j); MK_INSERT(Mk, key); }
        asm volatile("s_waitcnt lgkmcnt(0)" ::: "memory");
        float sk[16]; int ek[16]; float mx = -INFINITY;
#pragma unroll
        for (int k = 0; k < 16; ++k) { const int code = Mk[k] & 255, i = code >> 4, j = code & 15;
            sk[k] = L[i * NTHR + tid] + L[(32 + j) * NTHR + tid];
            ek[k] = __float_as_int(L[(16 + i) * NTHR + tid]) * 128 + __float_as_int(L[(48 + j) * NTHR + tid]); mx = fmaxf(mx, sk[k]); }
        const float inv = 1.0f; (void)mx;
#pragma unroll
        for (int k = 0; k < 4; ++k) { *(int4*)(EX + (size_t)t * 128 + h * 16 + 4 * k) = make_int4(ek[4 * k], ek[4 * k + 1], ek[4 * k + 2], ek[4 * k + 3]);
            *(f32x4*)(GT + (size_t)t * 128 + h * 16 + 4 * k) = (f32x4){sk[4 * k] * inv, sk[4 * k + 1] * inv, sk[4 * k + 2] * inv, sk[4 * k + 3] * inv}; }
        asm volatile("s_waitcnt lgkmcnt(0)" ::: "memory");
    }
}

typedef float f32x2 __attribute__((ext_vector_type(2)));
typedef _Float16 h16x2 __attribute__((ext_vector_type(2)));
__device__ __forceinline__ void p_gather(const Frame& F, int l, int gs) {
    const bf16_t* HN = (const bf16_t*)(F.ws + WS_HN); const int* EX = (const int*)(F.ws + WS_P + PO_EXP); const float* GT = (const float*)(F.ws + WS_P + PO_GATE);
    const unsigned char* U = F.a->ws + WS_W + (size_t)l * LW_END + LW_U; const unsigned char* V = F.a->ws + WS_W + (size_t)l * LW_END + LW_V;
#define MK_LANE() ({ unsigned z_ = 0u; asm volatile("" : "+v"(z_)); (int)__builtin_amdgcn_mbcnt_hi(~0u, __builtin_amdgcn_mbcnt_lo(~0u, z_)); })
    unsigned* tctr = (unsigned*)(F.a->ws + WS_CTL) + 14336 + 64 * (2 * l + gs);
#define MK_TPOP(ln) ({ unsigned v_ = 0u; if ((ln) == 0) v_ = xb_add(tctr, 1u); v_; })
    int tnext = __builtin_amdgcn_readfirstlane((int)MK_TPOP(MK_LANE()));
    for (int t = tnext; t < T; t = tnext) {
        int lane = MK_LANE();
        const unsigned tv = MK_TPOP(lane);
        h16x2 hh[32];
        float ssq = 0.f;
#pragma unroll
        for (int c = 0; c < 16; ++c) { const u32x2 a = *(const u32x2*)(HN + (size_t)t * DM + c * 256 + 4 * lane); const float a0 = bf_lo(a.x), a1 = bf_hi(a.x), a2 = bf_lo(a.y), a3 = bf_hi(a.y);
            ssq += (a0 * a0 + a1 * a1) + (a2 * a2 + a3 * a3); hh[2 * c] = (h16x2){(_Float16)a0, (_Float16)a1}; hh[2 * c + 1] = (h16x2){(_Float16)a2, (_Float16)a3}; }
        const float rstd = rsqrtf(wave_total(ssq) * (1.0f / DM) + EPS);
        tnext = __builtin_amdgcn_readfirstlane((int)tv); asm volatile("" : "+s"(tnext));
        const int e0 = EX[(size_t)t * 128 + lane], e1 = EX[(size_t)t * 128 + 64 + lane]; float g0 = GT[(size_t)t * 128 + lane] * rstd, g1 = GT[(size_t)t * 128 + 64 + lane] * rstd;
        {
            float m0 = g0, m1 = g1;
#define MK_DPP_MAX(v, ctrl) v = fmaxf(v, __int_as_float(__builtin_amdgcn_update_dpp(0, __float_as_int(v), ctrl, 0xF, 0xF, true)))
            MK_DPP_MAX(m0, 0xB1); MK_DPP_MAX(m0, 0x4E); MK_DPP_MAX(m0, 0x141); MK_DPP_MAX(m0, 0x140); MK_DPP_MAX(m1, 0xB1); MK_DPP_MAX(m1, 0x4E); MK_DPP_MAX(m1, 0x141); MK_DPP_MAX(m1, 0x140);
#undef MK_DPP_MAX
            g0 = __expf(g0 - m0); g1 = __expf(g1 - m1); float s0 = g0, s1 = g1;
            MK_DPP_ADD(s0, 0xB1); MK_DPP_ADD(s0, 0x4E); MK_DPP_ADD(s0, 0x141); MK_DPP_ADD(s0, 0x140); MK_DPP_ADD(s1, 0xB1); MK_DPP_ADD(s1, 0x4E); MK_DPP_ADD(s1, 0x141); MK_DPP_ADD(s1, 0x140);
            g0 /= s0; g1 /= s1; }
        const float zs = rstd * (1.0f / U_SCALE);
#define MK_GRP(w, q) (u32x6){w[(6 * (q) + 0) >> 2][(6 * (q) + 0) & 3], w[(6 * (q) + 1) >> 2][(6 * (q) + 1) & 3], w[(6 * (q) + 2) >> 2][(6 * (q) + 2) & 3], w[(6 * (q) + 3) >> 2][(6 * (q) + 3) & 3], w[(6 * (q) + 4) >> 2][(6 * (q) + 4) & 3], w[(6 * (q) + 5) >> 2][(6 * (q) + 5) & 3]}
#define MK_ROWS(buf, TAB, k) do { const int ev_ = (k) < 16 ? e0 : e1; _Pragma("unroll") for (int j_ = 0; j_ < 4; ++j_) { const int e_ = __builtin_amdgcn_readlane(ev_, (4 * (k) + j_) & 63); \
            const unsigned char* r_ = TAB + (size_t)e_ * 3072 + lane * 48; _Pragma("unroll") for (int c_ = 0; c_ < 3; ++c_) buf[j_][c_] = *(const u32x4*)(r_ + c_ * 16); } } while (0)
        int wv0 = 0, wv1 = 0;
#define MK_DPPF(v, ctrl) __int_as_float(__builtin_amdgcn_update_dpp(0, __float_as_int(v), ctrl, 0xF, 0xF, true))
#define MK_UCOMP(buf, k) do { float p_[4]; _Pragma("unroll") for (int j_ = 0; j_ < 4; ++j_) { float za_ = 0.f, zb_ = 0.f; \
            _Pragma("unroll") for (int q_ = 0; q_ < 2; ++q_) { const h16x32 d_ = __builtin_amdgcn_cvt_scalef32_pk32_f16_fp6(MK_GRP(buf[j_], q_), 1.0f); \
                _Pragma("unroll") for (int p2_ = 0; p2_ < 16; p2_ += 2) { za_ = __builtin_amdgcn_fdot2((h16x2){d_[2 * p2_], d_[2 * p2_ + 1]}, hh[q_ * 16 + p2_], za_, false); \
                    zb_ = __builtin_amdgcn_fdot2((h16x2){d_[2 * p2_ + 2], d_[2 * p2_ + 3]}, hh[q_ * 16 + p2_ + 1], zb_, false); } } \
            p_[j_] = za_ + zb_; } \
            const bool o0_ = (lane & 1) != 0, o1_ = (lane & 2) != 0; \
            const float r01_ = (o0_ ? p_[1] : p_[0]) + MK_DPPF((o0_ ? p_[0] : p_[1]), 0xB1), r23_ = (o0_ ? p_[3] : p_[2]) + MK_DPPF((o0_ ? p_[2] : p_[3]), 0xB1); \
            float r_ = (o1_ ? r23_ : r01_) + MK_DPPF((o1_ ? r01_ : r23_), 0x4E); \
            r_ += MK_DPPF(r_, 0x124); r_ += MK_DPPF(r_, 0x128); \
            { auto s_ = __builtin_amdgcn_permlane16_swap(__float_as_uint(r_), __float_as_uint(r_), false, false); r_ = __uint_as_float(s_[0]) + __uint_as_float(s_[1]); } \
            { auto s_ = __builtin_amdgcn_permlane32_swap(__float_as_uint(r_), __float_as_uint(r_), false, false); r_ = __uint_as_float(s_[0]) + __uint_as_float(s_[1]); } \
            const bool me_ = (lane >> 2) == ((k) & 15); \
            if ((k) < 16) wv0 = me_ ? __float_as_int(r_) : wv0; else wv1 = me_ ? __float_as_int(r_) : wv1; } while (0)
        {
            u32x4 b0[4][3], b1[4][3], b2[4][3];
            MK_ROWS(b0, U, 0); MK_ROWS(b1, U, 1);
            for (int k = 0; k < 30; k += 3) { MK_ROWS(b2, U, k + 2); MK_UCOMP(b0, k); MK_ROWS(b0, U, k + 3); MK_UCOMP(b1, k + 1); MK_ROWS(b1, U, k + 4); MK_UCOMP(b2, k + 2); }
            MK_UCOMP(b0, 30); MK_UCOMP(b1, 31);
        }
        {
            const float z0 = __int_as_float(wv0) * zs, z1 = __int_as_float(wv1) * zs;
            wv0 = __float_as_int(g0 * 0.5f * z0 * (1.0f + erff(z0 * 0.7071067811865476f)) * (1.0f / V_SCALE));
            wv1 = __float_as_int(g1 * 0.5f * z1 * (1.0f + erff(z1 * 0.7071067811865476f)) * (1.0f / V_SCALE)); }
        f32x2 acc[32];
#pragma unroll
        for (int i = 0; i < 32; ++i) acc[i] = (f32x2){0.f, 0.f};
#define MK_VCOMP(buf, k) do { const int wv_ = (k) < 16 ? wv0 : wv1; _Pragma("unroll") for (int j_ = 0; j_ < 4; ++j_) { const float w_ = __int_as_float(__builtin_amdgcn_readlane(wv_, (4 * (k) + j_) & 63)); const f32x2 w2_ = (f32x2){w_, w_}; \
            _Pragma("unroll") for (int q_ = 0; q_ < 2; ++q_) { const f32x32v d_ = __builtin_amdgcn_cvt_scalef32_pk32_f32_fp6(MK_GRP(buf[j_], q_), 1.0f); \
                _Pragma("unroll") for (int p_ = 0; p_ < 16; ++p_) acc[q_ * 16 + p_] = __builtin_elementwise_fma((f32x2){d_[2 * p_], d_[2 * p_ + 1]}, w2_, acc[q_ * 16 + p_]); } } } while (0)
        {
            u32x4 b0[4][3], b1[4][3];
            MK_ROWS(b0, V, 0);
            for (int k = 0; k < 32; k += 2) { MK_ROWS(b1, V, k + 1); MK_VCOMP(b0, k); if (k + 2 < 32) MK_ROWS(b0, V, k + 2); MK_VCOMP(b1, k + 1); }
        }
#undef MK_ROWS
#undef MK_UCOMP
#undef MK_DPPF
#undef MK_VCOMP
#undef MK_GRP
        asm volatile("" : "+v"(lane));
        float* xr = F.out + (size_t)t * DM + 4 * lane; f32x4 xo[16]; float ss = 0.f;
#pragma unroll
        for (int c = 0; c < 16; ++c) xo[c] = *(const f32x4*)(xr + c * 256);
#pragma unroll
        for (int c = 0; c < 16; ++c) { f32x4 a = xo[c]; const int q = c >> 3, pb_ = 2 * (c & 7);
            a[0] += acc[q * 16 + pb_].x; a[1] += acc[q * 16 + pb_].y; a[2] += acc[q * 16 + pb_ + 1].x; a[3] += acc[q * 16 + pb_ + 1].y; *(f32x4*)(xr + c * 256) = a; xo[c] = a;
            ss += (a[0] * a[0] + a[1] * a[1]) + (a[2] * a[2] + a[3] * a[3]); }
        if (l == 0) {
            const float r = rsqrtf(wave_total(ss) * (1.0f / DM) + EPS) * HN8_SCALE; unsigned char* hr = F.ws + WS_T2 + TO_HN8 + (size_t)t * DM + 4 * lane;
#pragma unroll
            for (int c = 0; c < 16; ++c) *(unsigned*)(hr + c * 256) = pk_fp8x4(xo[c][0] * r, xo[c][1] * r, xo[c][2] * r, xo[c][3] * r); }
    }
#undef MK_TPOP
#undef MK_LANE
}

__global__ void __launch_bounds__(NTHR, 2) mk_fwd(Args args) {
    extern __shared__ __attribute__((aligned(16))) unsigned char lds_raw[];
    Frame F;
    F.a = &args;
    F.out = args.out; F.ws = args.ws; F.lds = (LAS unsigned char*)lds_raw;
    const int wave_id = __builtin_amdgcn_readfirstlane((int)threadIdx.x >> 6);
#define MK_TID() ({ unsigned z_ = 0u; asm volatile("" : "+v"(z_)); wave_id * 64 + (int)__builtin_amdgcn_mbcnt_hi(~0u, __builtin_amdgcn_mbcnt_lo(~0u, z_)); })
    F.tid = MK_TID(); F.lane = F.tid & 63; F.wid = wave_id; F.rank = (int)blockIdx.x; F.nwg = (int)gridDim.x;
#define MK_BAR_PTR(full) ((unsigned*)(args.ws + WS_CTL) + ((full) ? 0 : 4096 * (1 + sid())))
    if (MK_TID() == 0) *(LAS u32x4*)(F.lds + LDS_XB) = (u32x4){0u, 0u, 0u, 0u};
    __syncthreads();
    (void)xcd_barrier_post(MK_BAR_PTR(1), (volatile LAS unsigned*)(F.lds + LDS_XB), MK_TID() == 0);
    (void)xcd_barrier_post(MK_BAR_PTR(0), (volatile LAS unsigned*)(F.lds + LDS_XB + 8), MK_TID() == 0);
#ifndef MK_ONLY
#define MK_ONLY -1
#endif
#define MK_EN(s) (MK_ONLY < 0 || MK_ONLY == (s))
#define MK_FRESH(gs, all) do { int t_ = MK_TID(); asm volatile("" : "+v"(t_)); F.tid = t_; F.lane = t_ & 63; F.wid = __builtin_amdgcn_readfirstlane(t_ >> 6); \
        F.rank = (all) ? (int)blockIdx.x : wg_rank(); F.nwg = (all) ? (int)gridDim.x : wg_count(); \
        __attribute__((address_space(1))) unsigned char* w_ = (__attribute__((address_space(1))) unsigned char*)(args.ws + (size_t)(gs) * ACT_SZ); \
        __attribute__((address_space(1))) float* o_ = (__attribute__((address_space(1))) float*)(args.out + (size_t)(gs) * T * DM); \
        asm volatile("" : "+s"(w_), "+s"(o_)); F.ws = (unsigned char*)w_; F.out = (float*)o_; } while (0)
#define MK_BAR(full) do { XcdBarrier b_; b_.bar = MK_BAR_PTR(full); b_.x = xb_xcc_id(); b_.G = (full) ? gridDim.x : (gridDim.x >> 1); b_.st = (volatile LAS unsigned*)(F.lds + LDS_XB + ((full) ? 0 : 8)); \
        xcd_barrier(b_, MK_TID() == 0); } while (0)
    if (MK_EN(100)) { MK_FRESH(0, 1); p0_a(F); MK_FRESH(0, 1); p0_b(F, (int)blockIdx.x, (int)gridDim.x);
        for (int gs = 0; gs < 2; ++gs) { MK_FRESH(gs, 1); p_norm(F, F.a->in[I_X] + (size_t)gs * T * DM, (bf16_t*)(F.ws + WS_T2 + TO_HN8)); } }
    MK_BAR(1);
#ifndef MK_NHEAD
#define MK_NHEAD 4
#endif
#ifndef MK_JTAIL
#define MK_JTAIL 15
#endif
    const int nsteps = (sid() == 0) ? (18 + 18 - MK_JTAIL) : (MK_NHEAD + 18);
    for (int i = 0; i < nsteps; ++i) {
        int gs, g, all, nall;
        if (sid() == 0) { if (i < 18) { gs = 0; g = i; all = i < MK_NHEAD; nall = (i + 1 < MK_NHEAD) || (i + 1 >= 18); } else { gs = 1; g = MK_JTAIL + (i - 18); all = 1; nall = 1; } }
        else { if (i < MK_NHEAD) { gs = 0; g = i; all = 1; nall = (i + 1 < MK_NHEAD); } else { gs = 1; g = i - MK_NHEAD; all = g >= MK_JTAIL; nall = (g + 1 >= MK_JTAIL); } }
        const int l = g >= 9 ? 1 : 0, st = g - 9 * l;
#define lw (F.a->ws + WS_W + (size_t)l * LW_END)
#define xin ((l == 0) ? (F.a->in[I_X] + (size_t)gs * T * DM) : (const float*)F.out)
        MK_FRESH(gs, all);
        if (st == 0) {
            if (MK_EN(1)) { pg8::Gemm gm{(const bf16_t*)(F.ws + WS_T2 + TO_HN8), (const bf16_t*)(lw + LW_WIN), T, NINP, DM}; pg8::StaticOrder So; So.init(T, NINP, F.nwg, F.rank);
                pg8::EpiG1N E{(bf16_t*)(F.ws + WS_P), NINP, (bf16_t*)(F.ws + WS_QKV), SZ_H1 / 2, 1.0f / (HN8_SCALE * WIN8_SCALE), F.a->in[I_DGQK] + l * 128, F.a->in[I_DILG] + l * 256, F.a->in[I_NAG] + l * 256, (LAS float*)(F.lds + LDS_G1X)};
                pg8::gemm_phase_f8<pg8::EpiG1N, pg8::StaticOrder>(F.lds, gm, So, E, nullptr, MK_TID()); }
        } else if (st == 1) {
            if (MK_EN(3)) {
                for (int gi = 0; gi < 2; ++gi) {
                    pg8::Gemm gm{(const bf16_t*)(F.ws + WS_P) + (gi ? 9984 : 9216), (const bf16_t*)(lw + (gi ? LW_WUKV : LW_WUQ)), T, gi ? 2048 : 1536, gi ? 512 : 768, NINP}; pg8::StaticOrder So; So.init(T, gm.N, F.nwg, F.rank);
                    pg8::EpiBf16P E{(bf16_t*)(F.ws + WS_O + (gi ? OO_KVRAW : OO_QRAW)), gm.N}; pg8::gemm_phase<pg8::EpiBf16P, pg8::StaticOrder>(F.lds, gm, So, E, nullptr, MK_TID());
                    __syncthreads();
                }
            }
        } else if (st == 2) { if (MK_EN(4)) p_post2(F, l);
        } else if (st == 3) { if (MK_EN(5)) p_attention(F, l, gs);
        } else if (st == 4) { if (MK_EN(6)) p_post3(F, l);
        } else if (st == 5) {
            if (MK_EN(7)) { pg8::Gemm gm{(const bf16_t*)(F.ws + WS_O), (const bf16_t*)(lw + LW_WOUT), T, DM, DM}; pg8::StaticOrder So; So.init(T, DM, F.nwg, F.rank);
                pg8::EpiResF32N E{xin, F.out, DM, (bf16_t*)(F.ws + WS_HN), 1.0f / (O8_SCALE * WOUT8_SCALE)}; pg8::gemm_phase_f8<pg8::EpiResF32N, pg8::StaticOrder>(F.lds, gm, So, E, nullptr, MK_TID()); }
        } else if (st == 6) {
            if (MK_EN(9)) { pg8::Gemm gm{(const bf16_t*)(F.ws + WS_HN), (const bf16_t*)(lw + LW_W2), T, 2048, DM}; pg8::StaticOrder So; So.init(T, 2048, F.nwg, F.rank);
                pg8::EpiF32 E{(float*)(F.ws + WS_P + PO_SC), 2048, nullptr}; pg8::gemm_phase<pg8::EpiF32, pg8::StaticOrder>(F.lds, gm, So, E, nullptr, MK_TID()); }
        } else if (st == 7) { if (MK_EN(10)) p_select(F, l);
        } else { if (MK_EN(11)) p_gather(F, l, gs); }
        if (i + 1 < nsteps) { if (all || nall) MK_BAR(1); else MK_BAR(0); }
#undef lw
#undef xin
    }
}
}

extern "C" void kernel_launch(void* const* d_in, const int* in_sizes, int n_in, void* d_out, int out_size, void* d_ws, size_t ws_size, hipStream_t stream) {
    static int grid = 0;
    if (grid == 0) {
        if (n_in != 20 || out_size != mk::TT * mk::DM || ws_size < mk::WS_TOTAL) { fprintf(stderr, "kernel_launch: unexpected shapes (n_in %d out %d ws %zu, need %zu)\n", n_in, out_size, ws_size, (size_t)mk::WS_TOTAL); grid = -1; return; }
        int dev = 0, cus = 0, per_cu = 0;
        if (hipGetDevice(&dev) != hipSuccess || hipDeviceGetAttribute(&cus, hipDeviceAttributeMultiprocessorCount, dev) != hipSuccess) { grid = -1; return; }
        if (hipFuncSetAttribute((const void*)mk::mk_fwd, hipFuncAttributeMaxDynamicSharedMemorySize, mk::LDS_BYTES) != hipSuccess) { fprintf(stderr, "kernel_launch: hipFuncSetAttribute failed\n"); grid = -1; return; }
        if (hipOccupancyMaxActiveBlocksPerMultiprocessor(&per_cu, (const void*)mk::mk_fwd, mk::NTHR, mk::LDS_BYTES) != hipSuccess || per_cu < 1) { fprintf(stderr, "kernel_launch: occupancy query says %d\n", per_cu); }
        (void)hipGetLastError();
        grid = cus & ~15;
    }
    if (grid < 0) return;
    (void)hipMemsetAsync((char*)d_ws + mk::WS_CTL, 0, 65536, stream);
    mk::Args a{};
    for (int i = 0; i < 20; ++i) a.in[i] = (const float*)d_in[i];
    a.out = (float*)d_out; a.ws = (unsigned char*)d_ws;
    hipLaunchKernelGGL(mk::mk_fwd, dim3(grid), dim3(mk::NTHR), mk::LDS_BYTES, stream, a);
    const hipError_t le = hipPeekAtLastError();
    if (le != hipSuccess) fprintf(stderr, "kernel_launch: launch failed: %s\n", hipGetErrorName(le));
}
```

```cpp
#define MK_JTAIL 14
#define MK_NHEAD 5
#include <hip/hip_runtime.h>
#include <cstdio>
#include <cstdint>
#include <cstddef>
namespace pg8 {
#define PG8_LAS __attribute__((address_space(3)))
typedef unsigned short bf16_t;
typedef short bf16x8 __attribute__((ext_vector_type(8)));
typedef float f32x4 __attribute__((ext_vector_type(4)));
typedef unsigned u32x4 __attribute__((ext_vector_type(4)));
typedef int i32x8 __attribute__((ext_vector_type(8)));
typedef int i32x4 __attribute__((ext_vector_type(4)));
typedef int i32x16 __attribute__((ext_vector_type(16)));
typedef int i32x32 __attribute__((ext_vector_type(32)));
typedef float f32x32 __attribute__((ext_vector_type(32)));
constexpr int BM = 256, BK = 64, HALF = 128, HTB = HALF * BK * 2  , STAGE_BYTES = 8 * HTB, NXCD = 8, WGM = 4;

__host__ __device__ __forceinline__ int lds_byte(int r, int c) { const int st = (r >> 4) * 2 + (c >> 5), rr = r & 15, cc = c & 31, ob = rr * 64 + cc * 2; return st * 1024 + (ob ^ (((ob >> 9) & 1) << 5)); }
__host__ __device__ __forceinline__ void stage_rc(int b, int& R, int& C) { const int st = b / 1024, sb = b % 1024, swz = sb ^ (((sb >> 9) & 1) << 5); R = (st >> 1) * 16 + swz / 64; C = (st & 1) * 32 + (swz % 64) / 2; }
__host__ __device__ __forceinline__ int perm32(int rho) { const int n = rho >> 4, i = rho & 15; return 8 * (i >> 2) + 4 * n + (i & 3); }

struct Unit { int pm, pn; };
struct Gemm { const bf16_t* A; const bf16_t* Bt; int M, N, K; int lda = 0; };

struct StaticOrder {
    int nM, nN, nwg, G, c;
    __host__ __device__ void init(int M, int N, int G_, int c_) { nM = M / BM; nN = N / BM; nwg = nM * nN; G = G_; c = c_; }
    __host__ __device__ bool next(int i, Unit& u) const {
        const long L = (long)i * G + c; if (L >= nwg) return false;
        int wgid = (int)L; { const int q = nwg / NXCD, r = nwg % NXCD, xcd = wgid % NXCD, off = wgid / NXCD; wgid = (xcd < r ? xcd * (q + 1) : r * (q + 1) + (xcd - r) * q) + off; }
        const int nig = WGM * nN, gid = wgid / nig, fm = gid * WGM, gsz = (nM - fm) < WGM ? (nM - fm) : WGM;
        u.pm = fm + ((wgid % nig) % gsz); u.pn = (wgid % nig) / gsz; return true;
    }
    __device__ __forceinline__ void a_ready(const Unit&) const {}
    __device__ __forceinline__ void done(const Unit&) const {}
};
__device__ __forceinline__ unsigned cvt_pk_bf16(float lo, float hi) { unsigned r; asm volatile("v_cvt_pk_bf16_f32 %0, %1, %2" : "=v"(r) : "v"(lo), "v"(hi)); return r; }
typedef float f32x2 __attribute__((ext_vector_type(2)));
struct EpiF32 {
    static constexpr bool PERM = false, AFTER_DRAIN = false;
    float* C; int ldc; const float* bias;
    __device__ __forceinline__ void operator()(const f32x4 (&acc)[2][2][4][2], const Unit& u, int wr, int wc, int fr, int fq) const {
        const int row0 = u.pm * BM + wr * 64 + fr, col0 = u.pn * BM + wc * 32 + 4 * fq;
        f32x4 bv[2][2];
#pragma unroll
        for (int bj = 0; bj < 2; ++bj)
#pragma unroll
            for (int n = 0; n < 2; ++n) bv[bj][n] = bias ? *(const f32x4*)(bias + col0 + bj * HALF + n * 16) : (f32x4){0.f, 0.f, 0.f, 0.f};
#pragma unroll
        for (int ai = 0; ai < 2; ++ai)
#pragma unroll
            for (int m = 0; m < 4; ++m) { float* rowp = C + (size_t)(row0 + ai * HALF + m * 16) * ldc + col0;
#pragma unroll
                for (int bj = 0; bj < 2; ++bj)
#pragma unroll
                    for (int n = 0; n < 2; ++n) *(f32x4*)(rowp + bj * HALF + n * 16) = acc[ai][bj][m][n] + bv[bj][n]; }
    }
};
struct EpiBf16P {
    static constexpr bool PERM = true, AFTER_DRAIN = false;
    bf16_t* O; int ldc;
    __device__ __forceinline__ void operator()(const f32x4 (&acc)[2][2][4][2], const Unit& u, int wr, int wc, int fr, int fq) const {
        const int row0 = u.pm * BM + wr * 64 + fr, col0 = u.pn * BM + wc * 32 + 8 * fq;
#pragma unroll
        for (int ai = 0; ai < 2; ++ai)
#pragma unroll
            for (int m = 0; m < 4; ++m) { bf16_t* rowp = O + (size_t)(row0 + ai * HALF + m * 16) * ldc + col0;
#pragma unroll
                for (int bj = 0; bj < 2; ++bj) { const f32x4 v0 = acc[ai][bj][m][0], v1 = acc[ai][bj][m][1];
                    u32x4 w; w.x = cvt_pk_bf16(v0[0], v0[1]); w.y = cvt_pk_bf16(v0[2], v0[3]); w.z = cvt_pk_bf16(v1[0], v1[1]); w.w = cvt_pk_bf16(v1[2], v1[3]);
                    *(u32x4*)(rowp + bj * HALF) = w; } }
    }
};
struct EpiResF32 {
    static constexpr bool PERM = false, AFTER_DRAIN = false;
    const float* res; float* out; int ldc;
    __device__ __forceinline__ void operator()(const f32x4 (&acc)[2][2][4][2], const Unit& u, int wr, int wc, int fr, int fq) const {
        const int row0 = u.pm * BM + wr * 64 + fr, col0 = u.pn * BM + wc * 32 + 4 * fq;
#pragma unroll
        for (int ai = 0; ai < 2; ++ai)
#pragma unroll
            for (int m = 0; m < 4; ++m) { const size_t off = (size_t)(row0 + ai * HALF + m * 16) * ldc + col0;
#pragma unroll
                for (int bj = 0; bj < 2; ++bj)
#pragma unroll
                    for (int n = 0; n < 2; ++n) { const size_t o = off + bj * HALF + n * 16; const f32x4 r = *(const f32x4*)(res + o); *(f32x4*)(out + o) = r + acc[ai][bj][m][n]; } }
    }
};

struct EpiG1 {
    static constexpr bool PERM = true, AFTER_DRAIN = false;
    bf16_t* O; int ldc; bf16_t* vseg;
    size_t vstride; float oscale;
    __device__ __forceinline__ void operator()(const f32x4 (&acc)[2][2][4][2], const Unit& u, int wr, int wc, int fr, int fq) const {
        const int row0 = u.pm * BM + wr * 64 + fr, colt = u.pn * BM, seg = colt >> 10;
        const bool isv = (seg == 2) || (seg == 5) || (seg == 8);
#pragma unroll
        for (int ai = 0; ai < 2; ++ai)
#pragma unroll
            for (int m = 0; m < 4; ++m) { const int row = row0 + ai * HALF + m * 16;
#pragma unroll
                for (int bj = 0; bj < 2; ++bj) { const f32x4 v0 = acc[ai][bj][m][0] * oscale, v1 = acc[ai][bj][m][1] * oscale;
                    u32x4 w; w.x = cvt_pk_bf16(v0[0], v0[1]); w.y = cvt_pk_bf16(v0[2], v0[3]); w.z = cvt_pk_bf16(v1[0], v1[1]); w.w = cvt_pk_bf16(v1[2], v1[3]);
                    bf16_t* dst;
                    if (isv) { const int h = ((colt & 1023) >> 7) + bj; dst = vseg + (size_t)seg * vstride + ((size_t)((row >> 11) * 8 + h) * 2048 + (row & 2047)) * 128 + wc * 32 + 8 * fq; }
                    else dst = O + (size_t)row * ldc + colt + bj * HALF + wc * 32 + 8 * fq;
                    *(u32x4*)dst = w; } }
    }
};
struct EpiResF32N {
    static constexpr bool PERM = false, AFTER_DRAIN = false;
    const float* res; float* out; int ldc; bf16_t* xb; float oscale;
    __device__ __forceinline__ void operator()(const f32x4 (&acc)[2][2][4][2], const Unit& u, int wr, int wc, int fr, int fq) const {
        asm volatile("" : "+v"(fr), "+v"(fq));
        const int row0 = u.pm * BM + wr * 64 + fr, col0 = u.pn * BM + wc * 32 + 4 * fq;
        typedef unsigned u32x2e __attribute__((ext_vector_type(2)));
#pragma unroll
        for (int ai = 0; ai < 2; ++ai) { f32x4 r[4][2][2];
#pragma unroll
            for (int m = 0; m < 4; ++m)
#pragma unroll
                for (int bj = 0; bj < 2; ++bj)
#pragma unroll
                    for (int n = 0; n < 2; ++n) r[m][bj][n] = *(const f32x4*)(res + (size_t)(row0 + ai * HALF + m * 16) * ldc + col0 + bj * HALF + n * 16);
            asm volatile("" ::: "memory");
#pragma unroll
            for (int m = 0; m < 4; ++m)
#pragma unroll
                for (int bj = 0; bj < 2; ++bj)
#pragma unroll
                    for (int n = 0; n < 2; ++n) { const size_t o = (size_t)(row0 + ai * HALF + m * 16) * ldc + col0 + bj * HALF + n * 16;
                        const f32x4 v = r[m][bj][n] + acc[ai][bj][m][n] * oscale; *(f32x4*)(out + o) = v;
                        u32x2e w; w.x = cvt_pk_bf16(v[0], v[1]); w.y = cvt_pk_bf16(v[2], v[3]); *(u32x2e*)(xb + o) = w; }
            asm volatile("" ::: "memory"); }
    }
};

struct EpiG1N {
    static constexpr bool PERM = true, AFTER_DRAIN = false;
    bf16_t* O; int ldc; bf16_t* qkv;
    size_t vstride; float oscale; const float* gA; const float* gB; const float* gC;
    PG8_LAS float* X;
    __device__ __forceinline__ void operator()(const f32x4 (&acc)[2][2][4][2], const Unit& u, int wr, int wc, int fr, int fq) const {
        asm volatile("" : "+v"(fr), "+v"(fq));
        const int row0 = u.pm * BM + wr * 64 + fr, colt = u.pn * BM, seg = colt >> 10, which = seg % 3, mixer = seg / 3;
        if (seg >= 9 || which == 2) {
#pragma unroll
            for (int ai = 0; ai < 2; ++ai)
#pragma unroll
                for (int m = 0; m < 4; ++m) { const int row = row0 + ai * HALF + m * 16;
#pragma unroll
                    for (int bj = 0; bj < 2; ++bj) { const f32x4 v0 = acc[ai][bj][m][0] * oscale, v1 = acc[ai][bj][m][1] * oscale;
                        u32x4 w; w.x = cvt_pk_bf16(v0[0], v0[1]); w.y = cvt_pk_bf16(v0[2], v0[3]); w.z = cvt_pk_bf16(v1[0], v1[1]); w.w = cvt_pk_bf16(v1[2], v1[3]);
                        bf16_t* dst;
                        if (seg < 9) { const int h = ((colt & 1023) >> 7) + bj; dst = qkv + (size_t)seg * vstride + ((size_t)((row >> 11) * 8 + h) * 2048 + (row & 2047)) * 128 + wc * 32 + 8 * fq; }
                        else dst = O + (size_t)row * ldc + colt + bj * HALF + wc * 32 + 8 * fq;
                        *(u32x4*)dst = w; } }
            return;
        }
        const int lane = fr + 16 * fq;
        float ss[2][4][2];
#pragma unroll
        for (int ai = 0; ai < 2; ++ai)
#pragma unroll
            for (int m = 0; m < 4; ++m)
#pragma unroll
                for (int bj = 0; bj < 2; ++bj) { const f32x4 v0 = acc[ai][bj][m][0] * oscale, v1 = acc[ai][bj][m][1] * oscale;
                    float s = (v0[0] * v0[0] + v0[1] * v0[1]) + (v0[2] * v0[2] + v0[3] * v0[3]) + (v1[0] * v1[0] + v1[1] * v1[1]) + (v1[2] * v1[2] + v1[3] * v1[3]);
                    s += __int_as_float(__builtin_amdgcn_ds_bpermute((lane ^ 16) << 2, __float_as_int(s)));
                    s += __int_as_float(__builtin_amdgcn_ds_bpermute((lane ^ 32) << 2, __float_as_int(s)));
                    ss[ai][m][bj] = s; }
        if (fq == 0) {
#pragma unroll
            for (int ai = 0; ai < 2; ++ai)
#pragma unroll
                for (int m = 0; m < 4; ++m)
#pragma unroll
                    for (int bj = 0; bj < 2; ++bj) X[(((wr * 128) + ai * 64 + m * 16 + fr) * 2 + bj) * 4 + wc] = ss[ai][m][bj]; }
        asm volatile("s_waitcnt lgkmcnt(0)" ::: "memory"); __builtin_amdgcn_s_barrier(); asm volatile("" ::: "memory");
        const float* g = (mixer == 0 ? gA + which * 64 + (wc & 1) * 32 : (mixer == 1 ? gB : gC) + which * 128 + wc * 32) + 8 * fq;
        const f32x4 g0 = *(const f32x4*)g, g1 = *(const f32x4*)(g + 4);
        const float qs = which == 0 ? (mixer == 0 ? 0.125f : 0.08838834764831845f) : 1.0f;
#pragma unroll
        for (int ai = 0; ai < 2; ++ai)
#pragma unroll
            for (int m = 0; m < 4; ++m) { const int row = row0 + ai * HALF + m * 16;
#pragma unroll
                for (int bj = 0; bj < 2; ++bj) { const f32x4 pw = *(const PG8_LAS f32x4*)(X + (((wr * 128) + ai * 64 + m * 16 + fr) * 2 + bj) * 4);
                    float tot, inv; if (mixer == 0) { tot = (wc & 2) ? (pw[2] + pw[3]) : (pw[0] + pw[1]); inv = 1.0f / 64; } else { tot = (pw[0] + pw[1]) + (pw[2] + pw[3]); inv = 1.0f / 128; }
                    const float r = rsqrtf(tot * inv + 1e-6f) * qs * oscale;
                    const f32x4 v0 = acc[ai][bj][m][0] * r * g0, v1 = acc[ai][bj][m][1] * r * g1;
                    u32x4 w; w.x = cvt_pk_bf16(v0[0], v0[1]); w.y = cvt_pk_bf16(v0[2], v0[3]); w.z = cvt_pk_bf16(v1[0], v1[1]); w.w = cvt_pk_bf16(v1[2], v1[3]);
                    const int h = ((colt & 1023) >> 7) + bj; bf16_t* dst;
                    if (mixer == 0) dst = qkv + (size_t)seg * vstride + ((size_t)((row >> 11) * 16 + 2 * h + (wc >> 1)) * 2048 + (row & 2047)) * 64 + (wc & 1) * 32 + 8 * fq;
                    else dst = qkv + (size_t)seg * vstride + ((size_t)((row >> 11) * 8 + h) * 2048 + (row & 2047)) * 128 + wc * 32 + 8 * fq;
                    *(u32x4*)dst = w; } }
    }
};

template <class Epi, class Sched, bool STAMP = false>
__device__ __forceinline__ void gemm_phase(PG8_LAS unsigned char* lds, const Gemm g, const Sched& S, const Epi& E, unsigned long long* stamps, int tid_in) {
    int tid_ = tid_in; asm volatile("" : "+v"(tid_));
    const int tid = tid_, wid = __builtin_amdgcn_readfirstlane(tid >> 6), lane = tid & 63, wr = wid >> 2, wc = wid & 3, fr = lane & 15, fq = lane >> 4;
    const int K = g.K, nt = K / BK, LDA = g.lda ? g.lda : g.K;
    int ts_lo = 0, ts_hi = 0, nts = 0; const unsigned long long rt_entry = STAMP ? (unsigned long long)wall_clock64() : 0ull;
#define PG8_STAMP() do { if (STAMP && wid == 0 && nts < 64) { const unsigned long long _c = (unsigned long long)clock64(); \
        ts_lo = (lane == nts) ? (int)(unsigned)_c : ts_lo; ts_hi = (lane == nts) ? (int)(unsigned)(_c >> 32) : ts_hi; ++nts; } } while (0)
    PG8_STAMP();
    unsigned voffA[2], voffB[2];
#pragma unroll
    for (int i = 0; i < 2; ++i) { int R, C; stage_rc(tid * 16 + i * 8192, R, C); const int Rb = Epi::PERM ? ((R & ~31) + perm32(R & 31)) : R;
        voffA[i] = (unsigned)(R * LDA + C) * 2u; voffB[i] = (unsigned)(Rb * K + C) * 2u; }
    const size_t kstep = (size_t)(BK * 2);
    const size_t hstep = (size_t)HALF * K * 2;
    const size_t tstep = 2 * hstep;
    const size_t hstepA = (size_t)HALF * LDA * 2, tstepA = 2 * hstepA;
    const unsigned ldsw = (unsigned)wid * 1024u;
    const int aoff = lds_byte(wr * 64 + fr, fq * 8), boff = lds_byte(wc * 32 + fr, fq * 8);
#define PG8_SA(b, h) (((b) * 2 + (h)) * HTB)
#define PG8_SB(b, h) ((4 + (b) * 2 + (h)) * HTB)
#define PG8_STAGE(bufoff, gbase, voff) do { _Pragma("unroll") for (int _i = 0; _i < 2; ++_i) \
        __builtin_amdgcn_global_load_lds((const unsigned*)((const char*)(gbase) + (voff)[_i]), (PG8_LAS unsigned*)(lds + (bufoff) + ldsw + _i * 8192), 16, 0, 0); } while (0)
#define PG8_LDA(dst, b, h) do { _Pragma("unroll") for (int m = 0; m < 4; ++m) _Pragma("unroll") for (int k = 0; k < 2; ++k) dst[m][k] = *(const PG8_LAS bf16x8*)(lds + PG8_SA(b, h) + aoff + m * 2048 + k * 1024); } while (0)
#define PG8_LDB(dst, b, h) do { _Pragma("unroll") for (int n = 0; n < 2; ++n) _Pragma("unroll") for (int k = 0; k < 2; ++k) dst[n][k] = *(const PG8_LAS bf16x8*)(lds + PG8_SB(b, h) + boff + n * 2048 + k * 1024); } while (0)
#define PG8_MMA(ai, bj, At, Bt) do { __builtin_amdgcn_s_setprio(1); _Pragma("unroll") for (int m = 0; m < 4; ++m) _Pragma("unroll") for (int n = 0; n < 2; ++n) _Pragma("unroll") for (int k = 0; k < 2; ++k) \
        acc[ai][bj][m][n] = __builtin_amdgcn_mfma_f32_16x16x32_bf16(Bt[n][k], At[m][k], acc[ai][bj][m][n], 0, 0, 0); __builtin_amdgcn_s_setprio(0); } while (0)
#define PG8_WAIT_V(n) asm volatile("s_waitcnt vmcnt(" #n ")" ::: "memory")
#define PG8_WAIT_L(n) asm volatile("s_waitcnt lgkmcnt(" #n ")" ::: "memory")
#define PG8_BAR __builtin_amdgcn_s_barrier()
#define PG8_SCHED __builtin_amdgcn_sched_barrier(0)
    Unit cur, nxt; int ui = 0;
    if (!S.next(0, cur)) return;
    f32x4 acc[2][2][4][2];
#pragma unroll
    for (int a = 0; a < 2; ++a)
#pragma unroll
        for (int b = 0; b < 2; ++b)
#pragma unroll
            for (int m = 0; m < 4; ++m)
#pragma unroll
                for (int n = 0; n < 2; ++n) acc[a][b][m][n] = (f32x4){0.f, 0.f, 0.f, 0.f};
    bf16x8 At[4][2], B0[2][2], B1[2][2];
    const char* cA = (const char*)g.A + (size_t)cur.pm * tstepA; const char* cB = (const char*)g.Bt + (size_t)cur.pn * tstep;
    S.a_ready(cur);
    PG8_STAGE(PG8_SB(0, 0), cB, voffB); PG8_STAGE(PG8_SA(0, 0), cA, voffA); PG8_STAGE(PG8_SB(0, 1), cB + hstep, voffB); PG8_STAGE(PG8_SA(0, 1), cA + hstepA, voffA);
    if (wr == 1) PG8_BAR;
    PG8_WAIT_V(4); PG8_BAR;
    PG8_STAGE(PG8_SB(1, 0), cB + kstep, voffB); PG8_STAGE(PG8_SA(1, 0), cA + kstep, voffA); PG8_STAGE(PG8_SB(1, 1), cB + hstep + kstep, voffB);
    PG8_WAIT_V(6); PG8_BAR;
    PG8_STAMP();
    for (;;) {
        const bool has_next = S.next(ui + 1, nxt);
        const char* nA = has_next ? (const char*)g.A + (size_t)nxt.pm * tstepA : cA; const char* nB = has_next ? (const char*)g.Bt + (size_t)nxt.pn * tstep : cB;
        for (int t = 0; t < nt; t += 2) {
            const bool last = (t == nt - 2);
            const char* a1 = cA + (size_t)(t + 1) * kstep;
            const char* a2 = last ? nA : cA + (size_t)(t + 2) * kstep; const char* b2 = last ? nB : cB + (size_t)(t + 2) * kstep;
            const char* a3 = a2 + kstep; const char* b3 = b2 + kstep;
            if (last && has_next) S.a_ready(nxt);
            PG8_LDB(B0, 0, 0); PG8_SCHED; PG8_LDA(At, 0, 0); PG8_STAGE(PG8_SA(1, 1), a1 + hstepA, voffA);
            PG8_WAIT_L(8); PG8_BAR; PG8_WAIT_L(0); PG8_MMA(0, 0, At, B0); PG8_BAR; PG8_SCHED;
            PG8_LDB(B1, 0, 1); PG8_STAGE(PG8_SB(0, 0), b2, voffB);
            PG8_BAR; PG8_WAIT_L(0); PG8_MMA(0, 1, At, B1); PG8_BAR;
            PG8_LDA(At, 0, 1); PG8_STAGE(PG8_SA(0, 0), a2, voffA);
            PG8_BAR; PG8_WAIT_L(0); PG8_MMA(1, 0, At, B0); PG8_BAR; PG8_SCHED;
            PG8_STAGE(PG8_SB(0, 1), b2 + hstep, voffB);
            PG8_WAIT_V(6); PG8_BAR; PG8_MMA(1, 1, At, B1); PG8_BAR;
            PG8_LDB(B0, 1, 0); PG8_SCHED; PG8_LDA(At, 1, 0); PG8_STAGE(PG8_SA(0, 1), a2 + hstepA, voffA);
            PG8_WAIT_L(8); PG8_BAR; PG8_WAIT_L(0); PG8_MMA(0, 0, At, B0); PG8_BAR; PG8_SCHED;
            PG8_LDB(B1, 1, 1); PG8_STAGE(PG8_SB(1, 0), b3, voffB);
            PG8_BAR; PG8_WAIT_L(0); PG8_MMA(0, 1, At, B1); PG8_BAR;
            PG8_LDA(At, 1, 1); PG8_STAGE(PG8_SA(1, 0), a3, voffA);
            PG8_BAR; PG8_WAIT_L(0); PG8_MMA(1, 0, At, B0); PG8_BAR; PG8_SCHED;
            PG8_STAGE(PG8_SB(1, 1), b3 + hstep, voffB);
            PG8_WAIT_V(6); PG8_BAR; PG8_MMA(1, 1, At, B1); PG8_BAR;
        }
        PG8_STAMP();
        if constexpr (!Epi::AFTER_DRAIN) { E(acc, cur, wr, wc, fr, fq); S.done(cur); }
        PG8_STAMP();
        if (!has_next) break;
#pragma unroll
        for (int a = 0; a < 2; ++a)
#pragma unroll
            for (int b = 0; b < 2; ++b)
#pragma unroll
                for (int m = 0; m < 4; ++m)
#pragma unroll
                    for (int n = 0; n < 2; ++n) acc[a][b][m][n] = (f32x4){0.f, 0.f, 0.f, 0.f};
        cur = nxt; cA = nA; cB = nB; ++ui;
    }
    PG8_WAIT_V(0);
    if (wr == 0) PG8_BAR;
    PG8_BAR;
    if constexpr (Epi::AFTER_DRAIN) { E.fused(acc, cur, wr, wc, fr, fq, lds, wid, lane); S.done(cur); }
    PG8_STAMP();
    if (STAMP && wid == 0) { stamps[lane] = lane < nts ? (((unsigned long long)(unsigned)ts_hi << 32) | (unsigned)ts_lo) : 0ull;
        if (lane == 62) stamps[62] = rt_entry; if (lane == 63) stamps[63] = (unsigned long long)wall_clock64(); }
#undef PG8_STAMP
#undef PG8_SA
#undef PG8_SB
#undef PG8_STAGE
#undef PG8_LDA
#undef PG8_LDB
#undef PG8_MMA
#undef PG8_WAIT_V
#undef PG8_WAIT_L
#undef PG8_BAR
#undef PG8_SCHED
}

template <class Epi, class Sched, bool STAMP = false>
__device__ __forceinline__ void gemm_phase_f8(PG8_LAS unsigned char* lds, const Gemm g, const Sched& S, const Epi& E, unsigned long long* stamps, int tid_in) {
    int tid_ = tid_in; asm volatile("" : "+v"(tid_));
    const int tid = tid_, wid = __builtin_amdgcn_readfirstlane(tid >> 6), lane = tid & 63, wr = wid >> 2, wc = wid & 3, fr = lane & 15, fq = lane >> 4;
    const int K = g.K, nt = K / 128;
    int ts_lo = 0, ts_hi = 0, nts = 0; const unsigned long long rt_entry = STAMP ? (unsigned long long)wall_clock64() : 0ull;
#define PG8_STAMP() do { if (STAMP && wid == 0 && nts < 64) { const unsigned long long _c = (unsigned long long)clock64(); \
        ts_lo = (lane == nts) ? (int)(unsigned)_c : ts_lo; ts_hi = (lane == nts) ? (int)(unsigned)(_c >> 32) : ts_hi; ++nts; } } while (0)
    PG8_STAMP();
    unsigned voffA[2], voffB[2];
#pragma unroll
    for (int i = 0; i < 2; ++i) { int R, C; stage_rc(tid * 16 + i * 8192, R, C); const int Rb = Epi::PERM ? ((R & ~31) + perm32(R & 31)) : R;
        voffA[i] = (unsigned)(R * K + C * 2); voffB[i] = (unsigned)(Rb * K + C * 2); }
    const size_t kstep = (size_t)(BK * 2);
    const size_t hstep = (size_t)HALF * K;
    const size_t tstep = 2 * hstep;
    const unsigned ldsw = (unsigned)wid * 1024u;
    const int aoff = lds_byte(wr * 64 + fr, fq * 16), boff = lds_byte(wc * 32 + fr, fq * 16);
    const int aoffk[2] = {aoff + 16 * (fq & 1), aoff + 16 * ((fq & 1) ^ 1)}, boffk[2] = {boff + 16 * (fq & 1), boff + 16 * ((fq & 1) ^ 1)};
#define PG8_SA(b, h) (((b) * 2 + (h)) * HTB)
#define PG8_SB(b, h) ((4 + (b) * 2 + (h)) * HTB)
#define PG8_STAGE(bufoff, gbase, voff) do { _Pragma("unroll") for (int _i = 0; _i < 2; ++_i) \
        __builtin_amdgcn_global_load_lds((const unsigned*)((const char*)(gbase) + (voff)[_i]), (PG8_LAS unsigned*)(lds + (bufoff) + ldsw + _i * 8192), 16, 0, 0); } while (0)
#define PG8_LDA(dst, b, h) do { _Pragma("unroll") for (int m = 0; m < 4; ++m) _Pragma("unroll") for (int k = 0; k < 2; ++k) { const i32x4 t_ = *(const PG8_LAS i32x4*)(lds + PG8_SA(b, h) + aoffk[k] + m * 2048); \
        dst[m * 8 + k * 4 + 0] = t_[0]; dst[m * 8 + k * 4 + 1] = t_[1]; dst[m * 8 + k * 4 + 2] = t_[2]; dst[m * 8 + k * 4 + 3] = t_[3]; } } while (0)
#define PG8_LDB(dst, b, h) do { _Pragma("unroll") for (int n = 0; n < 2; ++n) _Pragma("unroll") for (int k = 0; k < 2; ++k) { const i32x4 t_ = *(const PG8_LAS i32x4*)(lds + PG8_SB(b, h) + boffk[k] + n * 2048); \
        dst[n * 8 + k * 4 + 0] = t_[0]; dst[n * 8 + k * 4 + 1] = t_[1]; dst[n * 8 + k * 4 + 2] = t_[2]; dst[n * 8 + k * 4 + 3] = t_[3]; } } while (0)
#define PG8_MMA(ai, bj, At, Bt) do { __builtin_amdgcn_s_setprio(1); \
        { f32x4 c_ = __builtin_shufflevector(accv[ai][bj], accv[ai][bj], 0, 1, 2, 3); c_ = __builtin_amdgcn_mfma_scale_f32_16x16x128_f8f6f4(__builtin_shufflevector(Bt, Bt, 0, 1, 2, 3, 4, 5, 6, 7), __builtin_shufflevector(At, At, 0, 1, 2, 3, 4, 5, 6, 7), c_, 0, 0, 0, 0, 0, 0); accv[ai][bj] = __builtin_shufflevector(accv[ai][bj], __builtin_shufflevector(c_, c_, 0, 1, 2, 3, -1, -1, -1, -1, -1, -1, -1, -1, -1, -1, -1, -1, -1, -1, -1, -1, -1, -1, -1, -1, -1, -1, -1, -1, -1, -1, -1, -1), 32, 33, 34, 35, 4, 5, 6, 7, 8, 9, 10, 11, 12, 13, 14, 15, 16, 17, 18, 19, 20, 21, 22, 23, 24, 25, 26, 27, 28, 29, 30, 31); } \
        { f32x4 c_ = __builtin_shufflevector(accv[ai][bj], accv[ai][bj], 4, 5, 6, 7); c_ = __builtin_amdgcn_mfma_scale_f32_16x16x128_f8f6f4(__builtin_shufflevector(Bt, Bt, 8, 9, 10, 11, 12, 13, 14, 15), __builtin_shufflevector(At, At, 0, 1, 2, 3, 4, 5, 6, 7), c_, 0, 0, 0, 0, 0, 0); accv[ai][bj] = __builtin_shufflevector(accv[ai][bj], __builtin_shufflevector(c_, c_, 0, 1, 2, 3, -1, -1, -1, -1, -1, -1, -1, -1, -1, -1, -1, -1, -1, -1, -1, -1, -1, -1, -1, -1, -1, -1, -1, -1, -1, -1, -1, -1), 0, 1, 2, 3, 32, 33, 34, 35, 8, 9, 10, 11, 12, 13, 14, 15, 16, 17, 18, 19, 20, 21, 22, 23, 24, 25, 26, 27, 28, 29, 30, 31); } \
        { f32x4 c_ = __builtin_shufflevector(accv[ai][bj], accv[ai][bj], 8, 9, 10, 11); c_ = __builtin_amdgcn_mfma_scale_f32_16x16x128_f8f6f4(__builtin_shufflevector(Bt, Bt, 0, 1, 2, 3, 4, 5, 6, 7), __builtin_shufflevector(At, At, 8, 9, 10, 11, 12, 13, 14, 15), c_, 0, 0, 0, 0, 0, 0); accv[ai][bj] = __builtin_shufflevector(accv[ai][bj], __builtin_shufflevector(c_, c_, 0, 1, 2, 3, -1, -1, -1, -1, -1, -1, -1, -1, -1, -1, -1, -1, -1, -1, -1, -1, -1, -1, -1, -1, -1, -1, -1, -1, -1, -1, -1, -1), 0, 1, 2, 3, 4, 5, 6, 7, 32, 33, 34, 35, 12, 13, 14, 15, 16, 17, 18, 19, 20, 21, 22, 23, 24, 25, 26, 27, 28, 29, 30, 31); } \
        { f32x4 c_ = __builtin_shufflevector(accv[ai][bj], accv[ai][bj], 12, 13, 14, 15); c_ = __builtin_amdgcn_mfma_scale_f32_16x16x128_f8f6f4(__builtin_shufflevector(Bt, Bt, 8, 9, 10, 11, 12, 13, 14, 15), __builtin_shufflevector(At, At, 8, 9, 10, 11, 12, 13, 14, 15), c_, 0, 0, 0, 0, 0, 0); accv[ai][bj] = __builtin_shufflevector(accv[ai][bj], __builtin_shufflevector(c_, c_, 0, 1, 2, 3, -1, -1, -1, -1, -1, -1, -1, -1, -1, -1, -1, -1, -1, -1, -1, -1, -1, -1, -1, -1, -1, -1, -1, -1, -1, -1, -1, -1), 0, 1, 2, 3, 4, 5, 6, 7, 8, 9, 10, 11, 32, 33, 34, 35, 16, 17, 18, 19, 20, 21, 22, 23, 24, 25, 26, 27, 28, 29, 30, 31); } \
        { f32x4 c_ = __builtin_shufflevector(accv[ai][bj], accv[ai][bj], 16, 17, 18, 19); c_ = __builtin_amdgcn_mfma_scale_f32_16x16x128_f8f6f4(__builtin_shufflevector(Bt, Bt, 0, 1, 2, 3, 4, 5, 6, 7), __builtin_shufflevector(At, At, 16, 17, 18, 19, 20, 21, 22, 23), c_, 0, 0, 0, 0, 0, 0); accv[ai][bj] = __builtin_shufflevector(accv[ai][bj], __builtin_shufflevector(c_, c_, 0, 1, 2, 3, -1, -1, -1, -1, -1, -1, -1, -1, -1, -1, -1, -1, -1, -1, -1, -1, -1, -1, -1, -1, -1, -1, -1, -1, -1, -1, -1, -1), 0, 1, 2, 3, 4, 5, 6, 7, 8, 9, 10, 11, 12, 13, 14, 15, 32, 33, 34, 35, 20, 21, 22, 23, 24, 25, 26, 27, 28, 29, 30, 31); } \
        { f32x4 c_ = __builtin_shufflevector(accv[ai][bj], accv[ai][bj], 20, 21, 22, 23); c_ = __builtin_amdgcn_mfma_scale_f32_16x16x128_f8f6f4(__builtin_shufflevector(Bt, Bt, 8, 9, 10, 11, 12, 13, 14, 15), __builtin_shufflevector(At, At, 16, 17, 18, 19, 20, 21, 22, 23), c_, 0, 0, 0, 0, 0, 0); accv[ai][bj] = __builtin_shufflevector(accv[ai][bj], __builtin_shufflevector(c_, c_, 0, 1, 2, 3, -1, -1, -1, -1, -1, -1, -1, -1, -1, -1, -1, -1, -1, -1, -1, -1, -1, -1, -1, -1, -1, -1, -1, -1, -1, -1, -1, -1), 0, 1, 2, 3, 4, 5, 6, 7, 8, 9, 10, 11, 12, 13, 14, 15, 16, 17, 18, 19, 32, 33, 34, 35, 24, 25, 26, 27, 28, 29, 30, 31); } \
        { f32x4 c_ = __builtin_shufflevector(accv[ai][bj], accv[ai][bj], 24, 25, 26, 27); c_ = __builtin_amdgcn_mfma_scale_f32_16x16x128_f8f6f4(__builtin_shufflevector(Bt, Bt, 0, 1, 2, 3, 4, 5, 6, 7), __builtin_shufflevector(At, At, 24, 25, 26, 27, 28, 29, 30, 31), c_, 0, 0, 0, 0, 0, 0); accv[ai][bj] = __builtin_shufflevector(accv[ai][bj], __builtin_shufflevector(c_, c_, 0, 1, 2, 3, -1, -1, -1, -1, -1, -1, -1, -1, -1, -1, -1, -1, -1, -1, -1, -1, -1, -1, -1, -1, -1, -1, -1, -1, -1, -1, -1, -1), 0, 1, 2, 3, 4, 5, 6, 7, 8, 9, 10, 11, 12, 13, 14, 15, 16, 17, 18, 19, 20, 21, 22, 23, 32, 33, 34, 35, 28, 29, 30, 31); } \
        { f32x4 c_ = __builtin_shufflevector(accv[ai][bj], accv[ai][bj], 28, 29, 30, 31); c_ = __builtin_amdgcn_mfma_scale_f32_16x16x128_f8f6f4(__builtin_shufflevector(Bt, Bt, 8, 9, 10, 11, 12, 13, 14, 15), __builtin_shufflevector(At, At, 24, 25, 26, 27, 28, 29, 30, 31), c_, 0, 0, 0, 0, 0, 0); accv[ai][bj] = __builtin_shufflevector(accv[ai][bj], __builtin_shufflevector(c_, c_, 0, 1, 2, 3, -1, -1, -1, -1, -1, -1, -1, -1, -1, -1, -1, -1, -1, -1, -1, -1, -1, -1, -1, -1, -1, -1, -1, -1, -1, -1, -1, -1), 0, 1, 2, 3, 4, 5, 6, 7, 8, 9, 10, 11, 12, 13, 14, 15, 16, 17, 18, 19, 20, 21, 22, 23, 24, 25, 26, 27, 32, 33, 34, 35); } \
        __builtin_amdgcn_s_setprio(0); } while (0)
#define PG8_WAIT_V(n) asm volatile("s_waitcnt vmcnt(" #n ")" ::: "memory")
#define PG8_WAIT_L(n) asm volatile("s_waitcnt lgkmcnt(" #n ")" ::: "memory")
#define PG8_BAR __builtin_amdgcn_s_barrier()
#define PG8_SCHED __builtin_amdgcn_sched_barrier(0)
    Unit cur, nxt; int ui = 0;
    if (!S.next(0, cur)) return;
    f32x32 accv[2][2];
#pragma unroll
    for (int a = 0; a < 2; ++a)
#pragma unroll
        for (int b = 0; b < 2; ++b) accv[a][b] = f32x32{};
    i32x32 At; i32x16 B0, B1;
    const char* cA = (const char*)g.A + (size_t)cur.pm * tstep; const char* cB = (const char*)g.Bt + (size_t)cur.pn * tstep;
    S.a_ready(cur);
    PG8_STAGE(PG8_SB(0, 0), cB, voffB); PG8_STAGE(PG8_SA(0, 0), cA, voffA); PG8_STAGE(PG8_SB(0, 1), cB + hstep, voffB); PG8_STAGE(PG8_SA(0, 1), cA + hstep, voffA);
    if (wr == 1) PG8_BAR;
    PG8_WAIT_V(4); PG8_BAR;
    PG8_STAGE(PG8_SB(1, 0), cB + kstep, voffB); PG8_STAGE(PG8_SA(1, 0), cA + kstep, voffA); PG8_STAGE(PG8_SB(1, 1), cB + hstep + kstep, voffB);
    PG8_WAIT_V(6); PG8_BAR;
    PG8_STAMP();
    for (;;) {
        const bool has_next = S.next(ui + 1, nxt);
        const char* nA = has_next ? (const char*)g.A + (size_t)nxt.pm * tstep : cA; const char* nB = has_next ? (const char*)g.Bt + (size_t)nxt.pn * tstep : cB;
        for (int t = 0; t < nt; t += 2) {
            const bool last = (t == nt - 2);
            const char* a1 = cA + (size_t)(t + 1) * kstep;
            const char* a2 = last ? nA : cA + (size_t)(t + 2) * kstep; const char* b2 = last ? nB : cB + (size_t)(t + 2) * kstep;
            const char* a3 = a2 + kstep; const char* b3 = b2 + kstep;
            if (last && has_next) S.a_ready(nxt);
            PG8_LDB(B0, 0, 0); PG8_SCHED; PG8_LDA(At, 0, 0); PG8_STAGE(PG8_SA(1, 1), a1 + hstep, voffA);
            PG8_WAIT_L(8); PG8_BAR; PG8_WAIT_L(0); PG8_MMA(0, 0, At, B0); PG8_BAR; PG8_SCHED;
            PG8_LDB(B1, 0, 1); PG8_STAGE(PG8_SB(0, 0), b2, voffB);
            PG8_BAR; PG8_WAIT_L(0); PG8_MMA(0, 1, At, B1); PG8_BAR;
            PG8_LDA(At, 0, 1); PG8_STAGE(PG8_SA(0, 0), a2, voffA);
            PG8_BAR; PG8_WAIT_L(0); PG8_MMA(1, 0, At, B0); PG8_BAR; PG8_SCHED;
            PG8_STAGE(PG8_SB(0, 1), b2 + hstep, voffB);
            PG8_WAIT_V(6); PG8_BAR; PG8_MMA(1, 1, At, B1); PG8_BAR;
            PG8_LDB(B0, 1, 0); PG8_SCHED; PG8_LDA(At, 1, 0); PG8_STAGE(PG8_SA(0, 1), a2 + hstep, voffA);
            PG8_WAIT_L(8); PG8_BAR; PG8_WAIT_L(0); PG8_MMA(0, 0, At, B0); PG8_BAR; PG8_SCHED;
            PG8_LDB(B1, 1, 1); PG8_STAGE(PG8_SB(1, 0), b3, voffB);
            PG8_BAR; PG8_WAIT_L(0); PG8_MMA(0, 1, At, B1); PG8_BAR;
            PG8_LDA(At, 1, 1); PG8_STAGE(PG8_SA(1, 0), a3, voffA);
            PG8_BAR; PG8_WAIT_L(0); PG8_MMA(1, 0, At, B0); PG8_BAR; PG8_SCHED;
            PG8_STAGE(PG8_SB(1, 1), b3 + hstep, voffB);
            PG8_WAIT_V(6); PG8_BAR; PG8_MMA(1, 1, At, B1); PG8_BAR;
        }
        PG8_STAMP();
        if constexpr (!Epi::AFTER_DRAIN) { f32x4 acc[2][2][4][2];
#pragma unroll
            for (int a = 0; a < 2; ++a)
#pragma unroll
                for (int b = 0; b < 2; ++b)
#pragma unroll
                    for (int m = 0; m < 4; ++m)
#pragma unroll
                        for (int n = 0; n < 2; ++n) { const int q_ = 4 * (m * 2 + n); acc[a][b][m][n] = (f32x4){accv[a][b][q_], accv[a][b][q_ + 1], accv[a][b][q_ + 2], accv[a][b][q_ + 3]}; }
            E(acc, cur, wr, wc, fr, fq); S.done(cur); }
        PG8_STAMP();
        if (!has_next) break;
#pragma unroll
        for (int a = 0; a < 2; ++a)
#pragma unroll
            for (int b = 0; b < 2; ++b) accv[a][b] = f32x32{};
        cur = nxt; cA = nA; cB = nB; ++ui;
    }
    PG8_WAIT_V(0);
    if (wr == 0) PG8_BAR;
    PG8_BAR;
    static_assert(!Epi::AFTER_DRAIN, "no fused epilogues in the fp8 body");
    PG8_STAMP();
    if (STAMP && wid == 0) { stamps[lane] = lane < nts ? (((unsigned long long)(unsigned)ts_hi << 32) | (unsigned)ts_lo) : 0ull;
        if (lane == 62) stamps[62] = rt_entry; if (lane == 63) stamps[63] = (unsigned long long)wall_clock64(); }
#undef PG8_STAMP
#undef PG8_SA
#undef PG8_SB
#undef PG8_STAGE
#undef PG8_LDA
#undef PG8_LDB
#undef PG8_MMA
#undef PG8_WAIT_V
#undef PG8_WAIT_L
#undef PG8_BAR
#undef PG8_SCHED
}

}

#define XB_TMO      128
#define XB_XCNT(j)  (256  + 64 * (j))
#define XB_XSUB(j)  (1280 + 64 * (j))
#define XB_XGEN(j)  (2304 + 64 * (j))
#define XB_TOP      3328
#define XB_TOPGEN   3392
#define XCD_BAR_WORDS 3456
#define XB_SPIN_CAP (1u << 18)
#define LAS __attribute__((address_space(3)))

__device__ __forceinline__ unsigned xb_ld(unsigned* p)              { return __hip_atomic_load(p, __ATOMIC_RELAXED, __HIP_MEMORY_SCOPE_AGENT); }
__device__ __forceinline__ unsigned xb_add(unsigned* p, unsigned v) { return __hip_atomic_fetch_add(p, v, __ATOMIC_RELAXED, __HIP_MEMORY_SCOPE_AGENT); }
__device__ __forceinline__ unsigned xb_xcc_id() { return (unsigned)__builtin_amdgcn_s_getreg((3 << 11) | 20) & 0xFu; }
#define XB_SPIN(cond, bar) do { unsigned _sp = 0; while (cond) { __builtin_amdgcn_s_sleep(1); \
    if ((++_sp & 255u) == 0u) { if (xb_ld(&(bar)[XB_TMO])) break; if (_sp > XB_SPIN_CAP) { atomicAdd(&(bar)[XB_TMO], 1u); break; } } } } while (0)

struct XcdBarrier {
    unsigned* bar; unsigned x; unsigned G;
    volatile LAS unsigned* st;
};

__device__ __forceinline__ XcdBarrier xcd_barrier_post(unsigned* bar, volatile LAS unsigned* st, bool t0  ) {
    XcdBarrier b; b.bar = bar; b.x = xb_xcc_id(); b.st = st; b.G = 0u;
    if (t0) (void)xb_add(&bar[XB_XCNT(b.x)], 1u);
    return b;
}
__device__ __forceinline__ void xcd_barrier_complete(unsigned* bar, unsigned x, unsigned G, unsigned& nloc, unsigned& nx) {
    unsigned sum, cnt, mine, sp = 0u;
    for (;;) {
        sum = 0u; cnt = 0u; mine = 0u;
#pragma unroll
        for (unsigned j = 0; j < 16; ++j) { const unsigned c = xb_ld(&bar[XB_XCNT(j)]); sum += c; cnt += (c > 0u) ? 1u : 0u; mine = (j == x) ? c : mine; }
        if (sum == G) break;
        __builtin_amdgcn_s_sleep(1);
        if ((++sp & 255u) == 0u) { if (xb_ld(&bar[XB_TMO])) break; if (sp > XB_SPIN_CAP) { atomicAdd(&bar[XB_TMO], 1u); break; } }
    }
    nloc = mine > 0u ? mine : 1u; nx = cnt > 0u ? cnt : 1u;
}

__device__ __forceinline__ void xcd_barrier(const XcdBarrier& b, bool t0  ) {
    asm volatile("s_waitcnt vmcnt(0)" ::: "memory");
    __syncthreads();
    if (t0) {
        unsigned* bar = b.bar;
        __builtin_amdgcn_s_waitcnt(0);
        unsigned nloc = b.st[0], nx = b.st[1];
        if (nloc == 0u) { xcd_barrier_complete(bar, b.x, b.G, nloc, nx); b.st[0] = nloc; b.st[1] = nx; }
        const unsigned old = xb_add(&bar[XB_XSUB(b.x)], 1u);
        const unsigned gen = old / nloc;
        if (old + 1u == (gen + 1u) * nloc) {
            __builtin_amdgcn_fence(__ATOMIC_RELEASE, "agent");
            asm volatile("s_waitcnt vmcnt(0)" ::: "memory");
            const unsigned og = xb_add(&bar[XB_TOP], 1u);
            const unsigned tg = og / nx;
            if (og + 1u == (tg + 1u) * nx) xb_add(&bar[XB_TOPGEN], 1u);
            else XB_SPIN(xb_ld(&bar[XB_TOPGEN]) == tg, bar);
            __builtin_amdgcn_fence(__ATOMIC_ACQUIRE, "agent");
            xb_add(&bar[XB_XGEN(b.x)], 1u);
            asm volatile("s_waitcnt vmcnt(0)" ::: "memory");
        } else {
            XB_SPIN(xb_ld(&bar[XB_XGEN(b.x)]) == gen, bar);
            __builtin_amdgcn_fence(__ATOMIC_ACQUIRE, "agent");
            asm volatile("s_waitcnt vmcnt(0)" ::: "memory");
        }
    }
    __syncthreads();
}


namespace mk {
typedef unsigned short bf16_t;
typedef short bf16x8 __attribute__((ext_vector_type(8)));
typedef short s16x4 __attribute__((ext_vector_type(4)));
typedef float f32x16 __attribute__((ext_vector_type(16)));
typedef float f32x4 __attribute__((ext_vector_type(4)));
typedef unsigned u32x4 __attribute__((ext_vector_type(4)));
typedef unsigned u32x2 __attribute__((ext_vector_type(2)));
typedef __bf16 bf2 __attribute__((ext_vector_type(2)));
typedef float f32x16v __attribute__((ext_vector_type(16)));
typedef float f32x32v __attribute__((ext_vector_type(32)));
typedef unsigned u32x6 __attribute__((ext_vector_type(6)));
typedef _Float16 h16x32 __attribute__((ext_vector_type(32)));
typedef _Float16 h16x2 __attribute__((ext_vector_type(2)));

constexpr int TT = 16384, T = 8192, S = 2048, NB = 4, DM = 4096, NIN = 10560, NINP = 10752, NH = 8, NEXP = 16384;
constexpr float EPS = 1e-6f;
constexpr float O8_SCALE = 32.0f, WOUT8_SCALE = 2048.0f;
constexpr float HN8_SCALE = 16.0f, WIN8_SCALE = 2048.0f;
constexpr float U_SCALE = 128.0f, V_SCALE = 5.656854249f;
constexpr int NWAVES = 8, NTHR = 512;
constexpr int LDS_BYTES = 143360;
constexpr int LDS_XB = 131072;
constexpr int LDS_G1X = 131072 + 1024;

constexpr size_t SZ_WIN = (size_t)NINP * DM * 2, SZ_WOUT = (size_t)DM * DM * 2, SZ_W2 = (size_t)2048 * DM * 2, SZ_WUQ = (size_t)1536 * 768 * 2, SZ_WUKV = (size_t)2048 * 512 * 2,
                 SZ_TAB = (size_t)NEXP * 3072;
constexpr size_t LW_WIN = 0, LW_WOUT = LW_WIN + SZ_WIN, LW_W2 = LW_WOUT + SZ_WOUT, LW_WUQ = LW_W2 + SZ_W2, LW_WUKV = LW_WUQ + SZ_WUQ, LW_U = LW_WUKV + SZ_WUKV, LW_V = LW_U + SZ_TAB,
                 LW_END = LW_V + SZ_TAB;
constexpr size_t WS_CTL = 0, WS_SSQ = 65536, WS_W = 65536 + 2 * 65536;
constexpr size_t WS_HN = WS_W + 2 * LW_END, SZ_HN = (size_t)T * DM * 2, WS_P = WS_HN + SZ_HN, SZ_P = (size_t)T * NINP * 2;
constexpr size_t SZ_H1 = (size_t)T * 1024 * 2;
constexpr size_t WS_QKV = WS_P + SZ_P;
constexpr size_t QO_QA = 0, QO_KA = SZ_H1, QO_VA = 2 * SZ_H1, QO_QB = 3 * SZ_H1, QO_KB = 4 * SZ_H1, QO_VB = 5 * SZ_H1, QO_QC = 6 * SZ_H1, QO_KC = 7 * SZ_H1, QO_VC = 8 * SZ_H1,
                 QO_QD = 9 * SZ_H1, SZ_QD = (size_t)T * 1536 * 2, QO_KD = QO_QD + SZ_QD, QO_VD = QO_KD + SZ_QD, SZ_QKV = QO_VD + SZ_H1;
constexpr size_t WS_O = WS_QKV + SZ_QKV, SZ_O = (size_t)T * DM * 2, WS_T2 = WS_O + SZ_O, SZ_T2 = (size_t)2 * T * 1024 * 4, WS_END = WS_T2 + SZ_T2;
constexpr size_t SZ_F1 = (size_t)T * 1024 * 4;
constexpr size_t PO_OA = 0, PO_OB = 2 * SZ_H1, PO_LSE = 5 * SZ_H1, SZ_LSE = (size_t)3 * T * 8 * 4;
static_assert(PO_LSE + SZ_LSE <= SZ_P, "P alias");
constexpr size_t PO_SC = 0, SZ_SC = (size_t)T * 2048 * 4, PO_EXP = SZ_SC, SZ_EG = (size_t)T * 128 * 4, PO_GATE = PO_EXP + SZ_EG;
static_assert(PO_GATE + SZ_EG <= SZ_P, "P alias 2");
constexpr size_t OO_QRAW = 0, OO_KVRAW = (size_t)T * 1536 * 2;
static_assert(OO_KVRAW + (size_t)T * 2048 * 2 <= SZ_O, "O alias");
constexpr size_t TO_HN8 = 0;
constexpr size_t TO_CQ = 0, TO_CKV = (size_t)T * 768 * 2;
constexpr size_t ACT_SZ = WS_END - WS_HN, WS_TOTAL = WS_HN + 2 * ACT_SZ;
constexpr size_t TO_OC = 0, TO_OD = SZ_F1;

struct Args { const float* in[20]; float* out; unsigned char* ws; };
enum { I_X = 0, I_GMIX, I_WIN, I_WOUT, I_DLAM, I_DGQK, I_DGOUT, I_DILG, I_NAG, I_RPB, I_GCQ, I_GCKV, I_WUQ, I_WUKV, I_MLAG, I_GFFN, I_PWQ, I_PSK, I_PU, I_PV };

struct Frame {
    const Args* a; float* out; unsigned char* ws; LAS unsigned char* lds;
    int tid, lane, wid;
    int rank, nwg;
};

#ifdef MK_XCDSPLIT
__device__ __forceinline__ int sid() { return ((int)blockIdx.x >> 2) & 1; }
__device__ __forceinline__ int wg_rank() { return (((int)blockIdx.x >> 3) << 2) | ((int)blockIdx.x & 3); }
#else
__device__ __forceinline__ int sid() { return ((int)blockIdx.x >> 3) & 1; }
__device__ __forceinline__ int wg_rank() { return (((int)blockIdx.x >> 4) << 3) | ((int)blockIdx.x & 7); }
#endif
__device__ __forceinline__ int wg_count() { return (int)gridDim.x >> 1; }

#define MK_DPP_ADD(v, ctrl) v += __int_as_float(__builtin_amdgcn_update_dpp(0, __float_as_int(v), ctrl, 0xF, 0xF, true))
__device__ __forceinline__ float wave_total(float v) {
    MK_DPP_ADD(v, 0xB1); MK_DPP_ADD(v, 0x4E); MK_DPP_ADD(v, 0x141); MK_DPP_ADD(v, 0x140);
    const int vi = __float_as_int(v);
    return (__int_as_float(__builtin_amdgcn_readlane(vi, 0)) + __int_as_float(__builtin_amdgcn_readlane(vi, 16))) + (__int_as_float(__builtin_amdgcn_readlane(vi, 32)) + __int_as_float(__builtin_amdgcn_readlane(vi, 48)));
}
__device__ __forceinline__ float wsum(float v) { return wave_total(v); }
__device__ __forceinline__ float sum4(float v) { MK_DPP_ADD(v, 0xB1); MK_DPP_ADD(v, 0x4E); return v; }
__device__ __forceinline__ float sum8(float v) { MK_DPP_ADD(v, 0xB1); MK_DPP_ADD(v, 0x4E); MK_DPP_ADD(v, 0x141); return v; }
__device__ __forceinline__ unsigned pk_bf16(float lo, float hi) { unsigned r; asm volatile("v_cvt_pk_bf16_f32 %0, %1, %2" : "=v"(r) : "v"(lo), "v"(hi)); return r; }
__device__ __forceinline__ unsigned pk_fp8x4(float a, float b, float c, float d) {
    a = fminf(fmaxf(a, -448.f), 448.f); b = fminf(fmaxf(b, -448.f), 448.f); c = fminf(fmaxf(c, -448.f), 448.f); d = fminf(fmaxf(d, -448.f), 448.f);
    int p = 0; p = __builtin_amdgcn_cvt_pk_fp8_f32(a, b, p, false); p = __builtin_amdgcn_cvt_pk_fp8_f32(c, d, p, true); return (unsigned)p; }
__device__ __forceinline__ float bf_lo(unsigned w) { return __uint_as_float(w << 16); }
__device__ __forceinline__ float bf_hi(unsigned w) { return __uint_as_float(w & 0xffff0000u); }

template <bool F8> __device__ __forceinline__ void transpose_tile4(const Frame& F, const float* __restrict__ src, int N, int K, bf16_t* __restrict__ dst, const float* __restrict__ gain, int k0, int n0) {
    LAS float* tile = (LAS float*)F.lds;
    const int r = F.tid >> 4, c4 = F.tid & 15;
    f32x4 v[8]; float g[8];
#pragma unroll
    for (int i = 0; i < 8; ++i) { const int k = r + 32 * i; v[i] = *(const f32x4*)(src + (size_t)(k0 + k) * N + n0 + c4 * 4); g[i] = gain ? gain[k0 + k] : 1.0f; }
#pragma unroll
    for (int i = 0; i < 8; ++i) { const int k = r + 32 * i;
        tile[k * 65 + c4 * 4 + 0] = v[i][0] * g[i]; tile[k * 65 + c4 * 4 + 1] = v[i][1] * g[i]; tile[k * 65 + c4 * 4 + 2] = v[i][2] * g[i]; tile[k * 65 + c4 * 4 + 3] = v[i][3] * g[i]; }
    __syncthreads();
    const int n = F.tid >> 3, k8 = F.tid & 7;
#pragma unroll
    for (int q = 0; q < 4; ++q) { float e[8];
#pragma unroll
        for (int j = 0; j < 8; ++j) e[j] = tile[(q * 64 + k8 * 8 + j) * 65 + n];
        if (F8) { u32x2 w; w.x = pk_fp8x4(e[0] * 2048.0f, e[1] * 2048.0f, e[2] * 2048.0f, e[3] * 2048.0f); w.y = pk_fp8x4(e[4] * 2048.0f, e[5] * 2048.0f, e[6] * 2048.0f, e[7] * 2048.0f);
            *(u32x2*)((unsigned char*)dst + (size_t)(n0 + n) * K + k0 + q * 64 + k8 * 8) = w; }
        else { u32x4 w; w.x = pk_bf16(e[0], e[1]); w.y = pk_bf16(e[2], e[3]); w.z = pk_bf16(e[4], e[5]); w.w = pk_bf16(e[6], e[7]);
            *(u32x4*)(dst + (size_t)(n0 + n) * K + k0 + q * 64 + k8 * 8) = w; } }
    __syncthreads();
}

struct TDesc { const float* src; const float* gain; unsigned char* dst; int N, K, k0, n0, f8; };
__device__ __forceinline__ TDesc t_decode(const Frame& F, int u) {
    constexpr int N_WIN = 16 * 165, N_WOUT = 16 * 64, N_UQ = 3 * 24, N_UKV = 2 * 32, N_L = N_WIN + N_WOUT + N_UQ + N_UKV;
    const int l = u / N_L; int r = u % N_L; unsigned char* lw = F.a->ws + WS_W + (size_t)l * LW_END; TDesc d;
    if (r < N_WIN) { d.src = F.a->in[I_WIN] + (size_t)l * DM * NIN; d.gain = F.a->in[I_GMIX] + l * DM; d.dst = lw + LW_WIN; d.N = NIN; d.K = DM; d.k0 = (r & 15) * 256; d.n0 = (r >> 4) * 64; d.f8 = 1; return d; }
    r -= N_WIN;
    if (r < N_WOUT) { d.src = F.a->in[I_WOUT] + (size_t)l * DM * DM; d.gain = nullptr; d.dst = lw + LW_WOUT; d.N = DM; d.K = DM; d.k0 = (r & 15) * 256; d.n0 = (r >> 4) * 64; d.f8 = 1; return d; }
    r -= N_WOUT;
    if (r < N_UQ) { d.src = F.a->in[I_WUQ] + (size_t)l * 768 * 1536; d.gain = F.a->in[I_GCQ] + l * 768; d.dst = lw + LW_WUQ; d.N = 1536; d.K = 768; d.k0 = (r % 3) * 256; d.n0 = (r / 3) * 64; d.f8 = 0; return d; }
    r -= N_UQ;
    d.src = F.a->in[I_WUKV] + (size_t)l * 512 * 2048; d.gain = F.a->in[I_GCKV] + l * 512; d.dst = lw + LW_WUKV; d.N = 2048; d.K = 512; d.k0 = (r & 1) * 256; d.n0 = (r >> 1) * 64; d.f8 = 0; return d;
}
#define MK_TLOAD(d, v, g) do { const int r_ = F.tid >> 4, c4_ = F.tid & 15; _Pragma("unroll") for (int i = 0; i < 8; ++i) { const int k_ = r_ + 32 * i; \
        v[i] = *(const f32x4*)(d.src + (size_t)(d.k0 + k_) * d.N + d.n0 + c4_ * 4); g[i] = d.gain ? d.gain[d.k0 + k_] : 1.0f; } } while (0)
#define MK_TFIN(d, v, g) do { LAS float* tile = (LAS float*)F.lds; const int r_ = F.tid >> 4, c4_ = F.tid & 15; \
        _Pragma("unroll") for (int i = 0; i < 8; ++i) { const int k_ = r_ + 32 * i; \
            tile[k_ * 65 + c4_ * 4 + 0] = v[i][0] * g[i]; tile[k_ * 65 + c4_ * 4 + 1] = v[i][1] * g[i]; tile[k_ * 65 + c4_ * 4 + 2] = v[i][2] * g[i]; tile[k_ * 65 + c4_ * 4 + 3] = v[i][3] * g[i]; } \
        __syncthreads(); \
        const int n_ = F.tid >> 3, k8_ = F.tid & 7; \
        _Pragma("unroll") for (int q = 0; q < 4; ++q) { float e[8]; \
            _Pragma("unroll") for (int j = 0; j < 8; ++j) e[j] = tile[(q * 64 + k8_ * 8 + j) * 65 + n_]; \
            if (d.f8) { u32x2 w; w.x = pk_fp8x4(e[0] * 2048.0f, e[1] * 2048.0f, e[2] * 2048.0f, e[3] * 2048.0f); w.y = pk_fp8x4(e[4] * 2048.0f, e[5] * 2048.0f, e[6] * 2048.0f, e[7] * 2048.0f);     \
                *(u32x2*)(d.dst + (size_t)(d.n0 + n_) * d.K + d.k0 + q * 64 + k8_ * 8) = w; } \
            else { u32x4 w; w.x = pk_bf16(e[0], e[1]); w.y = pk_bf16(e[2], e[3]); w.z = pk_bf16(e[4], e[5]); w.w = pk_bf16(e[6], e[7]); \
                *(u32x4*)((bf16_t*)d.dst + (size_t)(d.n0 + n_) * d.K + d.k0 + q * 64 + k8_ * 8) = w; } } \
        __syncthreads(); } while (0)
__device__ __forceinline__ void p0_transpose_range(const Frame& F, int u0, int u1, int rank, int nwg) {
    int u = u0 + rank; if (u >= u1) return;
    TDesc a = t_decode(F, u), b = a; f32x4 va[8], vb[8]; float ga[8], gb[8];
    MK_TLOAD(a, va, ga);
    for (; u < u1; u += 2 * nwg) {
        const bool hb = u + nwg < u1; if (hb) { b = t_decode(F, u + nwg); MK_TLOAD(b, vb, gb); }
        MK_TFIN(a, va, ga);
        const bool ha = u + 2 * nwg < u1; if (ha) { a = t_decode(F, u + 2 * nwg); MK_TLOAD(a, va, ga); }
        if (hb) MK_TFIN(b, vb, gb);
    }
}
#undef MK_TLOAD
#undef MK_TFIN

__device__ __forceinline__ void p0_w2t(const Frame& F, int rank, int nwg) {
    {
        LAS float* SK = (LAS float*)F.lds;
        LAS float* WQ = (LAS float*)(F.lds + 65536);
        for (int u = rank; u < 2 * 16 * 64; u += nwg) {
            const int l = u >> 10, hc = (u >> 6) & 15, k0 = (u & 63) * 64;
            const float* sk = F.a->in[I_PSK] + (size_t)(l * 16 + hc) * 128 * 128;
            const float* wq = F.a->in[I_PWQ] + (size_t)l * DM * 2048 + (size_t)k0 * 2048 + hc * 128;
#pragma unroll
            for (int i = 0; i < 8; ++i) { const int idx = F.tid + NTHR * i, row = idx >> 5, c4 = idx & 31; *(LAS f32x4*)(SK + row * 128 + c4 * 4) = *(const f32x4*)(sk + row * 128 + c4 * 4); }
#pragma unroll
            for (int i = 0; i < 4; ++i) { const int idx = F.tid + NTHR * i, row = idx >> 5, c4 = idx & 31; *(LAS f32x4*)(WQ + row * 132 + c4 * 4) = *(const f32x4*)(wq + (size_t)row * 2048 + c4 * 4); }
            __syncthreads();
            const int k = F.lane, ng = F.wid;
            float acc[16];
#pragma unroll
            for (int j = 0; j < 16; ++j) acc[j] = 0.f;
            for (int d4 = 0; d4 < 32; ++d4) { const f32x4 w = *(const LAS f32x4*)(WQ + k * 132 + d4 * 4);
#pragma unroll
                for (int j = 0; j < 16; ++j) { const f32x4 s = *(const LAS f32x4*)(SK + (ng * 16 + j) * 128 + d4 * 4); acc[j] += w[0] * s[0] + w[1] * s[1] + w[2] * s[2] + w[3] * s[3]; } }
            const float g = F.a->in[I_GFFN][l * DM + k0 + k];
            bf16_t* w2 = (bf16_t*)(F.a->ws + WS_W + (size_t)l * LW_END + LW_W2);
#pragma unroll
            for (int j = 0; j < 16; ++j) w2[(size_t)(hc * 128 + ng * 16 + j) * DM + k0 + k] = (bf16_t)(pk_bf16(acc[j] * g, 0.f) & 0xffffu);
            __syncthreads();
        }
    }
}

__device__ __forceinline__ void p0_a(const Frame& F) {
    constexpr int N_WIN = 16 * 165;
    p0_transpose_range(F, 0, N_WIN, (int)blockIdx.x, (int)gridDim.x);
    for (int i = (int)blockIdx.x * NTHR + F.tid; i < 2 * 192 * DM / 16; i += (int)gridDim.x * NTHR) { const int l = i / (192 * DM / 16), o = i % (192 * DM / 16);
        *(u32x4*)(F.a->ws + WS_W + (size_t)l * LW_END + LW_WIN + (size_t)NIN * DM + (size_t)o * 16) = (u32x4){0u, 0u, 0u, 0u}; }
}

__device__ __forceinline__ void p0_b(const Frame& F, int rank, int nwg) {
    constexpr int N_WIN = 16 * 165, N_WOUT = 16 * 64, N_UQ = 3 * 24, N_UKV = 2 * 32, N_L = N_WIN + N_WOUT + N_UQ + N_UKV;
    p0_transpose_range(F, N_WIN, 2 * N_L, rank, nwg);
    {
        constexpr size_t NIT = (size_t)NEXP * 64;
        const size_t stride = (size_t)nwg * NTHR; const int nit = (int)((4 * NIT - (size_t)rank * NTHR + stride - 1) / stride);
        const int slot = (rank * 13) % nit; int it = 0;
#define MK_TBL_LOAD(x, base_) do { const size_t i_ = (base_) + F.tid; const int tb_ = (int)(i_ / NIT); const size_t o_ = i_ % NIT; const int l_ = tb_ >> 1, isv_ = tb_ & 1; \
            const float* src_ = (isv_ ? F.a->in[I_PV] : F.a->in[I_PU]) + (size_t)l_ * NEXP * DM + (o_ >> 6) * DM + 4 * (int)(o_ & 63); \
            _Pragma("unroll") for (int c = 0; c < 16; ++c) x[c] = *(const f32x4*)(src_ + c * 256); } while (0)
#define MK_TBL_FIN(x, base_) do { const size_t i_ = (base_) + F.tid; const int tb_ = (int)(i_ / NIT); const size_t o_ = i_ % NIT; const int l_ = tb_ >> 1, isv_ = tb_ & 1; const size_t row_ = o_ >> 6; const int ln_ = (int)(o_ & 63); \
            const float* g_ = F.a->in[I_GFFN] + l_ * DM + 4 * ln_; const float sc_ = isv_ ? V_SCALE : U_SCALE; \
            _Pragma("unroll") for (int c = 0; c < 16; ++c) { if (!isv_) x[c] *= *(const f32x4*)(g_ + c * 256); \
                _Pragma("unroll") for (int j = 0; j < 4; ++j) x[c][j] = fminf(fmaxf(x[c][j] * sc_, -7.5f), 7.5f); } \
            u32x4 w_[3]; \
            _Pragma("unroll") for (int q = 0; q < 2; ++q) { f32x16v s0_, s1_; \
                _Pragma("unroll") for (int c = 0; c < 8; ++c) { s0_[2 * c] = x[8 * q + c][0]; s1_[2 * c] = x[8 * q + c][1]; s0_[2 * c + 1] = x[8 * q + c][2]; s1_[2 * c + 1] = x[8 * q + c][3]; } \
                const u32x6 p_ = __builtin_amdgcn_cvt_scalef32_2xpk16_fp6_f32(s0_, s1_, 1.0f); \
                _Pragma("unroll") for (int k = 0; k < 6; ++k) w_[(6 * q + k) >> 2][(6 * q + k) & 3] = p_[k]; } \
            unsigned char* dst_ = F.a->ws + WS_W + (size_t)l_ * LW_END + (isv_ ? LW_V : LW_U) + row_ * 3072 + ln_ * 16;       \
            _Pragma("unroll") for (int k = 0; k < 3; ++k) *(u32x4*)(dst_ + 1024 * k) = w_[k]; } while (0)
        f32x4 xa[16], xb[16];
        size_t base = (size_t)rank * NTHR;
        if (base < 4 * NIT) MK_TBL_LOAD(xa, base);
        for (; base < 4 * NIT; base += 2 * stride, it += 2) {
            const bool hb = base + stride < 4 * NIT;
            if (it == slot || it + 1 == slot) p0_w2t(F, rank, nwg);
            if (hb) MK_TBL_LOAD(xb, base + stride);
            MK_TBL_FIN(xa, base);
            if (base + 2 * stride < 4 * NIT) MK_TBL_LOAD(xa, base + 2 * stride);
            if (hb) MK_TBL_FIN(xb, base + stride);
        }
#undef MK_TBL_LOAD
#undef MK_TBL_FIN
    }
}

__device__ __forceinline__ void p_norm(const Frame& F, const float* __restrict__ x, bf16_t* __restrict__ hn) {
#define MK_NLOAD(v, t_) do { const f32x4* xr_ = (const f32x4*)(x + (size_t)(t_) * DM); _Pragma("unroll") for (int i = 0; i < 16; ++i) v[i] = xr_[i * 64 + F.lane]; } while (0)
#define MK_NFIN(v, t_) do { float ss_ = 0.f; _Pragma("unroll") for (int i = 0; i < 16; ++i) ss_ += v[i][0] * v[i][0] + v[i][1] * v[i][1] + v[i][2] * v[i][2] + v[i][3] * v[i][3]; \
        ss_ = wsum(ss_); const float r8_ = rsqrtf(ss_ * (1.0f / DM) + EPS) * HN8_SCALE;        \
        unsigned* o_ = (unsigned*)((unsigned char*)hn + (size_t)(t_) * DM); \
        _Pragma("unroll") for (int i = 0; i < 16; ++i) o_[i * 64 + F.lane] = pk_fp8x4(v[i][0] * r8_, v[i][1] * r8_, v[i][2] * r8_, v[i][3] * r8_); } while (0)
    const int tstep = F.nwg * NWAVES;
    for (int t = F.rank * NWAVES + F.wid; t < T; t += 2 * tstep) {
        const bool h2 = t + tstep < T; f32x4 va[16], vb[16];
        MK_NLOAD(va, t); if (h2) MK_NLOAD(vb, t + tstep);
        MK_NFIN(va, t); if (h2) MK_NFIN(vb, t + tstep);
    }
#undef MK_NLOAD
#undef MK_NFIN
}

__device__ __forceinline__ void unpack16(const u32x4 a, const u32x4 b, float (&x)[16]) {
#pragma unroll
    for (int i = 0; i < 4; ++i) { x[2 * i] = bf_lo(a[i]); x[2 * i + 1] = bf_hi(a[i]); x[8 + 2 * i] = bf_lo(b[i]); x[8 + 2 * i + 1] = bf_hi(b[i]); }
}
__device__ __forceinline__ void p_post1(const Frame& F, int l) {
    const bf16_t* P = (const bf16_t*)(F.ws + WS_P);
    for (int t = F.rank * NWAVES + F.wid; t < T; t += F.nwg * NWAVES) {
        const bf16_t* pr = P + (size_t)t * NINP; const int lane = F.lane;
        u32x2 cq3[3]; u32x4 ckv4;
#pragma unroll
        for (int i = 0; i < 3; ++i) cq3[i] = ((const u32x2*)(pr + 9216 + lane * 12))[i];
        ckv4 = *(const u32x4*)(pr + 9984 + lane * 8);
        {
            u32x2 c[3]; float ss = 0.f;
#pragma unroll
            for (int i = 0; i < 3; ++i) { c[i] = cq3[i]; const float a0 = bf_lo(c[i].x), a1 = bf_hi(c[i].x), a2 = bf_lo(c[i].y), a3 = bf_hi(c[i].y); ss += a0 * a0 + a1 * a1 + a2 * a2 + a3 * a3; }
            ss = wsum(ss); const float r = rsqrtf(ss * (1.0f / 768) + EPS);
            u32x2* d = (u32x2*)((bf16_t*)(F.ws + WS_T2 + TO_CQ) + (size_t)t * 768 + lane * 12);
#pragma unroll
            for (int i = 0; i < 3; ++i) { u32x2 w; w.x = pk_bf16(bf_lo(c[i].x) * r, bf_hi(c[i].x) * r); w.y = pk_bf16(bf_lo(c[i].y) * r, bf_hi(c[i].y) * r); d[i] = w; }
        }
        {
            const u32x4 c = ckv4; float ss = 0.f;
#pragma unroll
            for (int i = 0; i < 4; ++i) { const float a0 = bf_lo(c[i]), a1 = bf_hi(c[i]); ss += a0 * a0 + a1 * a1; }
            ss = wsum(ss); const float r = rsqrtf(ss * (1.0f / 512) + EPS);
            u32x4 w;
#pragma unroll
            for (int i = 0; i < 4; ++i) w[i] = pk_bf16(bf_lo(c[i]) * r, bf_hi(c[i]) * r);
            *(u32x4*)((bf16_t*)(F.ws + WS_T2 + TO_CKV) + (size_t)t * 512 + lane * 8) = w;
        }
    }
}

__device__ __forceinline__ void p_post2(const Frame& F, int l) {
    const bf16_t* QR = (const bf16_t*)(F.ws + WS_O + OO_QRAW); const bf16_t* KVR = (const bf16_t*)(F.ws + WS_O + OO_KVRAW); const bf16_t* P = (const bf16_t*)(F.ws + WS_P);
    bf16_t* QD = (bf16_t*)(F.ws + WS_QKV + QO_QD); bf16_t* KD = (bf16_t*)(F.ws + WS_QKV + QO_KD); bf16_t* VD = (bf16_t*)(F.ws + WS_QKV + QO_VD);
    LAS float* L = (LAS float*)F.lds + F.wid * 3712; LAS float* q = L; LAS float* kv = L + 1536; LAS float* kr = L + 3584; LAS float* cs = L + 3648;
    const float* g0 = F.a->in[I_MLAG] + (size_t)(l * 2 + 0) * 192; const float* g1 = F.a->in[I_MLAG] + (size_t)(l * 2 + 1) * 192;
    const int lane = F.lane;
    for (int t = F.rank * NWAVES + F.wid; t < T; t += F.nwg * NWAVES) {
        const int b = t / S, s = t % S;
        float aq, akv;
        { const bf16_t* pr = P + (size_t)t * NINP; float sq = 0.f, sk = 0.f;
#pragma unroll
          for (int i = 0; i < 3; ++i) { const u32x2 c2 = ((const u32x2*)(pr + 9216 + lane * 12))[i]; const float a0 = bf_lo(c2.x), a1 = bf_hi(c2.x), a2 = bf_lo(c2.y), a3 = bf_hi(c2.y); sq += (a0 * a0 + a1 * a1) + (a2 * a2 + a3 * a3); }
          { const u32x4 c4 = *(const u32x4*)(pr + 9984 + lane * 8);
#pragma unroll
            for (int i = 0; i < 4; ++i) { const float a0 = bf_lo(c4[i]), a1 = bf_hi(c4[i]); sk += a0 * a0 + a1 * a1; } }
          aq = rsqrtf(wave_total(sq) * (1.0f / 768) + EPS); akv = rsqrtf(wave_total(sk) * (1.0f / 512) + EPS); }
#pragma unroll
        for (int i = 0; i < 3; ++i) { const int c = lane + 64 * i; const u32x4 w = *(const u32x4*)(QR + (size_t)t * 1536 + c * 8);
            *(LAS f32x4*)(q + c * 8) = (f32x4){bf_lo(w[0]), bf_hi(w[0]), bf_lo(w[1]), bf_hi(w[1])}; *(LAS f32x4*)(q + c * 8 + 4) = (f32x4){bf_lo(w[2]), bf_hi(w[2]), bf_lo(w[3]), bf_hi(w[3])}; }
#pragma unroll
        for (int i = 0; i < 4; ++i) { const int c = lane + 64 * i; const u32x4 w = *(const u32x4*)(KVR + (size_t)t * 2048 + c * 8);
            *(LAS f32x4*)(kv + c * 8) = (f32x4){bf_lo(w[0]), bf_hi(w[0]), bf_lo(w[1]), bf_hi(w[1])}; *(LAS f32x4*)(kv + c * 8 + 4) = (f32x4){bf_lo(w[2]), bf_hi(w[2]), bf_lo(w[3]), bf_hi(w[3])}; }
        u32x4 vcp[2];
#pragma unroll
        for (int i = 0; i < 2; ++i) { const int c = lane + 64 * i; vcp[i] = *(const u32x4*)(KVR + (size_t)t * 2048 + (c >> 4) * 256 + 128 + (c & 15) * 8); }
        kr[lane] = __uint_as_float(((unsigned)P[(size_t)t * NINP + 10496 + lane]) << 16);
        if (lane < 32) { const float inv = exp2f(-(float)lane * (2.0f / 64.0f) * 13.287712379549449f);
            float rev = (float)s * inv * 0.15915494309189535f; rev -= rintf(rev);
            cs[lane] = __builtin_amdgcn_cosf(rev); cs[32 + lane] = __builtin_amdgcn_sinf(rev); }
        asm volatile("s_waitcnt lgkmcnt(0)" ::: "memory");
        const int h = lane >> 3, part = lane & 7;
        float qss = 0.f, kss = 0.f;
#pragma unroll
        for (int j = 0; j < 24; ++j) { const float a = q[h * 192 + part + 8 * j]; qss += a * a; }
#pragma unroll
        for (int j = 0; j < 16; ++j) { const float a = kv[h * 256 + part + 8 * j]; kss += a * a; }
        kss *= akv * akv;
#pragma unroll
        for (int j = 0; j < 8; ++j) { const float a = kr[part + 8 * j]; kss += a * a; }
        qss = sum8(qss); kss = sum8(kss);
        const float rq = rsqrtf(aq * aq * qss * (1.0f / 192) + EPS) * aq * 0.07216878364870322f;
        const float rk = rsqrtf(kss * (1.0f / 192) + EPS);
#pragma unroll
        for (int i = 0; i < 3; ++i) {
            const int c = lane + 64 * i, hh = c / 24, e0 = (c % 24) * 8;
            const float rqh = __int_as_float(__builtin_amdgcn_ds_bpermute(hh * 32, __float_as_int(rq))), rkh = __int_as_float(__builtin_amdgcn_ds_bpermute(hh * 32, __float_as_int(rk)));
            float vq[8], vk[8];
#pragma unroll
            for (int j = 0; j < 8; ++j) {
                const int e = e0 + j;
                if (e0 < 128) { vq[j] = q[hh * 192 + e] * g0[e] * rqh; vk[j] = kv[hh * 256 + e] * akv * g1[e] * rkh; }
                else { const int i2 = (e - 128) & 31; const float co = cs[i2], si = cs[32 + i2];
                    const float q1 = q[hh * 192 + 128 + i2] * g0[128 + i2], q2 = q[hh * 192 + 160 + i2] * g0[160 + i2];
                    const float k1 = kr[i2] * g1[128 + i2], k2 = kr[32 + i2] * g1[160 + i2];
                    if (e0 < 160) { vq[j] = (q1 * co - q2 * si) * rqh; vk[j] = (k1 * co - k2 * si) * rkh; }
                    else { vq[j] = (q2 * co + q1 * si) * rqh; vk[j] = (k2 * co + k1 * si) * rkh; } }
            }
            u32x4 wq, wk;
#pragma unroll
            for (int j = 0; j < 4; ++j) { wq[j] = pk_bf16(vq[2 * j], vq[2 * j + 1]); wk[j] = pk_bf16(vk[2 * j], vk[2 * j + 1]); }
            const size_t o = ((size_t)(b * 8 + hh) * S + s) * 192 + e0;
            *(u32x4*)(QD + o) = wq; *(u32x4*)(KD + o) = wk;
        }
#pragma unroll
        for (int i = 0; i < 2; ++i) { const int c = lane + 64 * i, hh = c >> 4, e0 = (c & 15) * 8;
            u32x4 wv;
#pragma unroll
            for (int j = 0; j < 4; ++j) wv[j] = pk_bf16(bf_lo(vcp[i][j]) * akv, bf_hi(vcp[i][j]) * akv);
            *(u32x4*)(VD + ((size_t)(b * 8 + hh) * S + s) * 128 + e0) = wv; }
        asm volatile("s_waitcnt lgkmcnt(0)" ::: "memory");
    }
}

constexpr int SHM_V = 64 * 128 * 2, SHM_KMAX = 64 * 192 * 2, ATT_WS = 2 * SHM_V + 2 * SHM_KMAX, ATT_RPB = ATT_WS + NWAVES * 64 * 4, ATT_END = ATT_RPB + 15 * 128 * 4;
constexpr float LOG2E = 1.4426950408889634f, ATT_THR = 8.0f;
struct AP {
    const bf16_t* Q; const bf16_t* K; const bf16_t* V;
    bf16_t* O; int opitch; int o8; float* lse;
    int NT;
    int dil, l0, r0, qmask, qshift;
    int lk0, jmask, jshift;
    float nslope;
    int qinfo;
};
__device__ __forceinline__ int crow(int r, int hi) { return (r & 3) + 8 * (r >> 2) + 4 * hi; }
template <int DQK> __device__ __forceinline__ int kswz(int row) { return (DQK == 128 ? (row & 15) : ((row >> 1) & 7)) << 4; }
__device__ __forceinline__ int v_st(int k, int c) { const int kk = (k & ~0xC) | ((k & 4) << 1) | ((k & 8) >> 1); return ((kk >> 3) * 4 + (c >> 5)) * 512 + ((kk & 7) * 32 + (c & 31)) * 2; }
__device__ __forceinline__ int v_rd_base(int lane) { return ((lane & 3) << 3) | (((lane >> 2) & 3) << 6) | (((lane >> 4) & 1) << 5) | (((lane >> 5) & 1) << 8); }
constexpr int v_rd_off(int d0, int ks, int half) { return d0 * 512 + ks * 4096 + half * 2048; }
template <int OFF> __device__ __forceinline__ s16x4 tr_read(int vb) { s16x4 r; asm volatile("ds_read_b64_tr_b16 %0, %1 offset:%2" : "=&v"(r) : "v"(vb), "i"(OFF) : "memory"); return r; }
template <int D0> __device__ __forceinline__ void pv_one(f32x16& od, int vb, bf16x8 pa0, bf16x8 pa1, bf16x8 pa2, bf16x8 pa3) {
    const s16x4 l0 = tr_read<v_rd_off(D0, 0, 0)>(vb), h0 = tr_read<v_rd_off(D0, 0, 1)>(vb), l1 = tr_read<v_rd_off(D0, 1, 0)>(vb), h1 = tr_read<v_rd_off(D0, 1, 1)>(vb);
    const s16x4 l2 = tr_read<v_rd_off(D0, 2, 0)>(vb), h2 = tr_read<v_rd_off(D0, 2, 1)>(vb), l3 = tr_read<v_rd_off(D0, 3, 0)>(vb), h3 = tr_read<v_rd_off(D0, 3, 1)>(vb);
    asm volatile("s_waitcnt lgkmcnt(0)" ::: "memory"); __builtin_amdgcn_sched_barrier(0);
#define MK_PK(L, H) (bf16x8){L[0], L[1], L[2], L[3], H[0], H[1], H[2], H[3]}
    od = __builtin_amdgcn_mfma_f32_32x32x16_bf16(pa0, MK_PK(l0, h0), od, 0, 0, 0);
    od = __builtin_amdgcn_mfma_f32_32x32x16_bf16(pa1, MK_PK(l1, h1), od, 0, 0, 0);
    od = __builtin_amdgcn_mfma_f32_32x32x16_bf16(pa2, MK_PK(l2, h2), od, 0, 0, 0);
    od = __builtin_amdgcn_mfma_f32_32x32x16_bf16(pa3, MK_PK(l3, h3), od, 0, 0, 0);
#undef MK_PK
}

#define MK_TR8(D0, vb, L0, H0, L1, H1, L2, H2, L3, H3) do { L0 = tr_read<v_rd_off(D0, 0, 0)>(vb); H0 = tr_read<v_rd_off(D0, 0, 1)>(vb); L1 = tr_read<v_rd_off(D0, 1, 0)>(vb); H1 = tr_read<v_rd_off(D0, 1, 1)>(vb); \
        L2 = tr_read<v_rd_off(D0, 2, 0)>(vb); H2 = tr_read<v_rd_off(D0, 2, 1)>(vb); L3 = tr_read<v_rd_off(D0, 3, 0)>(vb); H3 = tr_read<v_rd_off(D0, 3, 1)>(vb); } while (0)
#define MK_PKV(L, H) (bf16x8){L[0], L[1], L[2], L[3], H[0], H[1], H[2], H[3]}
#define MK_MM4(od, L0, H0, L1, H1, L2, H2, L3, H3) do { od = __builtin_amdgcn_mfma_f32_32x32x16_bf16(pa0, MK_PKV(L0, H0), od, 0, 0, 0); od = __builtin_amdgcn_mfma_f32_32x32x16_bf16(pa1, MK_PKV(L1, H1), od, 0, 0, 0); \
        od = __builtin_amdgcn_mfma_f32_32x32x16_bf16(pa2, MK_PKV(L2, H2), od, 0, 0, 0); od = __builtin_amdgcn_mfma_f32_32x32x16_bf16(pa3, MK_PKV(L3, H3), od, 0, 0, 0); } while (0)
__device__ __forceinline__ void pv_all(f32x16 (&o)[4], int vb, bf16x8 pa0, bf16x8 pa1, bf16x8 pa2, bf16x8 pa3) {
    s16x4 a0, a1, a2, a3, a4, a5, a6, a7, b0, b1, b2, b3, b4, b5, b6, b7;
    __builtin_amdgcn_sched_barrier(0);
    MK_TR8(0, vb, a0, a1, a2, a3, a4, a5, a6, a7);
    MK_TR8(1, vb, b0, b1, b2, b3, b4, b5, b6, b7);
    asm volatile("s_waitcnt lgkmcnt(8)" : "+v"(a0), "+v"(a1), "+v"(a2), "+v"(a3), "+v"(a4), "+v"(a5), "+v"(a6), "+v"(a7) :: "memory"); __builtin_amdgcn_sched_barrier(0);
    MK_MM4(o[0], a0, a1, a2, a3, a4, a5, a6, a7);
    __builtin_amdgcn_sched_barrier(0);
    MK_TR8(2, vb, a0, a1, a2, a3, a4, a5, a6, a7);
    asm volatile("s_waitcnt lgkmcnt(8)" : "+v"(b0), "+v"(b1), "+v"(b2), "+v"(b3), "+v"(b4), "+v"(b5), "+v"(b6), "+v"(b7) :: "memory"); __builtin_amdgcn_sched_barrier(0);
    MK_MM4(o[1], b0, b1, b2, b3, b4, b5, b6, b7);
    __builtin_amdgcn_sched_barrier(0);
    MK_TR8(3, vb, b0, b1, b2, b3, b4, b5, b6, b7);
    asm volatile("s_waitcnt lgkmcnt(8)" : "+v"(a0), "+v"(a1), "+v"(a2), "+v"(a3), "+v"(a4), "+v"(a5), "+v"(a6), "+v"(a7) :: "memory"); __builtin_amdgcn_sched_barrier(0);
    MK_MM4(o[2], a0, a1, a2, a3, a4, a5, a6, a7);
    asm volatile("s_waitcnt lgkmcnt(0)" : "+v"(b0), "+v"(b1), "+v"(b2), "+v"(b3), "+v"(b4), "+v"(b5), "+v"(b6), "+v"(b7) :: "memory"); __builtin_amdgcn_sched_barrier(0);
    MK_MM4(o[3], b0, b1, b2, b3, b4, b5, b6, b7);
}
#undef MK_TR8
#undef MK_MM4
#undef MK_PKV


constexpr unsigned QN = 448u, QEND = 0xffffu;
constexpr int LDS_QS = LDS_XB + 64;
__device__ __forceinline__ unsigned q_pop(unsigned* ctr, unsigned q) {
    unsigned v = xb_add(&ctr[64 * q], 1u);
    if (v < QN) return (q << 9) | v;
    for (;;) {
        unsigned best = 0xffffffffu, bq = 0u;
#pragma unroll
        for (unsigned j = 0; j < (unsigned)NB; ++j) { const unsigned c = xb_ld(&ctr[64 * j]); if (c < best) { best = c; bq = j; } }
        if (best >= QN) return QEND;
        v = xb_add(&ctr[64 * bq], 1u);
        if (v < QN) return (bq << 9) | v;
    }
}
#define MK_QHOOK() do { if (tid == 0) { const unsigned nx_ = q_pop((unsigned*)(F.a->ws + WS_CTL) + 12288 + 256 * (p.qinfo >> 8), (unsigned)(p.qinfo >> 1) & 3u); \
        *(volatile LAS unsigned*)(lds + LDS_QS + 4 * (p.qinfo & 1)) = nx_; } } while (0)

template <int MODE, int DQK>
__device__ __forceinline__ void attn_unit(const Frame& F, const AP p) {
    constexpr int KS = DQK / 16, PITCH = DQK * 2, SHMK = 64 * PITCH, KCH = DQK / 64;
    int tid_ = F.tid; asm volatile("" : "+v"(tid_));
    const int tid = tid_, wid = __builtin_amdgcn_readfirstlane(tid >> 6), lane = tid & 63, r32 = lane & 31, hi = lane >> 5;
    LAS char* lds = (LAS char*)F.lds;
    LAS char* V_lds = lds; LAS char* K_lds = lds + 2 * SHM_V;
    LAS float* wsl = (LAS float*)(lds + ATT_WS) + wid * 64; LAS float* li_l = wsl; LAS float* al_l = wsl + 32;
    const LAS float* rpb = (const LAS float*)(lds + ATT_RPB);
    float m_reg = -1e30f, l_reg = 0.f; f32x16 o[4];
#pragma unroll
    for (int d = 0; d < 4; ++d) o[d] = f32x16{};
    const int qi = wid * 32 + r32;
    const int tq = p.dil * (p.l0 + (qi & p.qmask)) + p.r0 + (qi >> p.qshift);
    bf16x8 qr[KS];
    { const bf16_t* Qw = p.Q + (size_t)tq * DQK + hi * 8;
#pragma unroll
      for (int d0 = 0; d0 < KS; ++d0) qr[d0] = *(const bf16x8*)(Qw + d0 * 16); }
    const int sr = tid >> 4, sc = (tid & 15) * 8, vst0 = v_st(sr, sc), vst1 = v_st(32 + sr, sc);
    const int vb0 = (int)(uintptr_t)V_lds + v_rd_base(lane);
    int krow[KCH], kcol[KCH];
#pragma unroll
    for (int i = 0; i < KCH; ++i) { const int c = tid + NTHR * i; krow[i] = c / (DQK / 8); kcol[i] = c % (DQK / 8); }
    u32x4 vs0, vs1, ksr[KCH];
#define ATT_TOK(j, row) (p.dil * (p.lk0 + 64 * ((j) & p.jmask) + (row)) + p.r0 + ((j) >> p.jshift))
#define ATT_CLAMP(t) ((t) < 0 ? 0 : ((t) > S - 1 ? S - 1 : (t)))
#define ATT_SLOAD(j) do { { const int t0 = ATT_CLAMP(ATT_TOK(j, sr)), t1 = ATT_CLAMP(ATT_TOK(j, 32 + sr)); \
        vs0 = *(const u32x4*)(p.V + (size_t)t0 * 128 + sc); vs1 = *(const u32x4*)(p.V + (size_t)t1 * 128 + sc); } \
        _Pragma("unroll") for (int _i = 0; _i < KCH; ++_i) { const int tk_ = ATT_CLAMP(ATT_TOK(j, krow[_i])); ksr[_i] = *(const u32x4*)(p.K + (size_t)tk_ * DQK + kcol[_i] * 8); } } while (0)
#define ATT_SWRITE(b) do { *(LAS u32x4*)(V_lds + (b) * SHM_V + vst0) = vs0; *(LAS u32x4*)(V_lds + (b) * SHM_V + vst1) = vs1; \
        _Pragma("unroll") for (int _i = 0; _i < KCH; ++_i) *(LAS u32x4*)(K_lds + (b) * SHMK + krow[_i] * PITCH + ((kcol[_i] * 16) ^ kswz<DQK>(krow[_i]))) = ksr[_i]; } while (0)
    ATT_SLOAD(0); MK_QHOOK(); ATT_SWRITE(0); __syncthreads();
    int na_rq = 0, na_cq = 0, na_rs = 0, na_cs = 0;
    if (MODE == 3) { na_rq = tq >> 6; na_cq = tq & 63; na_rs = na_rq - 4; na_rs = na_rs < 0 ? 0 : (na_rs > 24 ? 24 : na_rs); na_cs = na_cq - 8; na_cs = na_cs < 0 ? 0 : (na_cs > 48 ? 48 : na_cs); }
    for (int j = 0; j < p.NT; ++j) {
        const int cur = j & 1;
        if (j + 1 < p.NT) ATT_SLOAD(j + 1);
        const int kt0 = ATT_TOK(j, 0);
        bool skip = false;
        if (MODE == 2) { const int tq_lo = __builtin_amdgcn_readfirstlane(tq), tq_hi = tq_lo + 31 * p.dil, lim = 64 * p.dil;
            skip = (kt0 > tq_hi + lim) || (kt0 + 63 * p.dil < tq_lo - lim) || (((kt0 - tq_lo) & (p.dil - 1)) != 0); }
        if (MODE == 3) { const int rs_u = __builtin_amdgcn_readfirstlane(na_rs), rk = kt0 >> 6; skip = (rk < rs_u) || (rk >= rs_u + 8); }
        if (!skip) {
        f32x16 p0 = f32x16{}, p1 = f32x16{};
        { const LAS char* Ks = K_lds + cur * SHMK + r32 * PITCH; const int sw = kswz<DQK>(r32);
          bf16x8 c0 = *(const LAS bf16x8*)(Ks + ((hi * 16) ^ sw)), c1 = *(const LAS bf16x8*)(Ks + 32 * PITCH + ((hi * 16) ^ sw));
#pragma unroll
          for (int d0 = 0; d0 < KS; ++d0) { bf16x8 n0 = c0, n1 = c1;
            if (d0 + 1 < KS) { const int cb = (((d0 + 1) * 16 + hi * 8) * 2) ^ sw; n0 = *(const LAS bf16x8*)(Ks + cb); n1 = *(const LAS bf16x8*)(Ks + 32 * PITCH + cb); }
            __builtin_amdgcn_sched_barrier(0);
            p0 = __builtin_amdgcn_mfma_f32_32x32x16_bf16(c0, qr[d0], p0, 0, 0, 0);
            p1 = __builtin_amdgcn_mfma_f32_32x32x16_bf16(c1, qr[d0], p1, 0, 0, 0);
            __builtin_amdgcn_sched_barrier(0);
            c0 = n0; c1 = n1; } }
        if (MODE == 1) {
            const float base = (float)(kt0 + 4 * hi - tq);
#pragma unroll
            for (int r = 0; r < 16; ++r) { const float c = (float)((r & 3) + 8 * (r >> 2)); p0[r] = fmaf(fabsf(base + c), p.nslope, p0[r]); p1[r] = fmaf(fabsf(base + c + 32.0f), p.nslope, p1[r]); }
        }
        if (MODE == 2) {
            const int lim = 64 * p.dil, dm = p.dil - 1;
#pragma unroll
            for (int r = 0; r < 16; ++r) {
#pragma unroll
                for (int hf = 0; hf < 2; ++hf) { const int ki = crow(r, hi) + 32 * hf, tk = kt0 + ki * p.dil, d = tk - tq, ad = d < 0 ? -d : d;
                    const bool ok = ((unsigned)tk < (unsigned)S) && (ad <= lim) && ((d & dm) == 0);
                    if (hf) p1[r] = ok ? fmaf((float)ad, p.nslope, p1[r]) : -INFINITY; else p0[r] = ok ? fmaf((float)ad, p.nslope, p0[r]) : -INFINITY; } }
        }
        if (MODE == 3) {
            asm volatile("" : "+v"(na_cq), "+v"(na_cs));
            const int rk = kt0 >> 6; const bool rowok = (rk >= na_rs) && (rk < na_rs + 8); int ri = rk - na_rq + 7; ri = ri < 0 ? 0 : (ri > 14 ? 14 : ri);
            const LAS float* rb = rpb + ri * 128 + (63 - na_cq) + 4 * hi;
            const int cw = 4 * hi - na_cs;
#pragma unroll
            for (int r = 0; r < 16; ++r) {
#pragma unroll
                for (int hf = 0; hf < 2; ++hf) { const int c0 = (r & 3) + 8 * (r >> 2) + 32 * hf;
                    const bool ok = rowok && ((unsigned)(cw + c0) < 16u);
                    const float bv = rb[c0];
                    if (hf) p1[r] = ok ? p1[r] + bv : -INFINITY; else p0[r] = ok ? p0[r] + bv : -INFINITY; } }
        }
        float pmax = p0[0];
#pragma unroll
        for (int r = 1; r < 16; ++r) pmax = fmaxf(pmax, p0[r]);
#pragma unroll
        for (int r = 0; r < 16; ++r) pmax = fmaxf(pmax, p1[r]);
        { auto rr = __builtin_amdgcn_permlane32_swap(__float_as_uint(pmax), __float_as_uint(pmax), false, false); pmax = fmaxf(__uint_as_float(rr[0]), __uint_as_float(rr[1])); }
        float mn, alpha;
        if (__all(pmax - m_reg <= ATT_THR)) { mn = m_reg; alpha = 1.f; }
        else { mn = fmaxf(m_reg, pmax); alpha = __builtin_amdgcn_exp2f((m_reg - mn) * LOG2E); m_reg = mn; }
        const float mnC = -mn * LOG2E;
#pragma unroll
        for (int r = 0; r < 16; ++r) { p0[r] = __builtin_amdgcn_exp2f(fmaf(p0[r], LOG2E, mnC)); p1[r] = __builtin_amdgcn_exp2f(fmaf(p1[r], LOG2E, mnC)); }
        float ps = 0.f;
#pragma unroll
        for (int r = 0; r < 16; ++r) ps += p0[r];
#pragma unroll
        for (int r = 0; r < 16; ++r) ps += p1[r];
        { auto rr = __builtin_amdgcn_permlane32_swap(__float_as_uint(ps), __float_as_uint(ps), false, false); ps = __uint_as_float(rr[0]) + __uint_as_float(rr[1]); }
        l_reg = l_reg * alpha + ps;
        bf16x8 pa0, pa1, pa2, pa3;
#define ATT_PK4(P, BASE, OUT) do { unsigned a0 = pk_bf16(P[BASE + 0], P[BASE + 1]), a1 = pk_bf16(P[BASE + 2], P[BASE + 3]); \
        unsigned b0_ = pk_bf16(P[BASE + 4], P[BASE + 5]), b1_ = pk_bf16(P[BASE + 6], P[BASE + 7]); \
        auto r0_ = __builtin_amdgcn_permlane32_swap(a0, b0_, false, false); auto r1_ = __builtin_amdgcn_permlane32_swap(a1, b1_, false, false); \
        u32x4 w_ = {r0_[0], r1_[0], r0_[1], r1_[1]}; OUT = *reinterpret_cast<bf16x8*>(&w_); } while (0)
        ATT_PK4(p0, 0, pa0); ATT_PK4(p0, 8, pa1); ATT_PK4(p1, 0, pa2); ATT_PK4(p1, 8, pa3);
#undef ATT_PK4
        if (__any(alpha < 1.f)) { if (hi == 0) al_l[r32] = alpha; asm volatile("s_waitcnt lgkmcnt(0)" ::: "memory");
#pragma unroll
            for (int d = 0; d < 4; ++d)
#pragma unroll
                for (int r = 0; r < 16; ++r) o[d][r] *= al_l[crow(r, hi)]; }
        { const int vb = vb0 + cur * SHM_V;
          pv_all(o, vb, pa0, pa1, pa2, pa3); }
        }
        if (j + 1 < p.NT) ATT_SWRITE(cur ^ 1);
        __syncthreads();
    }
    if (hi == 0) li_l[r32] = l_reg;
    asm volatile("s_waitcnt lgkmcnt(0)" ::: "memory");
    if (p.lse != nullptr && hi == 0) p.lse[(size_t)tq * 8] = m_reg + __logf(l_reg);
#pragma unroll
    for (int r = 0; r < 16; ++r) { const int orow = crow(r, hi), qo = wid * 32 + orow; const int to = p.dil * (p.l0 + (qo & p.qmask)) + p.r0 + (qo >> p.qshift);
        const float lv = li_l[orow], rl = lv > 0.f ? 1.0f / lv : 0.f;
        bf16_t* orow_p = p.O + (size_t)to * p.opitch + r32;
#pragma unroll
        for (int d0 = 0; d0 < 4; ++d0) { const float ov = o[d0][r] * rl; if (p.o8) ((unsigned char*)p.O)[(size_t)to * p.opitch + r32 + d0 * 32] = (unsigned char)(pk_fp8x4(ov * O8_SCALE, 0.f, 0.f, 0.f) & 0xffu); else orow_p[d0 * 32] = (bf16_t)(pk_bf16(ov, 0.f) & 0xffffu); } }
    asm volatile("s_waitcnt lgkmcnt(0)" ::: "memory");
#undef ATT_TOK
#undef ATT_CLAMP
#undef ATT_SLOAD
#undef ATT_SWRITE
}


template <int MODE, int DQK>
__device__ __forceinline__ void attn_unit_p(const Frame& F, const AP p) {
    constexpr int KS = DQK / 16, PITCH = DQK * 2, SHMK = 64 * PITCH, KCH = DQK / 64;
    int tid_ = F.tid; asm volatile("" : "+v"(tid_));
    const int tid = tid_, wid = __builtin_amdgcn_readfirstlane(tid >> 6), lane = tid & 63, r32 = lane & 31, hi = lane >> 5;
    LAS char* lds = (LAS char*)F.lds;
    LAS char* V_lds = lds; LAS char* K_lds = lds + 2 * SHM_V;
    LAS float* wsl = (LAS float*)(lds + ATT_WS) + wid * 64; LAS float* li_l = wsl; LAS float* al_l = wsl + 32;
    float m_reg = -1e30f, l_reg = 0.f; f32x16 o[4];
#pragma unroll
    for (int d = 0; d < 4; ++d) o[d] = f32x16{};
    const int tq = p.l0 + wid * 32 + r32;
    bf16x8 qr[KS];
    { const bf16_t* Qw = p.Q + (size_t)tq * DQK + hi * 8;
#pragma unroll
      for (int d0 = 0; d0 < KS; ++d0) qr[d0] = *(const bf16x8*)(Qw + d0 * 16); }
    const int sr = tid >> 4, sc = (tid & 15) * 8, vst0 = v_st(sr, sc), vst1 = v_st(32 + sr, sc);
    const int vb0 = (int)(uintptr_t)V_lds + v_rd_base(lane);
    int krow[KCH], kcol[KCH];
#pragma unroll
    for (int i = 0; i < KCH; ++i) { const int c = tid + NTHR * i; krow[i] = c / (DQK / 8); kcol[i] = c % (DQK / 8); }
    u32x4 vsE0, vsE1, ksE[KCH], vsO0, vsO1, ksO[KCH];
#define AP_SLOAD(S, j) do { const int t0_ = p.lk0 + 64 * (j); vs##S##0 = *(const u32x4*)(p.V + (size_t)(t0_ + sr) * 128 + sc); vs##S##1 = *(const u32x4*)(p.V + (size_t)(t0_ + 32 + sr) * 128 + sc); \
        _Pragma("unroll") for (int _i = 0; _i < KCH; ++_i) ks##S[_i] = *(const u32x4*)(p.K + (size_t)(t0_ + krow[_i]) * DQK + kcol[_i] * 8); } while (0)
#define AP_SWRITE(b, S) do { *(LAS u32x4*)(V_lds + (b) * SHM_V + vst0) = vs##S##0; *(LAS u32x4*)(V_lds + (b) * SHM_V + vst1) = vs##S##1; \
        _Pragma("unroll") for (int _i = 0; _i < KCH; ++_i) *(LAS u32x4*)(K_lds + (b) * SHMK + krow[_i] * PITCH + ((kcol[_i] * 16) ^ kswz<DQK>(krow[_i]))) = ks##S[_i]; } while (0)
#define AP_QKT(P0, P1, b) do { P0 = f32x16{}; P1 = f32x16{}; const LAS char* Ks_ = K_lds + (b) * SHMK + r32 * PITCH; const int sw_ = kswz<DQK>(r32); \
        bf16x8 c0_ = *(const LAS bf16x8*)(Ks_ + ((hi * 16) ^ sw_)), c1_ = *(const LAS bf16x8*)(Ks_ + 32 * PITCH + ((hi * 16) ^ sw_)); \
        _Pragma("unroll") for (int d0 = 0; d0 < KS; ++d0) { bf16x8 n0_ = c0_, n1_ = c1_; \
            if (d0 + 1 < KS) { const int cb_ = (((d0 + 1) * 16 + hi * 8) * 2) ^ sw_; n0_ = *(const LAS bf16x8*)(Ks_ + cb_); n1_ = *(const LAS bf16x8*)(Ks_ + 32 * PITCH + cb_); } \
            P0 = __builtin_amdgcn_mfma_f32_32x32x16_bf16(c0_, qr[d0], P0, 0, 0, 0); P1 = __builtin_amdgcn_mfma_f32_32x32x16_bf16(c1_, qr[d0], P1, 0, 0, 0); c0_ = n0_; c1_ = n1_; } } while (0)
#define AP_PARTIAL(P0, P1, j, MN, AL) do { \
        if (MODE == 1) { const float base_ = (float)(p.lk0 + 64 * (j) + 4 * hi - tq); \
            _Pragma("unroll") for (int r = 0; r < 16; ++r) { const float c_ = (float)((r & 3) + 8 * (r >> 2)); P0[r] = fmaf(fabsf(base_ + c_), p.nslope, P0[r]); P1[r] = fmaf(fabsf(base_ + c_ + 32.0f), p.nslope, P1[r]); } } \
        float pmax_ = P0[0]; \
        _Pragma("unroll") for (int r = 1; r < 16; ++r) pmax_ = fmaxf(pmax_, P0[r]); \
        _Pragma("unroll") for (int r = 0; r < 16; ++r) pmax_ = fmaxf(pmax_, P1[r]); \
        { auto rr_ = __builtin_amdgcn_permlane32_swap(__float_as_uint(pmax_), __float_as_uint(pmax_), false, false); pmax_ = fmaxf(__uint_as_float(rr_[0]), __uint_as_float(rr_[1])); } \
        if (__builtin_expect(__all(pmax_ - m_reg <= ATT_THR), 1)) { MN = m_reg; AL = 1.f; } \
        else { MN = fmaxf(m_reg, pmax_); AL = __builtin_amdgcn_exp2f((m_reg - MN) * LOG2E); m_reg = MN; } \
        { const float mnC_ = -MN * LOG2E; \
          _Pragma("unroll") for (int r = 0; r < 16; ++r) { P0[r] = fmaf(P0[r], LOG2E, mnC_); P1[r] = fmaf(P1[r], LOG2E, mnC_); } \
          _Pragma("unroll") for (int r = 0; r < 16; ++r) P0[r] = __builtin_amdgcn_exp2f(P0[r]); } } while (0)
#define AP_PK4(P, BASE, OUT) do { unsigned a0 = pk_bf16(P[BASE + 0], P[BASE + 1]), a1 = pk_bf16(P[BASE + 2], P[BASE + 3]); \
        unsigned b0_ = pk_bf16(P[BASE + 4], P[BASE + 5]), b1_ = pk_bf16(P[BASE + 6], P[BASE + 7]); \
        auto r0_ = __builtin_amdgcn_permlane32_swap(a0, b0_, false, false); auto r1_ = __builtin_amdgcn_permlane32_swap(a1, b1_, false, false); \
        u32x4 w_ = {r0_[0], r1_[0], r0_[1], r1_[1]}; OUT = *reinterpret_cast<bf16x8*>(&w_); } while (0)
#define AP_FINISH(P0, P1, AL) do { \
        _Pragma("unroll") for (int r = 0; r < 16; ++r) P1[r] = __builtin_amdgcn_exp2f(P1[r]); \
        float ps_ = 0.f; \
        _Pragma("unroll") for (int r = 0; r < 16; ++r) ps_ += P0[r]; \
        _Pragma("unroll") for (int r = 0; r < 16; ++r) ps_ += P1[r]; \
        { auto rr_ = __builtin_amdgcn_permlane32_swap(__float_as_uint(ps_), __float_as_uint(ps_), false, false); ps_ = __uint_as_float(rr_[0]) + __uint_as_float(rr_[1]); } \
        l_reg = l_reg * (AL) + ps_; \
        AP_PK4(P0, 0, pa0); AP_PK4(P0, 8, pa1); AP_PK4(P1, 0, pa2); AP_PK4(P1, 8, pa3); } while (0)
#define AP_PV(b) do { const int vb_ = vb0 + (b) * SHM_V; pv_all(o, vb_, pa0, pa1, pa2, pa3); } while (0)
#define AP_RESC(a) do { if (__any((a) < 1.f)) { if (hi == 0) al_l[r32] = (a); asm volatile("s_waitcnt lgkmcnt(0)" ::: "memory"); \
        _Pragma("unroll") for (int d = 0; d < 4; ++d) _Pragma("unroll") for (int r = 0; r < 16; ++r) o[d][r] *= al_l[crow(r, hi)]; } } while (0)
#define AP_SB() __builtin_amdgcn_sched_barrier(0)
    f32x16 pA0, pA1, pB0, pB1; float mnA, mnB, alA, alB; bf16x8 pa0, pa1, pa2, pa3; const int NT = p.NT;
    AP_SLOAD(E, 0); MK_QHOOK(); AP_SWRITE(0, E); __syncthreads();
    AP_QKT(pA0, pA1, 0); AP_PARTIAL(pA0, pA1, 0, mnA, alA);
    AP_SLOAD(O, 1); if (2 < NT) AP_SLOAD(E, 2);
    AP_SWRITE(1, O); __syncthreads();
    for (int j = 1; j + 1 < NT; j += 2) {
        AP_SB(); AP_QKT(pB0, pB1, 1); AP_FINISH(pA0, pA1, alA); AP_SB();
        AP_SLOAD(O, j + 2); AP_SB();
        AP_PV(0); AP_PARTIAL(pB0, pB1, j, mnB, alB);
        __syncthreads(); AP_SWRITE(0, E);
        AP_RESC(alB); __syncthreads();
        AP_SB(); AP_QKT(pA0, pA1, 0); AP_FINISH(pB0, pB1, alB); AP_SB();
        if (j + 3 < NT) AP_SLOAD(E, j + 3); AP_SB();
        AP_PV(1); AP_PARTIAL(pA0, pA1, j + 1, mnA, alA);
        __syncthreads(); AP_SWRITE(1, O);
        AP_RESC(alA); __syncthreads();
    }
    AP_SB(); AP_QKT(pB0, pB1, 1); AP_FINISH(pA0, pA1, alA); AP_SB();
    AP_PV(0); AP_PARTIAL(pB0, pB1, NT - 1, mnB, alB);
    __syncthreads(); AP_RESC(alB);
    AP_FINISH(pB0, pB1, alB); AP_SB();
    AP_PV(1);
    (void)mnA; (void)mnB;
    if (hi == 0) li_l[r32] = l_reg;
    asm volatile("s_waitcnt lgkmcnt(0)" ::: "memory");
#pragma unroll
    for (int r = 0; r < 16; ++r) { const int orow = crow(r, hi), to = p.l0 + wid * 32 + orow;
        const float lv = li_l[orow], rl = lv > 0.f ? 1.0f / lv : 0.f;
        bf16_t* orow_p = p.O + (size_t)to * p.opitch + r32;
#pragma unroll
        for (int d0 = 0; d0 < 4; ++d0) { const float ov = o[d0][r] * rl; if (p.o8) ((unsigned char*)p.O)[(size_t)to * p.opitch + r32 + d0 * 32] = (unsigned char)(pk_fp8x4(ov * O8_SCALE, 0.f, 0.f, 0.f) & 0xffu); else orow_p[d0 * 32] = (bf16_t)(pk_bf16(ov, 0.f) & 0xffffu); } }
    asm volatile("s_waitcnt lgkmcnt(0)" ::: "memory");
    __syncthreads();
#undef AP_SLOAD
#undef AP_SWRITE
#undef AP_QKT
#undef AP_PARTIAL
#undef AP_PK4
#undef AP_FINISH
#undef AP_PV
#undef AP_RESC
#undef AP_SB
}

__device__ __forceinline__ void p_attention(const Frame& F, int l, int gs) {
    unsigned char* qkv = F.ws + WS_QKV;
    constexpr int N_MLA = 512, N_DIFF = 1024, N_NA = 512, N_D1 = 512, N_D4 = 512, N_D16 = 512, N_ALL = N_MLA + N_DIFF + N_NA + N_D1 + N_D4 + N_D16;
    static_assert(N_ALL == 8 * (int)QN, "queue size");
    const int ls = 2 * l + gs;
    unsigned* qctr = (unsigned*)(F.a->ws + WS_CTL) + 12288 + 256 * ls;
    volatile LAS unsigned* qs = (volatile LAS unsigned*)(F.lds + LDS_QS);
    { int t_ = F.tid; asm volatile("" : "+v"(t_)); if (t_ == 0) qs[0] = q_pop(qctr, xb_xcc_id() & 3u); }
    __syncthreads();
    for (int par = 0; ; par ^= 1) {
        const int u = __builtin_amdgcn_readfirstlane((int)qs[par]);
        if (u == (int)QEND) break;
        const int xl = u >> 9, qi_ = u & 511, sub = qi_ & 7; int v = qi_ >> 3, cat = 0;
        if (v >= 8) { v -= 8; cat = 1; if (v >= 16) { v -= 16; cat = 2; if (v >= 8) { v -= 8; cat = 3; if (v >= 8) { v -= 8; cat = 4; if (v >= 8) { v -= 8; cat = 5; } } } } }
        AP p; p.qinfo = (ls << 8) | (xl << 1) | (par ^ 1); p.lse = nullptr; p.opitch = 1024; p.o8 = 0; p.dil = 1; p.r0 = 0; p.qmask = 255; p.qshift = 8; p.jmask = 63; p.jshift = 6; p.nslope = 0.f; p.lk0 = 0; p.NT = 32;
        if (cat == 1) {
            const int b = xl, hp = 15 - v, h = hp >> 1, c = hp & 1;
            p.Q = (const bf16_t*)(qkv + QO_QA) + (size_t)(b * 16 + hp) * S * 64; p.K = (const bf16_t*)(qkv + QO_KA) + (size_t)(b * 16 + hp) * S * 64; p.V = (const bf16_t*)(qkv + QO_VA) + (size_t)(b * 8 + h) * S * 128;
            p.O = (bf16_t*)(F.ws + WS_P + PO_OA + (size_t)c * SZ_H1) + (size_t)b * S * 1024 + h * 128; p.l0 = sub * 256; p.nslope = -exp2f(-(float)(h + 1));
            {
                const int dmax = 1 << (h + 7), q0 = sub * 256; int jlo = (q0 - dmax + 1) >> 6; jlo = jlo < 0 ? 0 : jlo; int jhi = (q0 + 255 + dmax - 1) >> 6; jhi = jhi > 31 ? 31 : jhi;
                if (((jhi - jlo + 1) & 1) != 0) { if (jlo > 0) --jlo; else ++jhi; }
                p.lk0 = 64 * jlo; p.NT = jhi - jlo + 1; }
#if !defined(MK_ATT_ONLY) || MK_ATT_ONLY == 1
            attn_unit_p<1, 64>(F, p);
#endif
        } else {
            const int b = xl, h = v; const size_t ho = (size_t)(b * 8 + h) * S;
            if (cat == 0) {
                p.Q = (const bf16_t*)(qkv + QO_QD) + ho * 192; p.K = (const bf16_t*)(qkv + QO_KD) + ho * 192; p.V = (const bf16_t*)(qkv + QO_VD) + ho * 128;
                p.O = (bf16_t*)(F.ws + WS_O + (size_t)b * S * DM + 3072 + h * 128); p.opitch = DM; p.o8 = 1; p.l0 = sub * 256;
#if !defined(MK_ATT_ONLY) || MK_ATT_ONLY == 0
                attn_unit<0, 192>(F, p);
#endif
            } else if (cat == 2) {
                p.Q = (const bf16_t*)(qkv + QO_QC) + ho * 128; p.K = (const bf16_t*)(qkv + QO_KC) + ho * 128; p.V = (const bf16_t*)(qkv + QO_VC) + ho * 128;
                p.O = (bf16_t*)(F.ws + WS_O + (size_t)b * S * DM + 2048 + h * 128); p.opitch = DM; p.o8 = 1; p.l0 = sub * 256;
                const int R0 = sub * 4; int first = R0 - 4; first = first < 0 ? 0 : (first > 24 ? 24 : first); int lastb = R0 - 1; lastb = lastb < 0 ? 0 : (lastb > 24 ? 24 : lastb);
                p.lk0 = first * 64; p.NT = lastb + 7 - first + 1;
                { LAS float* rp = (LAS float*)(F.lds + ATT_RPB); const float* src = F.a->in[I_RPB] + (size_t)(l * 8 + h) * 465; int ti = F.tid; asm volatile("" : "+v"(ti)); if (ti < 465) rp[(ti / 31) * 128 + 48 + (ti % 31)] = src[ti]; }
#if !defined(MK_ATT_ONLY) || MK_ATT_ONLY == 3
                attn_unit<3, 128>(F, p);
#endif
            } else {
                const int br = cat - 3;
                p.Q = (const bf16_t*)(qkv + QO_QB) + ho * 128; p.K = (const bf16_t*)(qkv + QO_KB) + ho * 128; p.V = (const bf16_t*)(qkv + QO_VB) + ho * 128;
                p.O = (bf16_t*)(F.ws + WS_P + PO_OB + (size_t)br * SZ_H1) + (size_t)b * S * 1024 + h * 128;
                p.lse = (float*)(F.ws + WS_P + PO_LSE) + (size_t)br * T * 8 + (size_t)b * S * 8 + h; p.nslope = -exp2f(-(float)(h + 1));
                if (br == 0) { p.dil = 1; p.l0 = sub * 256; p.lk0 = p.l0 - 64; p.NT = 6; }
                else if (br == 1) { p.dil = 4; p.r0 = sub >> 1; p.l0 = (sub & 1) * 256; p.lk0 = p.l0 - 64; p.NT = 6; }
                else { p.dil = 16; p.r0 = sub * 2; p.l0 = 0; p.qmask = 127; p.qshift = 7; p.lk0 = 0; p.jmask = 1; p.jshift = 1; p.NT = 4; }
#if !defined(MK_ATT_ONLY) || MK_ATT_ONLY == 2
                attn_unit<2, 128>(F, p);
#endif
            }
        }
    }
}

__device__ __forceinline__ void p_post3(const Frame& F, int l) {
    const bf16_t* OA0 = (const bf16_t*)(F.ws + WS_P + PO_OA); const bf16_t* OA1 = OA0 + (size_t)T * 1024; const bf16_t* OB = (const bf16_t*)(F.ws + WS_P + PO_OB);
    const float* LSE = (const float*)(F.ws + WS_P + PO_LSE);
    unsigned char* O = F.ws + WS_O;
    const int lane = F.lane;
    const float* lv = F.a->in[I_DLAM] + l * 4 * 64;
    const float s01 = wsum(lv[lane] * lv[64 + lane]), s23 = wsum(lv[128 + lane] * lv[192 + lane]);
    const float lam_init = 0.8f - 0.6f * expf(-0.3f * (float)l), lam = expf(s01) - expf(s23) + lam_init;
    const float* gout = F.a->in[I_DGOUT] + l * 128 + (lane & 7) * 16;
    for (int t = F.rank * NWAVES + F.wid; t < T; t += F.nwg * NWAVES) {
        const size_t ro = (size_t)t * 1024 + lane * 16; unsigned char* orow = O + (size_t)t * DM + lane * 16;
        const int h = lane >> 3;
        u32x4 ra[2], rb[2], r0[2], r1[2], r2[2];
#pragma unroll
        for (int i = 0; i < 2; ++i) { ra[i] = *(const u32x4*)(OA0 + ro + 8 * i); rb[i] = *(const u32x4*)(OA1 + ro + 8 * i); r0[i] = *(const u32x4*)(OB + ro + 8 * i);
            r1[i] = *(const u32x4*)(OB + (size_t)T * 1024 + ro + 8 * i); r2[i] = *(const u32x4*)(OB + (size_t)2 * T * 1024 + ro + 8 * i); }
        float e0 = LSE[(size_t)t * 8 + h], e1 = LSE[(size_t)T * 8 + (size_t)t * 8 + h], e2 = LSE[(size_t)2 * T * 8 + (size_t)t * 8 + h];
        asm volatile("" : "+v"(e0), "+v"(e1), "+v"(e2) :: "memory");
        {
            float xa[16], xb[16], d[16]; unpack16(ra[0], ra[1], xa); unpack16(rb[0], rb[1], xb); float ss = 0.f;
#pragma unroll
            for (int j = 0; j < 16; ++j) { d[j] = xa[j] - lam * xb[j]; ss += d[j] * d[j]; }
            ss = sum8(ss);
            const float r = rsqrtf(ss * (1.0f / 128) + EPS) * (1.0f - lam_init);
            u32x4 w0; const float r8 = r * O8_SCALE;
#pragma unroll
            for (int i = 0; i < 4; ++i) w0[i] = pk_fp8x4(d[4 * i] * r8 * gout[4 * i], d[4 * i + 1] * r8 * gout[4 * i + 1], d[4 * i + 2] * r8 * gout[4 * i + 2], d[4 * i + 3] * r8 * gout[4 * i + 3]);
            *(u32x4*)orow = w0;
        }
        {
            const float m = fmaxf(e0, fmaxf(e1, e2)); float w0 = __expf(e0 - m), w1 = __expf(e1 - m), w2 = __expf(e2 - m); const float inv = 1.0f / (w0 + w1 + w2); w0 *= inv; w1 *= inv; w2 *= inv;
            float x0[16], x1[16], x2[16], d[16]; unpack16(r0[0], r0[1], x0); unpack16(r1[0], r1[1], x1); unpack16(r2[0], r2[1], x2);
#pragma unroll
            for (int j = 0; j < 16; ++j) d[j] = w0 * x0[j] + w1 * x1[j] + w2 * x2[j];
            u32x4 y0;
#pragma unroll
            for (int i = 0; i < 4; ++i) y0[i] = pk_fp8x4(d[4 * i] * O8_SCALE, d[4 * i + 1] * O8_SCALE, d[4 * i + 2] * O8_SCALE, d[4 * i + 3] * O8_SCALE);
            *(u32x4*)(orow + 1024) = y0;
        }
    }
}

__device__ __forceinline__ int med3i(int a, int b, int c) { return max(min(a, b), min(max(a, b), c)); }
__device__ __forceinline__ int ordkey(float v) { const int x = __float_as_int(v); return x ^ ((x >> 31) & 0x7fffffff); }
#define MK_INSERT(L, key) do { _Pragma("unroll") for (int _k = 15; _k >= 1; --_k) L[_k] = med3i((key), L[_k - 1], L[_k]); L[0] = max((key), L[0]); } while (0)
__device__ __forceinline__ void p_select(const Frame& F, int l) {
    const float* SC = (const float*)(F.ws + WS_P + PO_SC); int* EX = (int*)(F.ws + WS_P + PO_EXP); float* GT = (float*)(F.ws + WS_P + PO_GATE);
    LAS float* L = (LAS float*)F.lds;
    const int tid = F.tid;
    for (int blk = F.rank * NWAVES + F.wid; blk < T * 8 / 64; blk += F.nwg * NWAVES) {
        const int pid = blk * 64 + F.lane, t = pid >> 3, h = pid & 7;
        const float* sc = SC + (size_t)t * 2048 + h * 256;
        float fa[16], fb[16];
#pragma unroll
        for (int c = 0; c < 2; ++c) {
            int Lk[16];
#pragma unroll
            for (int k = 0; k < 16; ++k) Lk[k] = (int)0x80000000;
            for (int n32 = 0; n32 < 4; ++n32) { f32x4 v[8];
#pragma unroll
                for (int q = 0; q < 8; ++q) v[q] = *(const f32x4*)(sc + c * 128 + n32 * 32 + q * 4);
#pragma unroll
                for (int q = 0; q < 8; ++q)
#pragma unroll
                    for (int e = 0; e < 4; ++e) { const int key = (ordkey(v[q][e]) & ~127) | (n32 * 32 + q * 4 + e); MK_INSERT(Lk, key); } }
#pragma unroll
            for (int k = 0; k < 16; ++k) { const int idx = Lk[k] & 127; const float val = sc[c * 128 + idx];
                if (c == 0) fa[k] = val; else fb[k] = val;
                L[(c * 32 + k) * NTHR + tid] = val; L[(c * 32 + 16 + k) * NTHR + tid] = __int_as_float(idx); }
        }
        int Mk[16];
#pragma unroll
        for (int k = 0; k < 16; ++k) Mk[k] = (int)0x80000000;
#pragma unroll
        for (int i = 0; i < 16; ++i)
#pragma unroll
            for (int j = 0; j < 16; ++j) if ((i + 1) * (j + 1) <= 16) { const int key = (ordkey(fa[i] + fb[j]) & ~255) | (i * 16 + j); MK_INSERT(Mk, key); }
        asm volatile("s_waitcnt lgkmcnt(0)" ::: "memory");
        float sk[16]; int ek[16]; float mx = -INFINITY;
#pragma unroll
        for (int k = 0; k < 16; ++k) { const int code = Mk[k] & 255, i = code >> 4, j = code & 15;
            sk[k] = L[i * NTHR + tid] + L[(32 + j) * NTHR + tid];
            ek[k] = __float_as_int(L[(16 + i) * NTHR + tid]) * 128 + __float_as_int(L[(48 + j) * NTHR + tid]); mx = fmaxf(mx, sk[k]); }
        const float inv = 1.0f; (void)mx;
#pragma unroll
        for (int k = 0; k < 4; ++k) { *(int4*)(EX + (size_t)t * 128 + h * 16 + 4 * k) = make_int4(ek[4 * k], ek[4 * k + 1], ek[4 * k + 2], ek[4 * k + 3]);
            *(f32x4*)(GT + (size_t)t * 128 + h * 16 + 4 * k) = (f32x4){sk[4 * k] * inv, sk[4 * k + 1] * inv, sk[4 * k + 2] * inv, sk[4 * k + 3] * inv}; }
        asm volatile("s_waitcnt lgkmcnt(0)" ::: "memory");
    }
}

typedef float f32x2 __attribute__((ext_vector_type(2)));
typedef _Float16 h16x2 __attribute__((ext_vector_type(2)));
__device__ __forceinline__ void p_gather(const Frame& F, int l, int gs) {
    const bf16_t* HN = (const bf16_t*)(F.ws + WS_HN); const int* EX = (const int*)(F.ws + WS_P + PO_EXP); const float* GT = (const float*)(F.ws + WS_P + PO_GATE);
    const unsigned char* U = F.a->ws + WS_W + (size_t)l * LW_END + LW_U; const unsigned char* V = F.a->ws + WS_W + (size_t)l * LW_END + LW_V;
#define MK_LANE() ({ unsigned z_ = 0u; asm volatile("" : "+v"(z_)); (int)__builtin_amdgcn_mbcnt_hi(~0u, __builtin_amdgcn_mbcnt_lo(~0u, z_)); })
    unsigned* tctr = (unsigned*)(F.a->ws + WS_CTL) + 14336 + 64 * (2 * l + gs);
#define MK_TPOP(ln) ({ unsigned v_ = 0u; if ((ln) == 0) v_ = xb_add(tctr, 1u); v_; })
    int tnext = __builtin_amdgcn_readfirstlane((int)MK_TPOP(MK_LANE()));
    for (int t = tnext; t < T; t = tnext) {
        int lane = MK_LANE();
        const unsigned tv = MK_TPOP(lane);
        h16x2 hh[32];
        float ssq = 0.f;
#pragma unroll
        for (int c = 0; c < 16; ++c) { const u32x2 a = *(const u32x2*)(HN + (size_t)t * DM + c * 256 + 4 * lane); const float a0 = bf_lo(a.x), a1 = bf_hi(a.x), a2 = bf_lo(a.y), a3 = bf_hi(a.y);
            ssq += (a0 * a0 + a1 * a1) + (a2 * a2 + a3 * a3); hh[2 * c] = (h16x2){(_Float16)a0, (_Float16)a1}; hh[2 * c + 1] = (h16x2){(_Float16)a2, (_Float16)a3}; }
        const float rstd = rsqrtf(wave_total(ssq) * (1.0f / DM) + EPS);
        tnext = __builtin_amdgcn_readfirstlane((int)tv); asm volatile("" : "+s"(tnext));
        const int e0 = EX[(size_t)t * 128 + lane], e1 = EX[(size_t)t * 128 + 64 + lane]; float g0 = GT[(size_t)t * 128 + lane] * rstd, g1 = GT[(size_t)t * 128 + 64 + lane] * rstd;
        {
            float m0 = g0, m1 = g1;
#define MK_DPP_MAX(v, ctrl) v = fmaxf(v, __int_as_float(__builtin_amdgcn_update_dpp(0, __float_as_int(v), ctrl, 0xF, 0xF, true)))
            MK_DPP_MAX(m0, 0xB1); MK_DPP_MAX(m0, 0x4E); MK_DPP_MAX(m0, 0x141); MK_DPP_MAX(m0, 0x140); MK_DPP_MAX(m1, 0xB1); MK_DPP_MAX(m1, 0x4E); MK_DPP_MAX(m1, 0x141); MK_DPP_MAX(m1, 0x140);
#undef MK_DPP_MAX
            g0 = __expf(g0 - m0); g1 = __expf(g1 - m1); float s0 = g0, s1 = g1;
            MK_DPP_ADD(s0, 0xB1); MK_DPP_ADD(s0, 0x4E); MK_DPP_ADD(s0, 0x141); MK_DPP_ADD(s0, 0x140); MK_DPP_ADD(s1, 0xB1); MK_DPP_ADD(s1, 0x4E); MK_DPP_ADD(s1, 0x141); MK_DPP_ADD(s1, 0x140);
            g0 /= s0; g1 /= s1; }
        const float zs = rstd * (1.0f / U_SCALE);
#define MK_GRP(w, q) (u32x6){w[(6 * (q) + 0) >> 2][(6 * (q) + 0) & 3], w[(6 * (q) + 1) >> 2][(6 * (q) + 1) & 3], w[(6 * (q) + 2) >> 2][(6 * (q) + 2) & 3], w[(6 * (q) + 3) >> 2][(6 * (q) + 3) & 3], w[(6 * (q) + 4) >> 2][(6 * (q) + 4) & 3], w[(6 * (q) + 5) >> 2][(6 * (q) + 5) & 3]}
#define MK_ROWS(buf, TAB, k) do { const int ev_ = (k) < 16 ? e0 : e1; _Pragma("unroll") for (int j_ = 0; j_ < 4; ++j_) { const int e_ = __builtin_amdgcn_readlane(ev_, (4 * (k) + j_) & 63); \
            const unsigned char* r_ = TAB + (size_t)e_ * 3072 + lane * 16; _Pragma("unroll") for (int c_ = 0; c_ < 3; ++c_) buf[j_][c_] = *(const u32x4*)(r_ + c_ * 1024); } } while (0)
        int wv0 = 0, wv1 = 0;
#define MK_DPPF(v, ctrl) __int_as_float(__builtin_amdgcn_update_dpp(0, __float_as_int(v), ctrl, 0xF, 0xF, true))
#define MK_UCOMP(buf, k) do { float p_[4]; _Pragma("unroll") for (int j_ = 0; j_ < 4; ++j_) { float za_ = 0.f, zb_ = 0.f; \
            _Pragma("unroll") for (int q_ = 0; q_ < 2; ++q_) { const h16x32 d_ = __builtin_amdgcn_cvt_scalef32_pk32_f16_fp6(MK_GRP(buf[j_], q_), 1.0f); \
                _Pragma("unroll") for (int p2_ = 0; p2_ < 16; p2_ += 2) { za_ = __builtin_amdgcn_fdot2((h16x2){d_[2 * p2_], d_[2 * p2_ + 1]}, hh[q_ * 16 + p2_], za_, false); \
                    zb_ = __builtin_amdgcn_fdot2((h16x2){d_[2 * p2_ + 2], d_[2 * p2_ + 3]}, hh[q_ * 16 + p2_ + 1], zb_, false); } } \
            p_[j_] = za_ + zb_; } \
            const bool o0_ = (lane & 1) != 0, o1_ = (lane & 2) != 0; \
            const float r01_ = (o0_ ? p_[1] : p_[0]) + MK_DPPF((o0_ ? p_[0] : p_[1]), 0xB1), r23_ = (o0_ ? p_[3] : p_[2]) + MK_DPPF((o0_ ? p_[2] : p_[3]), 0xB1); \
            float r_ = (o1_ ? r23_ : r01_) + MK_DPPF((o1_ ? r01_ : r23_), 0x4E); \
            r_ += MK_DPPF(r_, 0x124); r_ += MK_DPPF(r_, 0x128); \
            { auto s_ = __builtin_amdgcn_permlane16_swap(__float_as_uint(r_), __float_as_uint(r_), false, false); r_ = __uint_as_float(s_[0]) + __uint_as_float(s_[1]); } \
            { auto s_ = __builtin_amdgcn_permlane32_swap(__float_as_uint(r_), __float_as_uint(r_), false, false); r_ = __uint_as_float(s_[0]) + __uint_as_float(s_[1]); } \
            const bool me_ = (lane >> 2) == ((k) & 15); \
            if ((k) < 16) wv0 = me_ ? __float_as_int(r_) : wv0; else wv1 = me_ ? __float_as_int(r_) : wv1; } while (0)
        {
            u32x4 b0[4][3], b1[4][3], b2[4][3];
            MK_ROWS(b0, U, 0); MK_ROWS(b1, U, 1);
            for (int k = 0; k < 30; k += 3) { MK_ROWS(b2, U, k + 2); MK_UCOMP(b0, k); MK_ROWS(b0, U, k + 3); MK_UCOMP(b1, k + 1); MK_ROWS(b1, U, k + 4); MK_UCOMP(b2, k + 2); }
            MK_UCOMP(b0, 30); MK_UCOMP(b1, 31);
        }
        {
            const float z0 = __int_as_float(wv0) * zs, z1 = __int_as_float(wv1) * zs;
            wv0 = __float_as_int(g0 * 0.5f * z0 * (1.0f + erff(z0 * 0.7071067811865476f)) * (1.0f / V_SCALE));
            wv1 = __float_as_int(g1 * 0.5f * z1 * (1.0f + erff(z1 * 0.7071067811865476f)) * (1.0f / V_SCALE)); }
        f32x2 acc[32];
#pragma unroll
        for (int i = 0; i < 32; ++i) acc[i] = (f32x2){0.f, 0.f};
#define MK_VCOMP(buf, k) do { const int wv_ = (k) < 16 ? wv0 : wv1; _Pragma("unroll") for (int j_ = 0; j_ < 4; ++j_) { const float w_ = __int_as_float(__builtin_amdgcn_readlane(wv_, (4 * (k) + j_) & 63)); const f32x2 w2_ = (f32x2){w_, w_}; \
            _Pragma("unroll") for (int q_ = 0; q_ < 2; ++q_) { const f32x32v d_ = __builtin_amdgcn_cvt_scalef32_pk32_f32_fp6(MK_GRP(buf[j_], q_), 1.0f); \
                _Pragma("unroll") for (int p_ = 0; p_ < 16; ++p_) acc[q_ * 16 + p_] = __builtin_elementwise_fma((f32x2){d_[2 * p_], d_[2 * p_ + 1]}, w2_, acc[q_ * 16 + p_]); } } } while (0)
        {
            u32x4 b0[4][3], b1[4][3];
            MK_ROWS(b0, V, 0);
            for (int k = 0; k < 32; k += 2) { MK_ROWS(b1, V, k + 1); MK_VCOMP(b0, k); if (k + 2 < 32) MK_ROWS(b0, V, k + 2); MK_VCOMP(b1, k + 1); }
        }
#undef MK_ROWS
#undef MK_UCOMP
#undef MK_DPPF
#undef MK_VCOMP
#undef MK_GRP
        asm volatile("" : "+v"(lane));
        float* xr = F.out + (size_t)t * DM + 4 * lane; f32x4 xo[16]; float ss = 0.f;
#pragma unroll
        for (int c = 0; c < 16; ++c) xo[c] = *(const f32x4*)(xr + c * 256);
#pragma unroll
        for (int c = 0; c < 16; ++c) { f32x4 a = xo[c]; const int q = c >> 3, pb_ = 2 * (c & 7);
            a[0] += acc[q * 16 + pb_].x; a[1] += acc[q * 16 + pb_].y; a[2] += acc[q * 16 + pb_ + 1].x; a[3] += acc[q * 16 + pb_ + 1].y; *(f32x4*)(xr + c * 256) = a; xo[c] = a;
            ss += (a[0] * a[0] + a[1] * a[1]) + (a[2] * a[2] + a[3] * a[3]); }
        if (l == 0) {
            const float r = rsqrtf(wave_total(ss) * (1.0f / DM) + EPS) * HN8_SCALE; unsigned char* hr = F.ws + WS_T2 + TO_HN8 + (size_t)t * DM + 4 * lane;
#pragma unroll
            for (int c = 0; c < 16; ++c) *(unsigned*)(hr + c * 256) = pk_fp8x4(xo[c][0] * r, xo[c][1] * r, xo[c][2] * r, xo[c][3] * r); }
    }
#undef MK_TPOP
#undef MK_LANE
}

__global__ void __launch_bounds__(NTHR, 2) mk_fwd(Args args) {
    extern __shared__ __attribute__((aligned(16))) unsigned char lds_raw[];
    Frame F;
    F.a = &args;
    F.out = args.out; F.ws = args.ws; F.lds = (LAS unsigned char*)lds_raw;
    const int wave_id = __builtin_amdgcn_readfirstlane((int)threadIdx.x >> 6);
#define MK_TID() ({ unsigned z_ = 0u; asm volatile("" : "+v"(z_)); wave_id * 64 + (int)__builtin_amdgcn_mbcnt_hi(~0u, __builtin_amdgcn_mbcnt_lo(~0u, z_)); })
    F.tid = MK_TID(); F.lane = F.tid & 63; F.wid = wave_id; F.rank = (int)blockIdx.x; F.nwg = (int)gridDim.x;
#define MK_BAR_PTR(full) ((unsigned*)(args.ws + WS_CTL) + ((full) ? 0 : 4096 * (1 + sid())))
    if (MK_TID() == 0) *(LAS u32x4*)(F.lds + LDS_XB) = (u32x4){0u, 0u, 0u, 0u};
    __syncthreads();
    (void)xcd_barrier_post(MK_BAR_PTR(1), (volatile LAS unsigned*)(F.lds + LDS_XB), MK_TID() == 0);
    (void)xcd_barrier_post(MK_BAR_PTR(0), (volatile LAS unsigned*)(F.lds + LDS_XB + 8), MK_TID() == 0);
#ifndef MK_ONLY
#define MK_ONLY -1
#endif
#define MK_EN(s) (MK_ONLY < 0 || MK_ONLY == (s))
#define MK_FRESH(gs, all) do { int t_ = MK_TID(); asm volatile("" : "+v"(t_)); F.tid = t_; F.lane = t_ & 63; F.wid = __builtin_amdgcn_readfirstlane(t_ >> 6); \
        F.rank = (all) ? (int)blockIdx.x : wg_rank(); F.nwg = (all) ? (int)gridDim.x : wg_count(); \
        __attribute__((address_space(1))) unsigned char* w_ = (__attribute__((address_space(1))) unsigned char*)(args.ws + (size_t)(gs) * ACT_SZ); \
        __attribute__((address_space(1))) float* o_ = (__attribute__((address_space(1))) float*)(args.out + (size_t)(gs) * T * DM); \
        asm volatile("" : "+s"(w_), "+s"(o_)); F.ws = (unsigned char*)w_; F.out = (float*)o_; } while (0)
#define MK_BAR(full) do { XcdBarrier b_; b_.bar = MK_BAR_PTR(full); b_.x = xb_xcc_id(); b_.G = (full) ? gridDim.x : (gridDim.x >> 1); b_.st = (volatile LAS unsigned*)(F.lds + LDS_XB + ((full) ? 0 : 8)); \
        xcd_barrier(b_, MK_TID() == 0); } while (0)
    if (MK_EN(100)) { MK_FRESH(0, 1); p0_a(F); MK_FRESH(0, 1); p0_b(F, (int)blockIdx.x, (int)gridDim.x);
        for (int gs = 0; gs < 2; ++gs) { MK_FRESH(gs, 1); p_norm(F, F.a->in[I_X] + (size_t)gs * T * DM, (bf16_t*)(F.ws + WS_T2 + TO_HN8)); } }
    MK_BAR(1);
#ifndef MK_NHEAD
#define MK_NHEAD 4
#endif
#ifndef MK_JTAIL
#define MK_JTAIL 15
#endif
    const int nsteps = (sid() == 0) ? (18 + 18 - MK_JTAIL) : (MK_NHEAD + 18);
    for (int i = 0; i < nsteps; ++i) {
        int gs, g, all, nall;
        if (sid() == 0) { if (i < 18) { gs = 0; g = i; all = i < MK_NHEAD; nall = (i + 1 < MK_NHEAD) || (i + 1 >= 18); } else { gs = 1; g = MK_JTAIL + (i - 18); all = 1; nall = 1; } }
        else { if (i < MK_NHEAD) { gs = 0; g = i; all = 1; nall = (i + 1 < MK_NHEAD); } else { gs = 1; g = i - MK_NHEAD; all = g >= MK_JTAIL; nall = (g + 1 >= MK_JTAIL); } }
        const int l = g >= 9 ? 1 : 0, st = g - 9 * l;
#define lw (F.a->ws + WS_W + (size_t)l * LW_END)
#define xin ((l == 0) ? (F.a->in[I_X] + (size_t)gs * T * DM) : (const float*)F.out)
        MK_FRESH(gs, all);
        if (st == 0) {
            if (MK_EN(1)) { pg8::Gemm gm{(const bf16_t*)(F.ws + WS_T2 + TO_HN8), (const bf16_t*)(lw + LW_WIN), T, NINP, DM}; pg8::StaticOrder So; So.init(T, NINP, F.nwg, F.rank);
                pg8::EpiG1N E{(bf16_t*)(F.ws + WS_P), NINP, (bf16_t*)(F.ws + WS_QKV), SZ_H1 / 2, 1.0f / (HN8_SCALE * WIN8_SCALE), F.a->in[I_DGQK] + l * 128, F.a->in[I_DILG] + l * 256, F.a->in[I_NAG] + l * 256, (LAS float*)(F.lds + LDS_G1X)};
                pg8::gemm_phase_f8<pg8::EpiG1N, pg8::StaticOrder>(F.lds, gm, So, E, nullptr, MK_TID()); }
        } else if (st == 1) {
            if (MK_EN(3)) {
                for (int gi = 0; gi < 2; ++gi) {
                    pg8::Gemm gm{(const bf16_t*)(F.ws + WS_P) + (gi ? 9984 : 9216), (const bf16_t*)(lw + (gi ? LW_WUKV : LW_WUQ)), T, gi ? 2048 : 1536, gi ? 512 : 768, NINP}; pg8::StaticOrder So; So.init(T, gm.N, F.nwg, F.rank);
                    pg8::EpiBf16P E{(bf16_t*)(F.ws + WS_O + (gi ? OO_KVRAW : OO_QRAW)), gm.N}; pg8::gemm_phase<pg8::EpiBf16P, pg8::StaticOrder>(F.lds, gm, So, E, nullptr, MK_TID());
                    __syncthreads();
                }
            }
        } else if (st == 2) { if (MK_EN(4)) p_post2(F, l);
        } else if (st == 3) { if (MK_EN(5)) p_attention(F, l, gs);
        } else if (st == 4) { if (MK_EN(6)) p_post3(F, l);
        } else if (st == 5) {
            if (MK_EN(7)) { pg8::Gemm gm{(const bf16_t*)(F.ws + WS_O), (const bf16_t*)(lw + LW_WOUT), T, DM, DM}; pg8::StaticOrder So; So.init(T, DM, F.nwg, F.rank);
                pg8::EpiResF32N E{xin, F.out, DM, (bf16_t*)(F.ws + WS_HN), 1.0f / (O8_SCALE * WOUT8_SCALE)}; pg8::gemm_phase_f8<pg8::EpiResF32N, pg8::StaticOrder>(F.lds, gm, So, E, nullptr, MK_TID()); }
        } else if (st == 6) {
            if (MK_EN(9)) { pg8::Gemm gm{(const bf16_t*)(F.ws + WS_HN), (const bf16_t*)(lw + LW_W2), T, 2048, DM}; pg8::StaticOrder So; So.init(T, 2048, F.nwg, F.rank);
                pg8::EpiF32 E{(float*)(F.ws + WS_P + PO_SC), 2048, nullptr}; pg8::gemm_phase<pg8::EpiF32, pg8::StaticOrder>(F.lds, gm, So, E, nullptr, MK_TID()); }
        } else if (st == 7) { if (MK_EN(10)) p_select(F, l);
        } else { if (MK_EN(11)) p_gather(F, l, gs); }
        if (i + 1 < nsteps) { if (all || nall) MK_BAR(1); else MK_BAR(0); }
#undef lw
#undef xin
    }
}
}

extern "C" void kernel_launch(void* const* d_in, const int* in_sizes, int n_in, void* d_out, int out_size, void* d_ws, size_t ws_size, hipStream_t stream) {
    static int grid = 0;
    if (grid == 0) {
        if (n_in != 20 || out_size != mk::TT * mk::DM || ws_size < mk::WS_TOTAL) { fprintf(stderr, "kernel_launch: unexpected shapes (n_in %d out %d ws %zu, need %zu)\n", n_in, out_size, ws_size, (size_t)mk::WS_TOTAL); grid = -1; return; }
        int dev = 0, cus = 0, per_cu = 0;
        if (hipGetDevice(&dev) != hipSuccess || hipDeviceGetAttribute(&cus, hipDeviceAttributeMultiprocessorCount, dev) != hipSuccess) { grid = -1; return; }
        if (hipFuncSetAttribute((const void*)mk::mk_fwd, hipFuncAttributeMaxDynamicSharedMemorySize, mk::LDS_BYTES) != hipSuccess) { fprintf(stderr, "kernel_launch: hipFuncSetAttribute failed\n"); grid = -1; return; }
        if (hipOccupancyMaxActiveBlocksPerMultiprocessor(&per_cu, (const void*)mk::mk_fwd, mk::NTHR, mk::LDS_BYTES) != hipSuccess || per_cu < 1) { fprintf(stderr, "kernel_launch: occupancy query says %d\n", per_cu); }
        (void)hipGetLastError();
        grid = cus & ~15;
    }
    if (grid < 0) return;
    (void)hipMemsetAsync((char*)d_ws + mk::WS_CTL, 0, 65536, stream);
    mk::Args a{};
    for (int i = 0; i < 20; ++i) a.in[i] = (const float*)d_in[i];
    a.out = (float*)d_out; a.ws = (unsigned char*)d_ws;
    hipLaunchKernelGGL(mk::mk_fwd, dim3(grid), dim3(mk::NTHR), mk::LDS_BYTES, stream, a);
    const hipError_t le = hipPeekAtLastError();
    if (le != hipSuccess) fprintf(stderr, "kernel_launch: launch failed: %s\n", hipGetErrorName(le));
}
```
